# Optimizing an MI355X kernel written in HIP

```python
import jax, jax.numpy as jnp
from jax import lax
import numpy as np


D_MODEL = 1024
BATCH = 2
SEQ = 8192
DEPTH = 1
DEC_BATCH = 32
DEC_SEQ = 16
PAST_LEN = 1024

CHUNK = 64
LEFT_CHUNKS = 8
LEFT_CONTEXT = LEFT_CHUNKS * CHUNK
MIX_WIDTH = D_MODEL
HEAD_DIM = 64
ATT_WIDTH = MIX_WIDTH // 2
RWKV_WIDTH = MIX_WIDTH - ATT_WIDTH
ATT_HEADS = ATT_WIDTH // HEAD_DIM
RWKV_HEADS = RWKV_WIDTH // HEAD_DIM
MAX_REL_DIST = 128
DECAY_LORA = 64
ICLR_LORA = 64
RMS_EPS = 1e-6
GN_EPS = 64e-5
ATT_COLS = 4 * ATT_WIDTH
RWKV_SHIFT_COLS = 3 * RWKV_WIDTH + DECAY_LORA + ICLR_LORA
IN_COLS = ATT_COLS + RWKV_SHIFT_COLS + RWKV_WIDTH

kernel_name = 'hymba_chunkattn_rwkv7_stream_step'

F32 = jnp.float32


def rms_norm(x, g):
    xf = x.astype(F32)
    y = xf * lax.rsqrt(jnp.mean(xf * xf, axis=-1, keepdims=True) + RMS_EPS)
    return (y * g.astype(F32)).astype(x.dtype)


def rel_bias(table, q_pos, k_pos):
    rel = jnp.clip(q_pos[:, None] - k_pos[None, :], -MAX_REL_DIST, MAX_REL_DIST) + MAX_REL_DIST
    return table.astype(F32)[:, rel]


def split_projection(proj):
    att = proj[..., :ATT_COLS]
    rcols = proj[..., ATT_COLS:ATT_COLS + RWKV_SHIFT_COLS]
    g_r = proj[..., ATT_COLS + RWKV_SHIFT_COLS:]
    return att, rcols, g_r


def attn_qkv(att, q_gain, k_gain):
    B, T, _ = att.shape
    q, k, v, g = jnp.split(att, 4, axis=-1)
    q = rms_norm(q.reshape(B, T, ATT_HEADS, HEAD_DIM), q_gain)
    k = rms_norm(k.reshape(B, T, ATT_HEADS, HEAD_DIM), k_gain)
    v = v.reshape(B, T, ATT_HEADS, HEAD_DIM)
    return q, k, v, g


def chunk_band_attention(q, k, v, table):
    B, T, H, Dh = q.shape
    nc = T // CHUNK
    pad = ((0, 0), (LEFT_CONTEXT, 0), (0, 0), (0, 0))
    kp = jnp.pad(k, pad).reshape(B, nc + LEFT_CHUNKS, CHUNK, H, Dh)
    vp = jnp.pad(v, pad).reshape(B, nc + LEFT_CHUNKS, CHUNK, H, Dh)
    kb = jnp.concatenate([kp[:, j:j + nc] for j in range(LEFT_CHUNKS + 1)], axis=2)
    vb = jnp.concatenate([vp[:, j:j + nc] for j in range(LEFT_CHUNKS + 1)], axis=2)
    qc = q.reshape(B, nc, CHUNK, H, Dh)
    s = jnp.einsum('bnqhd,bnkhd->bnhqk', qc.astype(F32), kb.astype(F32)) * (Dh ** -0.5)
    q_off = jnp.arange(CHUNK, dtype=jnp.int32)
    k_off = jnp.arange((LEFT_CHUNKS + 1) * CHUNK, dtype=jnp.int32) - LEFT_CONTEXT
    s = s + rel_bias(table, q_off, k_off)[None, None]
    valid = (jnp.arange(nc, dtype=jnp.int32)[:, None] * CHUNK + k_off[None, :]) >= 0
    s = jnp.where(valid[None, :, None, None, :], s, jnp.finfo(F32).min)
    p = jax.nn.softmax(s, axis=-1)
    o = jnp.einsum('bnhqk,bnkhd->bnqhd', p, vb.astype(F32))
    return o.reshape(B, T, H * Dh)


def cached_band_attention(q, k_new, v_new, cache_k, cache_v, table):
    B, Tn, H, Dh = q.shape
    W = cache_k.shape[2]
    kc = jnp.concatenate([cache_k.astype(F32), k_new.transpose(0, 2, 1, 3).astype(F32)], axis=2)
    vc = jnp.concatenate([cache_v.astype(F32), v_new.transpose(0, 2, 1, 3).astype(F32)], axis=2)
    s = jnp.einsum('bqhd,bhkd->bhqk', q.astype(F32), kc) * (Dh ** -0.5)
    q_off = jnp.arange(Tn, dtype=jnp.int32)
    k_off = jnp.arange(W + Tn, dtype=jnp.int32) - W
    s = s + rel_bias(table, q_off, k_off)[None]
    p = jax.nn.softmax(s, axis=-1)
    o = jnp.einsum('bhqk,bhkd->bqhd', p, vc)
    return o.reshape(B, Tn, H * Dh)


def wkv_scan(r, decay, k, v, kk, a, state0):
    def step(S, inp):
        r_t, w_t, k_t, v_t, kk_t, a_t = inp
        sa = jnp.einsum('bhij,bhj->bhi', S, -kk_t)
        S = (S * w_t[:, :, None, :] + sa[..., None] * (kk_t * a_t)[:, :, None, :]
             + v_t[..., None] * k_t[:, :, None, :])
        y = jnp.einsum('bhij,bhj->bhi', S, r_t)
        return S, y
    xs = tuple(jnp.moveaxis(t, 1, 0) for t in (r, decay, k, v, kk, a))
    S, ys = lax.scan(step, state0.astype(F32), xs)
    return jnp.moveaxis(ys, 0, 1), S


def rwkv_branch(cur, prev, state0, g, mix, w0, w_up, a0, a_up, k_k, k_a, r_k, gn_g, gn_b):
    B, T, _ = cur.shape
    xs = cur + (prev - cur) * mix
    r, k, v, wd, ad = jnp.split(xs, [RWKV_WIDTH, 2 * RWKV_WIDTH, 3 * RWKV_WIDTH,
                                     3 * RWKV_WIDTH + DECAY_LORA], axis=-1)
    w = -jax.nn.softplus(-(w0 + jnp.tanh(wd) @ w_up).astype(F32)) - 0.5
    decay = jnp.exp(-jnp.exp(w))
    a = jax.nn.sigmoid((a0 + ad @ a_up).astype(F32))
    heads = lambda t: t.astype(F32).reshape(B, T, RWKV_HEADS, HEAD_DIM)
    kk = heads(k * k_k)
    kk = kk * lax.rsqrt(jnp.maximum(jnp.sum(kk * kk, axis=-1, keepdims=True), 1e-24))
    k = k.astype(F32) * (1.0 + (a - 1.0) * k_a.astype(F32))
    r, k, v, a, decay = heads(r), heads(k), heads(v), heads(a), heads(decay)
    y, S = wkv_scan(r, decay, k, v, kk, a, state0)
    mu = jnp.mean(y, axis=-1, keepdims=True)
    var = jnp.mean(jnp.square(y - mu), axis=-1, keepdims=True)
    y = ((y - mu) * lax.rsqrt(var + GN_EPS)).reshape(B, T, RWKV_WIDTH) * gn_g.astype(F32) + gn_b.astype(F32)
    y = y + (jnp.sum(r * k * r_k.astype(F32), axis=-1, keepdims=True) * v).reshape(B, T, RWKV_WIDTH)
    return y * jax.nn.silu(g.astype(F32)), S


def merge_out(o_a, g_a, o_r, w_out, dtype):
    z = jnp.concatenate([o_a * jax.nn.silu(g_a.astype(F32)), o_r], axis=-1)
    return (z.astype(dtype) @ w_out).astype(dtype)


def setup_inputs(seed: int = 0) -> dict:
    key = jax.random.key(seed)
    ks = jax.random.split(key, 24)
    n = lambda i, shape: jax.random.normal(ks[i], shape, F32)
    win = min(LEFT_CONTEXT, PAST_LEN)
    return {
        'x_prompt': n(0, (BATCH, SEQ, D_MODEL)),
        'x_sample': n(1, (DEC_BATCH, DEC_SEQ, D_MODEL)),
        'cache_attn_k': n(2, (DEPTH, DEC_BATCH, ATT_HEADS, win, HEAD_DIM)),
        'cache_attn_v': n(3, (DEPTH, DEC_BATCH, ATT_HEADS, win, HEAD_DIM)),
        'state_rwkv_wkv': 0.1 * n(4, (DEPTH, DEC_BATCH, RWKV_HEADS, HEAD_DIM, HEAD_DIM)),
        'state_rwkv_shift': n(5, (DEPTH, DEC_BATCH, 1, RWKV_SHIFT_COLS)),
        'norm_gain': 1.0 + 0.05 * n(6, (DEPTH, D_MODEL)),
        'w_in': n(7, (DEPTH, D_MODEL, IN_COLS)) * D_MODEL ** -0.5,
        'q_norm_gain': 1.0 + 0.05 * n(8, (DEPTH, HEAD_DIM)),
        'k_norm_gain': 1.0 + 0.05 * n(9, (DEPTH, HEAD_DIM)),
        'rel_pos_bias': 0.1 * n(10, (DEPTH, ATT_HEADS, 2 * MAX_REL_DIST + 1)),
        'shift_mix': jax.random.uniform(ks[11], (DEPTH, RWKV_SHIFT_COLS), F32),
        'decay_base': jax.random.uniform(ks[12], (DEPTH, RWKV_WIDTH), F32, -6.0, -1.0),
        'decay_lora_up': 0.1 * n(13, (DEPTH, DECAY_LORA, RWKV_WIDTH)),
        'iclr_base': 0.1 * n(14, (DEPTH, RWKV_WIDTH)),
        'iclr_lora_up': n(15, (DEPTH, ICLR_LORA, RWKV_WIDTH)) * ICLR_LORA ** -0.5,
        'key_remove_scale': 0.85 + 0.05 * n(16, (DEPTH, RWKV_WIDTH)),
        'key_iclr_scale': 1.0 + 0.05 * n(17, (DEPTH, RWKV_WIDTH)),
        'bonus_scale': 0.1 * n(18, (DEPTH, RWKV_HEADS, HEAD_DIM)),
        'out_norm_gain': 1.0 + 0.05 * n(19, (DEPTH, RWKV_WIDTH)),
        'out_norm_bias': 0.01 * n(20, (DEPTH, RWKV_WIDTH)),
        'w_out': n(21, (DEPTH, MIX_WIDTH, D_MODEL)) * MIX_WIDTH ** -0.5,
    }


def reference(x_prompt, x_sample, cache_attn_k, cache_attn_v, state_rwkv_wkv, state_rwkv_shift,
              norm_gain, w_in, q_norm_gain, k_norm_gain, rel_pos_bias, shift_mix,
              decay_base, decay_lora_up, iclr_base, iclr_lora_up, key_remove_scale,
              key_iclr_scale, bonus_scale, out_norm_gain, out_norm_bias, w_out):
    h_p, h_s = x_prompt, x_sample
    kp_l, vp_l, ks_l, vs_l, sp_l, ss_l, shp_l, shs_l = [], [], [], [], [], [], [], []
    for l in range(DEPTH):
        rw = (shift_mix[l], decay_base[l], decay_lora_up[l], iclr_base[l], iclr_lora_up[l],
              key_remove_scale[l], key_iclr_scale[l], bonus_scale[l], out_norm_gain[l], out_norm_bias[l])
        B, T, _ = h_p.shape
        proj = rms_norm(h_p, norm_gain[l]) @ w_in[l]
        att, rcols, g_r = split_projection(proj)
        q, k, v, g_a = attn_qkv(att, q_norm_gain[l], k_norm_gain[l])
        o_a = chunk_band_attention(q, k, v, rel_pos_bias[l])
        prev = jnp.concatenate([jnp.zeros_like(rcols[:, :1]), rcols[:, :-1]], axis=1)
        o_r, S_p = rwkv_branch(rcols, prev, jnp.zeros((B, RWKV_HEADS, HEAD_DIM, HEAD_DIM), F32), g_r, *rw)
        h_p = h_p + merge_out(o_a, g_a, o_r, w_out[l], h_p.dtype)
        win = min(LEFT_CONTEXT, T)
        kp_l.append(k[:, T - win:].transpose(0, 2, 1, 3))
        vp_l.append(v[:, T - win:].transpose(0, 2, 1, 3))
        sp_l.append(S_p)
        shp_l.append(rcols[:, -1:])
        proj = rms_norm(h_s, norm_gain[l]) @ w_in[l]
        att, rcols, g_r = split_projection(proj)
        q, k, v, g_a = attn_qkv(att, q_norm_gain[l], k_norm_gain[l])
        o_a = cached_band_attention(q, k, v, cache_attn_k[l], cache_attn_v[l], rel_pos_bias[l])
        prev = jnp.concatenate([state_rwkv_shift[l].astype(rcols.dtype), rcols[:, :-1]], axis=1)
        o_r, S_s = rwkv_branch(rcols, prev, state_rwkv_wkv[l], g_r, *rw)
        h_s = h_s + merge_out(o_a, g_a, o_r, w_out[l], h_s.dtype)
        ks_l.append(k.transpose(0, 2, 1, 3))
        vs_l.append(v.transpose(0, 2, 1, 3))
        ss_l.append(S_s)
        shs_l.append(rcols[:, -1:])
    return (h_p, h_s, jnp.stack(kp_l), jnp.stack(vp_l), jnp.stack(ks_l), jnp.stack(vs_l),
            jnp.stack(sp_l), jnp.stack(ss_l), jnp.stack(shp_l), jnp.stack(shs_l))
```

```cpp
#include <hip/hip_runtime.h>
#include <hip/hip_cooperative_groups.h>
#include <cstdio>
#include <cstdint>
namespace cg = cooperative_groups;

#ifndef ONE_LAUNCH
#define ONE_LAUNCH 1
#endif

#define DI __device__ __forceinline__
#define LAS __attribute__((address_space(3)))
typedef unsigned short u16;
typedef short bf16x8 __attribute__((ext_vector_type(8)));
typedef short s16x4 __attribute__((ext_vector_type(4)));
typedef float f32x4 __attribute__((ext_vector_type(4)));
typedef float f32x16 __attribute__((ext_vector_type(16)));
typedef float f32x2_t __attribute__((ext_vector_type(2)));
typedef __bf16 bf16x2_t __attribute__((ext_vector_type(2)));
typedef __attribute__((address_space(3))) s16x4 lds_s16x4;

constexpr int DM = 1024, NC = 4224, NTP = 16384, NTS = 512, NTOK = 16896;
constexpr int C_Q = 0, C_K = 512, C_V = 1024, C_GA = 1536, C_R = 2048, C_RK = 2560, C_RV = 3072, C_WD = 3584, C_AD = 3648, C_GR = 3712;
constexpr int NUNIT = 2304;
constexpr size_t O_YP = 0, O_YS = 16777216, O_KP = 17301504, O_VP = 17825792, O_KS = 18350080, O_VS = 18612224,
                 O_SP = 18874368, O_SS = 18939904, O_SHP = 19988480, O_SHS = 19991808;
constexpr size_t W_XB = 0, W_WINT = 34603008, W_WOUTT = 43253760, W_WUPT = 45350912, W_AUPT = 45416448, W_RSTD = 45481984,
                 W_BONUS = 264339456  , W_PROJ = 46090240, W_GT = 188827648, W_HH = 207702016, W_QT = 226576384, W_SST = 245450752, W_BAR = 264325120;
constexpr int LDS_BYTES = 75776;
constexpr float LOG2E = 1.4426950408889634f;

struct Params {
    const float *x_p, *x_s, *cache_k, *cache_v, *st_wkv, *st_shift, *norm_g, *w_in, *q_g, *k_g, *relb, *mix, *w0, *w_up, *a0, *a_up,
        *k_k, *k_a, *r_k, *gn_g, *gn_b, *w_out;
    float* out;
    char* ws;
};

DI unsigned pack2(float lo, float hi) { f32x2_t v = {lo, hi}; bf16x2_t b = __builtin_convertvector(v, bf16x2_t); return __builtin_bit_cast(unsigned, b); }
DI u16 f2bf(float f) { return (u16)(pack2(f, 0.f) & 0xffffu); }
DI float bflo(unsigned u) { return __uint_as_float(u << 16); }
DI float bfhi(unsigned u) { return __uint_as_float(u & 0xffff0000u); }
DI float bf2f(u16 h) { return __uint_as_float((unsigned)h << 16); }
DI int swz(int row, int ch) { return row * 128 + ((ch ^ ((row >> 1) & 7)) << 4); }
DI float dpp_add(float v, const int ctrl_sel) {
    int x = __float_as_int(v), y;
    if (ctrl_sel == 0) y = __builtin_amdgcn_update_dpp(0, x, 0xB1, 0xf, 0xf, true);
    else if (ctrl_sel == 1) y = __builtin_amdgcn_update_dpp(0, x, 0x4E, 0xf, 0xf, true);
    else if (ctrl_sel == 2) y = __builtin_amdgcn_update_dpp(0, x, 0x141, 0xf, 0xf, true);
    else y = __builtin_amdgcn_update_dpp(0, x, 0x140, 0xf, 0xf, true);
    return v + __int_as_float(y);
}
DI float wave_sum(float v) {
    v = dpp_add(v, 0); v = dpp_add(v, 1); v = dpp_add(v, 2); v = dpp_add(v, 3);
    const int x = __float_as_int(v);
    const float a = __int_as_float(__builtin_amdgcn_readlane(x, 0)), b = __int_as_float(__builtin_amdgcn_readlane(x, 16)),
                c = __int_as_float(__builtin_amdgcn_readlane(x, 32)), d = __int_as_float(__builtin_amdgcn_readlane(x, 48));
    return (a + b) + (c + d);
}
DI float rcpf_(float x) { return __builtin_amdgcn_rcpf(x); }
DI float silu(float x) { return x * rcpf_(1.f + __expf(-x)); }
DI float xadd16(float v) { const unsigned x = __float_as_uint(v); auto r = __builtin_amdgcn_permlane16_swap(x, x, false, false); return __uint_as_float(r[0]) + __uint_as_float(r[1]); }
DI float xadd32(float v) { const unsigned x = __float_as_uint(v); auto r = __builtin_amdgcn_permlane32_swap(x, x, false, false); return __uint_as_float(r[0]) + __uint_as_float(r[1]); }
DI float xmax16(float v) { const unsigned x = __float_as_uint(v); auto r = __builtin_amdgcn_permlane16_swap(x, x, false, false); return fmaxf(__uint_as_float(r[0]), __uint_as_float(r[1])); }
DI uint4 widen16(uint2 w0, uint2 w1) {
    auto rx = __builtin_amdgcn_permlane16_swap(w0.x, w1.x, false, false); auto ry = __builtin_amdgcn_permlane16_swap(w0.y, w1.y, false, false);
    return (uint4){rx[0], ry[0], rx[1], ry[1]};
}
DI void unwiden16(uint4 L, uint2& w0, uint2& w1) {
    auto rx = __builtin_amdgcn_permlane16_swap(L.x, L.z, false, false); auto ry = __builtin_amdgcn_permlane16_swap(L.y, L.w, false, false);
    w0 = (uint2){rx[0], ry[0]}; w1 = (uint2){rx[1], ry[1]};
}
DI float xmax32(float v) { const unsigned x = __float_as_uint(v); auto r = __builtin_amdgcn_permlane32_swap(x, x, false, false); return fmaxf(__uint_as_float(r[0]), __uint_as_float(r[1])); }
DI void unpack8(uint4 u, float* o) {
    o[0] = bflo(u.x); o[1] = bfhi(u.x); o[2] = bflo(u.y); o[3] = bfhi(u.y); o[4] = bflo(u.z); o[5] = bfhi(u.z); o[6] = bflo(u.w); o[7] = bfhi(u.w);
}

DI void transpose_tile(const float* W, int K, int N, const float* gain, u16* dst, float* tile, int t) {
    const int nkt = K / 64; const int kt = t % nkt, nt = t / nkt; const int k0 = kt * 64, n0 = nt * 64;
    const int tid = threadIdx.x, lane = tid & 63, wave = tid >> 6;
    float4 wv[4];
#pragma unroll
    for (int i = 0; i < 4; ++i) { const int idx = tid + 256 * i; wv[i] = *(const float4*)(W + (size_t)(k0 + (idx >> 4)) * N + n0 + 4 * (idx & 15)); }
    const float gl = gain ? gain[k0 + lane] : 1.f;
#pragma unroll
    for (int i = 0; i < 4; ++i) { const int kr = 16 * i + 4 * wave + (lane >> 4);
        const float g = __shfl(gl, kr); float* tp = tile + kr * 65 + 4 * (lane & 15);
        tp[0] = wv[i].x * g; tp[1] = wv[i].y * g; tp[2] = wv[i].z * g; tp[3] = wv[i].w * g; }
    __syncthreads();
#pragma unroll 4
    for (int i = 0; i < 8; ++i) { const int n = i * 8 + (tid >> 5); const int kp = tid & 31;
        const unsigned v = pack2(tile[(2 * kp) * 65 + n], tile[(2 * kp + 1) * 65 + n]); *(unsigned*)(dst + (size_t)(n0 + n) * K + k0 + 2 * kp) = v; }
    __syncthreads();
}
DI void phase_prep(const Params& p, char* lds) {
    const int tid = threadIdx.x, lane = tid & 63, wave = tid >> 6;
    u16* xb = (u16*)(p.ws + W_XB); float* rstd = (float*)(p.ws + W_RSTD);
    for (int rg = blockIdx.x * 4 + wave; rg < NTOK / 4; rg += gridDim.x * 4) {
        float4 v[4][4]; float ss[4];
#pragma unroll
        for (int k = 0; k < 4; ++k) { const int row = rg * 4 + k; const float* src = row < NTP ? p.x_p + (size_t)row * DM : p.x_s + (size_t)(row - NTP) * DM;
#pragma unroll
            for (int i = 0; i < 4; ++i) v[k][i] = ((const float4*)src)[i * 64 + lane]; }
#pragma unroll
        for (int k = 0; k < 4; ++k) { float a = 0.f;
#pragma unroll
            for (int i = 0; i < 4; ++i) a += v[k][i].x * v[k][i].x + v[k][i].y * v[k][i].y + v[k][i].z * v[k][i].z + v[k][i].w * v[k][i].w;
            ss[k] = wave_sum(a); }
#pragma unroll
        for (int k = 0; k < 4; ++k) { const int row = rg * 4 + k;
            if (lane == 0) rstd[row] = rsqrtf(ss[k] * (1.f / 1024.f) + 1e-6f);
#pragma unroll
            for (int i = 0; i < 4; ++i) { uint2 w; w.x = pack2(v[k][i].x, v[k][i].y); w.y = pack2(v[k][i].z, v[k][i].w); *(uint2*)(xb + (size_t)row * DM + (i * 64 + lane) * 4) = w; } }
    }
    float* tile = (float*)lds;
    for (int t = blockIdx.x; t < 1056 + 256 + 16; t += gridDim.x) {
        if (t < 1056) transpose_tile(p.w_in, 1024, NC, p.norm_g, (u16*)(p.ws + W_WINT), tile, t);
        else if (t < 1312) transpose_tile(p.w_out, 1024, 1024, nullptr, (u16*)(p.ws + W_WOUTT), tile, t - 1056);
        else if (t < 1320) transpose_tile(p.w_up, 64, 512, nullptr, (u16*)(p.ws + W_WUPT), tile, t - 1312);
        else transpose_tile(p.a_up, 64, 512, nullptr, (u16*)(p.ws + W_AUPT), tile, t - 1320);
    }
}

template <class Epi>
DI void gemm_phase(const u16* __restrict__ A, const u16* __restrict__ B, int mtiles, int ntiles, char* lds, const Epi& epi) {
    const int ntile = mtiles * ntiles;
    const int vb = (blockIdx.x & 7) * (gridDim.x >> 3) + (blockIdx.x >> 3);
    const int npan = ntiles >> 3;
    int tile = vb; if (tile >= ntile) return;
#define TILE_MN(t, M0, N0) do { int pan_ = (t) / (mtiles * 8); if (pan_ >= npan) pan_ = npan - 1; const int pw_ = (pan_ == npan - 1) ? ntiles - 8 * pan_ : 8; const int loc_ = (t) - pan_ * mtiles * 8; \
        M0 = (loc_ / pw_) * 128; N0 = (8 * pan_ + loc_ % pw_) * 128; } while (0)
#define GSTAGE(buf, kt, GA, GB) do { _Pragma("unroll") for (int i = 0; i < 4; ++i) { \
            __builtin_amdgcn_global_load_lds((const unsigned*)((GA) + soff[i] + (kt) * 64), (LAS unsigned*)(lds + (buf) * 32768 + (i * 4 + wave) * 1024), 16, 0, 0); \
            __builtin_amdgcn_global_load_lds((const unsigned*)((GB) + soff[i] + (kt) * 64), (LAS unsigned*)(lds + (buf) * 32768 + 16384 + (i * 4 + wave) * 1024), 16, 0, 0); } } while (0)
    int m0, n0; TILE_MN(tile, m0, n0);
    {
        const int lane = threadIdx.x & 63, wave = __builtin_amdgcn_readfirstlane(threadIdx.x >> 6);
        unsigned soff[4];
#pragma unroll
        for (int i = 0; i < 4; ++i) { const int row = 8 * (i * 4 + wave) + (lane >> 3); const int ch = (lane & 7) ^ ((row >> 1) & 7); soff[i] = (unsigned)(row * 1024 + ch * 8); }
        GSTAGE(0, 0, A + (size_t)m0 * 1024, B + (size_t)n0 * 1024);
    }
    for (;;) {
        int tid = threadIdx.x; asm volatile("" : "+v"(tid));
        const int lane = tid & 63, wave = __builtin_amdgcn_readfirstlane(tid >> 6); const int wn = wave >> 1, wm = wave & 1; const int r = lane & 31, h = lane >> 5;
        f32x16 acc[2][2];
#pragma unroll
        for (int a = 0; a < 2; ++a)
#pragma unroll
            for (int b = 0; b < 2; ++b)
#pragma unroll
                for (int e = 0; e < 16; ++e) acc[a][b][e] = 0.f;
        unsigned soff[4];
#pragma unroll
        for (int i = 0; i < 4; ++i) { const int row = 8 * (i * 4 + wave) + (lane >> 3); const int ch = (lane & 7) ^ ((row >> 1) & 7); soff[i] = (unsigned)(row * 1024 + ch * 8); }
        const u16* ga = A + (size_t)m0 * 1024; const u16* gb = B + (size_t)n0 * 1024;
        __syncthreads();
        for (int kt = 0; kt < 16; ++kt) {
            if (kt + 1 < 16) GSTAGE((kt + 1) & 1, kt + 1, ga, gb);
            const char* sa = lds + (kt & 1) * 32768; const char* sb = sa + 16384;
#pragma unroll
            for (int ks = 0; ks < 4; ++ks) {
                bf16x8 fw[2], fx[2];
#pragma unroll
                for (int ct = 0; ct < 2; ++ct) fw[ct] = *(const bf16x8*)(sb + swz(wn * 64 + ct * 32 + r, 2 * ks + h));
#pragma unroll
                for (int tt = 0; tt < 2; ++tt) fx[tt] = *(const bf16x8*)(sa + swz(wm * 64 + tt * 32 + r, 2 * ks + h));
#pragma unroll
                for (int ct = 0; ct < 2; ++ct)
#pragma unroll
                    for (int tt = 0; tt < 2; ++tt) acc[ct][tt] = __builtin_amdgcn_mfma_f32_32x32x16_bf16(fw[ct], fx[tt], acc[ct][tt], 0, 0, 0);
            }
            __syncthreads();
        }
        const int nxt = tile + (int)gridDim.x; int m1 = 0, n1 = 0;
        if (nxt < ntile) { TILE_MN(nxt, m1, n1); GSTAGE(0, 0, A + (size_t)m1 * 1024, B + (size_t)n1 * 1024); }
        epi(acc, m0 + wm * 64, n0 + wn * 64, lane);
        if (nxt >= ntile) break;
        tile = nxt; m0 = m1; n0 = n1;
    }
#undef GSTAGE
#undef TILE_MN
}

struct Epi1 {
    const Params* p;
    DI void operator()(f32x16 (&acc)[2][2], int mrow0, int ncol0, int lane) const {
        const int r = lane & 31, h = lane >> 5; const int cb = ncol0 >> 6;
        u16* proj = (u16*)(p->ws + W_PROJ); const float* rstd = (const float*)(p->ws + W_RSTD); float* out = p->out;
#pragma unroll
        for (int tt = 0; tt < 2; ++tt) {
            const int row = mrow0 + tt * 32 + r; const float rs = rstd[row];
            float v[2][16];
#pragma unroll
            for (int ct = 0; ct < 2; ++ct)
#pragma unroll
                for (int e = 0; e < 16; ++e) v[ct][e] = acc[ct][tt][e] * rs;
            if (cb < 16) {
                float ss = 0.f;
#pragma unroll
                for (int ct = 0; ct < 2; ++ct)
#pragma unroll
                    for (int e = 0; e < 16; ++e) ss += v[ct][e] * v[ct][e];
                ss = xadd32(ss);
                const float inv = __builtin_amdgcn_rsqf(ss * (1.f / 64.f) + 1e-6f);
                const float* g = cb < 8 ? p->q_g : p->k_g;
#pragma unroll
                for (int ct = 0; ct < 2; ++ct)
#pragma unroll
                    for (int gq = 0; gq < 4; ++gq) { const float4 gg = *(const float4*)(g + ct * 32 + 8 * gq + 4 * h);
                        v[ct][4 * gq] *= inv * gg.x; v[ct][4 * gq + 1] *= inv * gg.y; v[ct][4 * gq + 2] *= inv * gg.z; v[ct][4 * gq + 3] *= inv * gg.w; }
            }
#pragma unroll
            for (int ct = 0; ct < 2; ++ct)
#pragma unroll
                for (int gq = 0; gq < 4; gq += 2) {
                    unsigned ax = pack2(v[ct][4 * gq], v[ct][4 * gq + 1]), ay = pack2(v[ct][4 * gq + 2], v[ct][4 * gq + 3]);
                    unsigned bx = pack2(v[ct][4 * gq + 4], v[ct][4 * gq + 5]), by = pack2(v[ct][4 * gq + 6], v[ct][4 * gq + 7]);
                    { auto rr = __builtin_amdgcn_permlane32_swap(ax, bx, false, false); ax = rr[0]; bx = rr[1]; }
                    { auto rr = __builtin_amdgcn_permlane32_swap(ay, by, false, false); ay = rr[0]; by = rr[1]; }
                    *(uint4*)(proj + (size_t)row * NC + ncol0 + ct * 32 + 8 * gq + 8 * h) = (uint4){ax, ay, bx, by};
                }
            float* dst = nullptr;
            if (cb >= 8 && cb < 24) {
                const int hh = cb & 7;
                if (row < NTP) { const int b = row >> 13, t = row & 8191; if (t >= 7680) dst = out + (cb < 16 ? O_KP : O_VP) + ((size_t)(b * 8 + hh) * 512 + (t - 7680)) * 64; }
                else { const int s = row - NTP; const int b = s >> 4, t = s & 15; dst = out + (cb < 16 ? O_KS : O_VS) + ((size_t)(b * 8 + hh) * 16 + t) * 64; }
            } else if (cb >= 32 && cb < 58) {
                if (row < NTP) { if ((row & 8191) == 8191) dst = out + O_SHP + (size_t)(row >> 13) * 1664 + (cb - 32) * 64; }
                else { const int s = row - NTP; if ((s & 15) == 15) dst = out + O_SHS + (size_t)(s >> 4) * 1664 + (cb - 32) * 64; }
            }
            if (dst) {
#pragma unroll
                for (int ct = 0; ct < 2; ++ct)
#pragma unroll
                    for (int gq = 0; gq < 4; ++gq) { float4 w = {v[ct][4 * gq], v[ct][4 * gq + 1], v[ct][4 * gq + 2], v[ct][4 * gq + 3]}; *(float4*)(dst + ct * 32 + 8 * gq + 4 * h) = w; }
            }
        }
    }
};
struct Epi2 {
    const Params* p;
    DI void operator()(f32x16 (&acc)[2][2], int mrow0, int ncol0, int lane) const {
        const int r = lane & 31, h = lane >> 5;
#pragma unroll
        for (int tt = 0; tt < 2; ++tt) {
            const int row = mrow0 + tt * 32 + r;
            const float* xr = row < NTP ? p->x_p + (size_t)row * DM : p->x_s + (size_t)(row - NTP) * DM;
            float* o = p->out + (size_t)row * DM;
#pragma unroll
            for (int ct = 0; ct < 2; ++ct)
#pragma unroll
                for (int gq = 0; gq < 4; ++gq) { const int col = ncol0 + ct * 32 + 8 * gq + 4 * h; const float4 xv = *(const float4*)(xr + col);
                    float4 w = {xv.x + acc[ct][tt][4 * gq], xv.y + acc[ct][tt][4 * gq + 1], xv.z + acc[ct][tt][4 * gq + 2], xv.w + acc[ct][tt][4 * gq + 3]}; *(float4*)(o + col) = w; }
        }
    }
};

DI void gemm_out(const Params& p, char* lds) {
    const u16* __restrict__ A = (const u16*)(p.ws + W_XB); const u16* __restrict__ B = (const u16*)(p.ws + W_WOUTT);
    const int ntile = 176 * 8;
    const int vb = (blockIdx.x & 7) * (gridDim.x >> 3) + (blockIdx.x >> 3);
    for (int tile = vb; tile < ntile; tile += gridDim.x) {
        int tid = threadIdx.x; asm volatile("" : "+v"(tid));
        const int lane = tid & 63, wave = __builtin_amdgcn_readfirstlane(tid >> 6); const int wn = wave >> 1, wm = wave & 1; const int q = lane & 15, g = lane >> 4;
        const int mt = tile >> 3, nt = tile & 7; const int m0 = mt * 96, n0 = nt * 128;
        f32x4 acc[4][3];
#pragma unroll
        for (int a = 0; a < 4; ++a)
#pragma unroll
            for (int b = 0; b < 3; ++b) acc[a][b] = (f32x4){0.f, 0.f, 0.f, 0.f};
        unsigned soffb[4], soffa[3];
#pragma unroll
        for (int i = 0; i < 4; ++i) { const int row = 8 * (i * 4 + wave) + (lane >> 3); const int ch = (lane & 7) ^ ((row >> 1) & 7); soffb[i] = (unsigned)(row * 1024 + ch * 8); }
#pragma unroll
        for (int i = 0; i < 3; ++i) { const int row = 8 * (i * 4 + wave) + (lane >> 3); const int ch = (lane & 7) ^ ((row >> 1) & 7); soffa[i] = (unsigned)(row * 1024 + ch * 8); }
        const u16* ga = A + (size_t)m0 * 1024; const u16* gb = B + (size_t)n0 * 1024;
#define OSTAGE(buf, kt) do { _Pragma("unroll") for (int i = 0; i < 4; ++i) \
            __builtin_amdgcn_global_load_lds((const unsigned*)(gb + soffb[i] + (kt) * 64), (LAS unsigned*)(lds + (buf) * 28672 + (i * 4 + wave) * 1024), 16, 0, 0); \
        _Pragma("unroll") for (int i = 0; i < 3; ++i) \
            __builtin_amdgcn_global_load_lds((const unsigned*)(ga + soffa[i] + (kt) * 64), (LAS unsigned*)(lds + (buf) * 28672 + 16384 + (i * 4 + wave) * 1024), 16, 0, 0); } while (0)
        OSTAGE(0, 0);
        float4 xres[3][4];
#pragma unroll
        for (int tt = 0; tt < 3; ++tt) { const int row = m0 + wm * 48 + tt * 16 + q; const float* xr = row < NTP ? p.x_p + (size_t)row * DM : p.x_s + (size_t)(row - NTP) * DM;
#pragma unroll
            for (int ct = 0; ct < 4; ++ct) xres[tt][ct] = *(const float4*)(xr + n0 + wn * 64 + ct * 16 + 4 * g); }
        __syncthreads();
        for (int kt = 0; kt < 16; ++kt) {
            if (kt + 1 < 16) OSTAGE((kt + 1) & 1, kt + 1);
            const char* sb = lds + (kt & 1) * 28672; const char* sa = sb + 16384;
#pragma unroll
            for (int ks = 0; ks < 2; ++ks) {
                bf16x8 fw[4], fx[3];
#pragma unroll
                for (int ct = 0; ct < 4; ++ct) fw[ct] = *(const bf16x8*)(sb + swz(wn * 64 + ct * 16 + q, 4 * ks + g));
#pragma unroll
                for (int tt = 0; tt < 3; ++tt) fx[tt] = *(const bf16x8*)(sa + swz(wm * 48 + tt * 16 + q, 4 * ks + g));
#pragma unroll
                for (int ct = 0; ct < 4; ++ct)
#pragma unroll
                    for (int tt = 0; tt < 3; ++tt) acc[ct][tt] = __builtin_amdgcn_mfma_f32_16x16x32_bf16(fw[ct], fx[tt], acc[ct][tt], 0, 0, 0);
            }
            __syncthreads();
        }
#undef OSTAGE
#pragma unroll
        for (int tt = 0; tt < 3; ++tt) {
            const int row = m0 + wm * 48 + tt * 16 + q;
            const float* xr = row < NTP ? p.x_p + (size_t)row * DM : p.x_s + (size_t)(row - NTP) * DM;
            float* o = p.out + (size_t)row * DM;
#pragma unroll
            for (int ct = 0; ct < 4; ++ct) { const int col = n0 + wn * 64 + ct * 16 + 4 * g; const float4 xv = xres[tt][ct];
                float4 w = {xv.x + acc[ct][tt][0], xv.y + acc[ct][tt][1], xv.z + acc[ct][tt][2], xv.w + acc[ct][tt][3]}; *(float4*)(o + col) = w; }
        }
    }
}

DI f32x16 mmq(const char* X, const char* Y, int qm, int qn, f32x16 acc, int lane) {
    const int r = lane & 31, h = lane >> 5;
#pragma unroll
    for (int ks = 0; ks < 4; ++ks) {
        const bf16x8 a = *(const bf16x8*)(X + swz(32 * qm + r, 2 * ks + h));
        const bf16x8 b = *(const bf16x8*)(Y + swz(32 * qn + r, 2 * ks + h));
        acc = __builtin_amdgcn_mfma_f32_32x32x16_bf16(a, b, acc, 0, 0, 0);
    }
    return acc;
}
DI void st_nat(char* img, const f32x16& a, int qm, int qn, int lane) {
    const int n = 32 * qn + (lane & 31), h = lane >> 5;
#pragma unroll
    for (int g = 0; g < 4; ++g) { const int m = 32 * qm + 8 * g + 4 * h; uint2 w; w.x = pack2(a[4 * g], a[4 * g + 1]); w.y = pack2(a[4 * g + 2], a[4 * g + 3]);
        *(uint2*)(img + swz(n, m >> 3) + (m & 7) * 2) = w; }
}
DI void st_nat_g(u16* gimg, const f32x16& a, int qm, int qn, int lane) {
    const int n = 32 * qn + (lane & 31), h = lane >> 5;
#pragma unroll
    for (int g = 0; g < 4; ++g) { const int m = 32 * qm + 8 * g + 4 * h; uint2 w; w.x = pack2(a[4 * g], a[4 * g + 1]); w.y = pack2(a[4 * g + 2], a[4 * g + 3]);
        *(uint2*)(gimg + n * 64 + m) = w; }
}
DI void st_nat_gp(u16* gimg, const f32x16& a, int qm, int qn, int lane) {
    const int n = 32 * qn + (lane & 31), h = lane >> 5;
#pragma unroll
    for (int g = 0; g < 2; ++g) { const int m = 32 * qm + 8 * g + 4 * h; const int mp = (m & ~0x1c) | ((m & 0xc) << 1) | ((m & 0x10) >> 2);
        uint4 w; w.x = pack2(a[4 * g], a[4 * g + 1]); w.y = pack2(a[4 * g + 2], a[4 * g + 3]); w.z = pack2(a[4 * g + 8], a[4 * g + 9]); w.w = pack2(a[4 * g + 10], a[4 * g + 11]);
        *(uint4*)(gimg + n * 64 + mp) = w; }
}
DI void st_sc(char* img, const f32x16& a, int qm, int qn, int lane) {
    const int n = 32 * qn + (lane & 31), h = lane >> 5;
#pragma unroll
    for (int e = 0; e < 16; ++e) { const int m = 32 * qm + (e & 3) + 8 * (e >> 2) + 4 * h; *(u16*)(img + swz(m, n >> 3) + (n & 7) * 2) = f2bf(a[e]); }
}
DI f32x16 ld_nat(const char* img, int qm, int qn, int lane) {
    const int n = 32 * qn + (lane & 31), h = lane >> 5; f32x16 a;
#pragma unroll
    for (int g = 0; g < 4; ++g) { const int m = 32 * qm + 8 * g + 4 * h; const uint2 w = *(const uint2*)(img + swz(n, m >> 3) + (m & 7) * 2);
        a[4 * g] = bflo(w.x); a[4 * g + 1] = bfhi(w.x); a[4 * g + 2] = bflo(w.y); a[4 * g + 3] = bfhi(w.y); }
    return a;
}
DI void ld_cur_prev8(const Params& p, int row, int col, int mode, int sb, float* cur, float* prev) {
    const u16* proj = (const u16*)(p.ws + W_PROJ);
    unpack8(*(const uint4*)(proj + (size_t)row * NC + col), cur);
    if (mode == 0) unpack8(*(const uint4*)(proj + (size_t)(row - 1) * NC + col), prev);
    else if (mode == 1) { for (int i = 0; i < 8; ++i) prev[i] = 0.f; }
    else { const float* s = p.st_shift + (size_t)sb * 1664 + (col - C_R); const float4 a = *(const float4*)s, b = *(const float4*)(s + 4);
        prev[0] = a.x; prev[1] = a.y; prev[2] = a.z; prev[3] = a.w; prev[4] = b.x; prev[5] = b.y; prev[6] = b.z; prev[7] = b.w; }
}
DI float ld_prev1(const Params& p, int row, int col, int mode, int sb) {
    const u16* proj = (const u16*)(p.ws + W_PROJ);
    if (mode == 0) return bf2f(proj[(size_t)(row - 1) * NC + col]);
    if (mode == 1) return 0.f;
    return p.st_shift[(size_t)sb * 1664 + (col - C_R)];
}

DI void phase_rwkv_prep(const Params& p, char* lds) {
    const u16* proj = (const u16*)(p.ws + W_PROJ);
    char* R0 = lds; char* R1 = lds + 8192; char* R2 = lds + 2 * 8192; char* R3 = lds + 3 * 8192; char* R4 = lds + 4 * 8192; char* R5 = lds + 5 * 8192;
    char* R6 = lds + 6 * 8192; char* R7 = lds + 7 * 8192; char* R8 = lds + 8 * 8192;
    float* tot = (float*)(lds + 9 * 8192); float* gam = tot + 256;
    for (int u = blockIdx.x; u < NUNIT; u += gridDim.x) {
        int tid = threadIdx.x; asm volatile("" : "+v"(tid));
        const int lane = tid & 63, wave = __builtin_amdgcn_readfirstlane(tid >> 6); const int qm = wave >> 1, qn = wave & 1; const int r = lane & 31, h5 = lane >> 5;
        int b, h, c, row0, ntok; bool prm = u < 2048;
        if (prm) { b = u >> 10; h = (u >> 7) & 7; c = u & 127; row0 = b * 8192 + c * 64; ntok = 64; }
        else { const int s = u - 2048; b = s >> 3; h = s & 7; c = 0; row0 = NTP + b * 16; ntok = 16; }
        const int mode0 = prm ? (c > 0 ? 0 : 1) : 2;
        uint4 wr_[2], wk_[2], wv_[2];
#pragma unroll
        for (int i = 0; i < 2; ++i) { wr_[i] = (uint4){0, 0, 0, 0}; wk_[i] = wr_[i]; wv_[i] = wr_[i];
            if (16 * wave < ntok) { const u16* src = proj + (size_t)(row0 + 16 * wave + 8 * i + (lane >> 3)) * NC + h * 64 + 8 * (lane & 7);
                wr_[i] = *(const uint4*)(src + C_R); wk_[i] = *(const uint4*)(src + C_RK); wv_[i] = *(const uint4*)(src + C_RV); } }
        {
            const int t = tid >> 2, q = tid & 3;
#pragma unroll
            for (int half = 0; half < 2; ++half) {
                const int cw = q * 16 + half * 8;
                uint4 ow = {0, 0, 0, 0}, oa = {0, 0, 0, 0};
                if (t < ntok) {
                    const int mode = t > 0 ? 0 : mode0; float cur[8], prv[8], xw[8], xa[8];
                    ld_cur_prev8(p, row0 + t, C_WD + cw, mode, b, cur, prv);
                    { const float4 ma = *(const float4*)(p.mix + 1536 + cw), mb = *(const float4*)(p.mix + 1540 + cw); const float mx_[8] = {ma.x, ma.y, ma.z, ma.w, mb.x, mb.y, mb.z, mb.w};
#pragma unroll
                    for (int i = 0; i < 8; ++i) { const float x = cur[i] + (prv[i] - cur[i]) * mx_[i]; const float e2 = __expf(2.f * x); xw[i] = 1.f - 2.f * rcpf_(e2 + 1.f); } }
                    ld_cur_prev8(p, row0 + t, C_AD + cw, mode, b, cur, prv);
                    { const float4 ma = *(const float4*)(p.mix + 1600 + cw), mb = *(const float4*)(p.mix + 1604 + cw); const float mx_[8] = {ma.x, ma.y, ma.z, ma.w, mb.x, mb.y, mb.z, mb.w};
#pragma unroll
                    for (int i = 0; i < 8; ++i) xa[i] = cur[i] + (prv[i] - cur[i]) * mx_[i]; }
                    ow.x = pack2(xw[0], xw[1]); ow.y = pack2(xw[2], xw[3]); ow.z = pack2(xw[4], xw[5]); ow.w = pack2(xw[6], xw[7]);
                    oa.x = pack2(xa[0], xa[1]); oa.y = pack2(xa[2], xa[3]); oa.z = pack2(xa[4], xa[5]); oa.w = pack2(xa[6], xa[7]);
                }
                *(uint4*)(R0 + swz(t, 2 * q + half)) = ow; *(uint4*)(R1 + swz(t, 2 * q + half)) = oa;
            }
        }
        __syncthreads();
        {
            f32x16 adw, ada;
#pragma unroll
            for (int e = 0; e < 16; ++e) { adw[e] = 0.f; ada[e] = 0.f; }
            const u16* wup = (const u16*)(p.ws + W_WUPT) + (size_t)(h * 64 + 32 * qn + r) * 64; const u16* aup = (const u16*)(p.ws + W_AUPT) + (size_t)(h * 64 + 32 * qn + r) * 64;
#pragma unroll
            for (int ks = 0; ks < 4; ++ks) {
                const bf16x8 xa = *(const bf16x8*)(R0 + swz(32 * qm + r, 2 * ks + h5)); const bf16x8 xb = *(const bf16x8*)(R1 + swz(32 * qm + r, 2 * ks + h5));
                const bf16x8 ya = *(const bf16x8*)(wup + 16 * ks + 8 * h5); const bf16x8 yb = *(const bf16x8*)(aup + 16 * ks + 8 * h5);
                adw = __builtin_amdgcn_mfma_f32_32x32x16_bf16(xa, ya, adw, 0, 0, 0); ada = __builtin_amdgcn_mfma_f32_32x32x16_bf16(xb, yb, ada, 0, 0, 0);
            }
            float* DW = (float*)R4; float* DA = (float*)R6; const int n = 32 * qn + r;
#pragma unroll
            for (int e = 0; e < 16; ++e) { const int m = 32 * qm + (e & 3) + 8 * (e >> 2) + 4 * h5; DW[m * 64 + n] = adw[e]; DA[m * 64 + n] = ada[e]; }
        }
        __syncthreads();
        {
            const int tg = wave, j = lane, hj = h * 64 + j;
            float* DW = (float*)R4; const float* DA = (const float*)R6;
            { const float w0j = p.w0[hj];
                float run = 0.f;
#pragma unroll 4
                for (int i = 0; i < 16; ++i) { const int t = 16 * tg + i; const float x = w0j + DW[t * 64 + j];
                    const float z = -x; const float sp = fmaxf(z, 0.f) + __logf(1.f + __expf(-fabsf(z))); float l = -__expf(-sp - 0.5f); if (t >= ntok) l = 0.f; DW[t * 64 + j] = l; run += l; }
                tot[tg * 64 + j] = run;
            }
            __syncthreads();
            float prefix = 0.f, ctot = 0.f;
#pragma unroll
            for (int g = 0; g < 4; ++g) { const float v = tot[g * 64 + j]; if (g < tg) prefix += v; ctot += v; }
            if (tg == 0) gam[j] = __expf(ctot);
            const float a0j = p.a0[hj], kkj = p.k_k[hj], kaj = p.k_a[hj], rkj = p.r_k[hj];
            const float mr = p.mix[hj], mk = p.mix[512 + hj], mv = p.mix[1024 + hj];
            float* bonus = (float*)(p.ws + W_BONUS);
            float mybon = 0.f;
            u16 gcr[16], gck[16], gcv[16];
            { char* tb = R8 + wave * 2048; char* wp = tb + (lane >> 3) * 128 + (lane & 7) * 16; const char* rp = tb + lane * 2;
#define XPOSE16(W, OUT) do { asm volatile("s_waitcnt lgkmcnt(0)" ::: "memory"); *(uint4*)wp = W[0]; *(uint4*)(wp + 1024) = W[1]; asm volatile("s_waitcnt lgkmcnt(0)" ::: "memory"); \
                    _Pragma("unroll") for (int tt = 0; tt < 16; ++tt) OUT[tt] = *(const u16*)(rp + tt * 128); } while (0)
                XPOSE16(wr_, gcr); XPOSE16(wk_, gck); XPOSE16(wv_, gcv);
#undef XPOSE16
            }
            float pr = 0.f, pk = 0.f, pv = 0.f;
            { const int t0 = 16 * tg; if (t0 < ntok) { const int mode = t0 > 0 ? 0 : mode0; pr = ld_prev1(p, row0 + t0, C_R + hj, mode, b); pk = ld_prev1(p, row0 + t0, C_RK + hj, mode, b); pv = ld_prev1(p, row0 + t0, C_RV + hj, mode, b); } }
            float ecl = __expf(prefix); const float etot = __expf(ctot);
            unsigned pAt[8], pV[8], pKb[8], pBb[8]; float hAt = 0.f, hV = 0.f, hKb = 0.f, hBb = 0.f;
#pragma unroll
            for (int i = 0; i < 16; ++i) {
                const int t = 16 * tg + i; const bool valid = t < ntok;
                float xr = 0.f, xk = 0.f, xv = 0.f;
                if (valid) { const float cr = bf2f(gcr[i]), ck = bf2f(gck[i]), cv = bf2f(gcv[i]);
                    xr = cr + (pr - cr) * mr; xk = ck + (pk - ck) * mk; xv = cv + (pv - cv) * mv; pr = cr; pk = ck; pv = cv; }
                const float a = rcpf_(1.f + __expf(-(a0j + DA[t * 64 + j])));
                const float kx = xk * kkj; const float ss = wave_sum(kx * kx); const float kk = kx * __builtin_amdgcn_rsqf(fmaxf(ss, 1e-24f));
                const float kmod = xk * (1.f + (a - 1.f) * kaj);
                const float bon = wave_sum(xr * kmod * rkj);
                if (lane == i) mybon = bon;
                const float e_ce = ecl; ecl *= __expf(DW[t * 64 + j]);
                const float e_cl = ecl, e_n = rcpf_(ecl), e_t = etot * e_n;
                const float vAt = -kk * e_ce, vRt = xr * e_cl, vBt = kk * a * e_n, vKt = kmod * e_n, vBb = kk * a * e_t, vKb = kmod * e_t;
                const int so = swz(t, j >> 3) + (j & 7) * 2;
                *(u16*)(R0 + so) = f2bf(vAt); *(u16*)(R1 + so) = f2bf(vRt); *(u16*)(R2 + so) = f2bf(vBt); *(u16*)(R3 + so) = f2bf(vKt);
                if (i & 1) { pAt[i >> 1] = pack2(hAt, vAt); pV[i >> 1] = pack2(hV, xv); pKb[i >> 1] = pack2(hKb, vKb); pBb[i >> 1] = pack2(hBb, vBb); }
                else { hAt = vAt; hV = xv; hKb = vKb; hBb = vBb; }
            }
            if (lane < 16) bonus[(size_t)u * 64 + 16 * tg + lane] = mybon;
            __syncthreads();
#pragma unroll
            for (int half = 0; half < 2; ++half) { const int o = swz(j, 2 * tg + half);
                *(uint4*)(R4 + o) = (uint4){pAt[4 * half], pAt[4 * half + 1], pAt[4 * half + 2], pAt[4 * half + 3]};
                *(uint4*)(R5 + o) = (uint4){pV[4 * half], pV[4 * half + 1], pV[4 * half + 2], pV[4 * half + 3]};
                *(uint4*)(R6 + o) = (uint4){pKb[4 * half], pKb[4 * half + 1], pKb[4 * half + 2], pKb[4 * half + 3]};
                *(uint4*)(R7 + o) = (uint4){pBb[4 * half], pBb[4 * half + 1], pBb[4 * half + 2], pBb[4 * half + 3]}; }
        }
        __syncthreads();
        f32x16 z16;
#pragma unroll
        for (int e = 0; e < 16; ++e) z16[e] = 0.f;
        f32x16 aN = mmq(R2, R0, qm, qn, z16, lane);
        f32x16 aKa = mmq(R3, R0, qm, qn, z16, lane);
        f32x16 aW1 = mmq(R2, R1, qm, qn, z16, lane);
        f32x16 aKr = mmq(R3, R1, qm, qn, z16, lane);
        {
            const int n = 32 * qn + r;
#pragma unroll
            for (int e = 0; e < 16; ++e) { const int m = 32 * qm + (e & 3) + 8 * (e >> 2) + 4 * h5;
                if (!(m < n)) { aN[e] = 0.f; aKa[e] = 0.f; } if (!(m <= n)) { aW1[e] = 0.f; aKr[e] = 0.f; } }
        }
        f32x16 aW2 = ld_nat(R7, qm, qn, lane);
        __syncthreads();
        st_sc(R0, aN, qm, qn, lane);
        st_nat(R2, aN, qm, qn, lane);
        st_sc(R3, aKa, qm, qn, lane);
        st_nat(R8, aW1, qm, qn, lane);
        __syncthreads();
        for (int it = 0; it < 6; ++it) {
            aW1 = mmq(R0, R8, qm, qn, aW1, lane);
            aW2 = mmq(R0, R7, qm, qn, aW2, lane);
            if (it < 5) aN = mmq(R0, R2, qm, qn, z16, lane);
            __syncthreads();
            st_nat(R8, aW1, qm, qn, lane); st_nat(R7, aW2, qm, qn, lane);
            if (it < 5) { st_sc(R0, aN, qm, qn, lane); st_nat(R2, aN, qm, qn, lane); }
            __syncthreads();
        }
        {
            f32x16 aG = mmq(R4, R7, qm, qn, z16, lane);
            { const int n = 32 * qn + r; const float gn = gam[n];
#pragma unroll
                for (int e = 0; e < 16; ++e) { const int m = 32 * qm + (e & 3) + 8 * (e >> 2) + 4 * h5; if (m == n) aG[e] += gn; } }
            st_nat_gp((u16*)(p.ws + W_GT) + (size_t)u * 4096, aG, qm, qn, lane);
            f32x16 aQ = ld_nat(R1, qm, qn, lane);
            aQ = mmq(R4, R8, qm, qn, aQ, lane);
            st_nat_gp((u16*)(p.ws + W_QT) + (size_t)u * 4096, aQ, qm, qn, lane);
            f32x16 aP1 = ld_nat(R6, qm, qn, lane);
            aP1 = mmq(R3, R7, qm, qn, aP1, lane);
            aKr = mmq(R3, R8, qm, qn, aKr, lane);
            st_nat(R0, aP1, qm, qn, lane);
            st_nat(R2, aKr, qm, qn, lane);
        }
        __syncthreads();
        {
            f32x16 aH = mmq(R0, R5, qm, qn, z16, lane);
            st_nat_gp((u16*)(p.ws + W_HH) + (size_t)u * 4096, aH, qm, qn, lane);
            f32x16 aY = mmq(R5, R2, qm, qn, z16, lane);
            const int n = 32 * qn + r;

#pragma unroll
            for (int g = 0; g < 4; g += 2) {
                unsigned ax = pack2(aY[4 * g], aY[4 * g + 1]), ay = pack2(aY[4 * g + 2], aY[4 * g + 3]), bx = pack2(aY[4 * g + 4], aY[4 * g + 5]), by = pack2(aY[4 * g + 6], aY[4 * g + 7]);
                { auto rr = __builtin_amdgcn_permlane32_swap(ax, bx, false, false); ax = rr[0]; bx = rr[1]; }
                { auto rr = __builtin_amdgcn_permlane32_swap(ay, by, false, false); ay = rr[0]; by = rr[1]; }
                if (n < ntok) *(uint4*)((u16*)(p.ws + W_XB) + (size_t)(row0 + n) * DM + 512 + h * 64 + 32 * qm + 8 * g + 8 * h5) = (uint4){ax, ay, bx, by};
            }
        }
        __syncthreads();
    }
}

struct ScanSlot { uint4 ga[4][2]; uint4 gh[2]; };
DI void scan_load(ScanSlot& s, const u16* GT, const u16* HH, int u, int irow, int i16, int g) {
    const u16* gt = GT + (size_t)u * 4096; const u16* hh = HH + (size_t)u * 4096 + irow * 64;
#pragma unroll
    for (int mt = 0; mt < 4; ++mt) {
#pragma unroll
        for (int ks = 0; ks < 2; ++ks) s.ga[mt][ks] = *(const uint4*)(gt + (16 * mt + i16) * 64 + 32 * ks + 8 * g);
    }
#pragma unroll
    for (int ks = 0; ks < 2; ++ks) s.gh[ks] = *(const uint4*)(hh + 32 * ks + 8 * g);
}
DI void scan_step(const ScanSlot& s, f32x4 (&acc)[4], u16* sst, int irow, int g) {
    unsigned pk[4][2];
#pragma unroll
    for (int mt = 0; mt < 4; ++mt) { pk[mt][0] = pack2(acc[mt][0], acc[mt][1]); pk[mt][1] = pack2(acc[mt][2], acc[mt][3]); }
    bf16x8 bfr[2];
#pragma unroll
    for (int ks = 0; ks < 2; ++ks) { uint4 w = {pk[2 * ks][0], pk[2 * ks][1], pk[2 * ks + 1][0], pk[2 * ks + 1][1]}; bfr[ks] = __builtin_bit_cast(bf16x8, w);
        *(uint4*)(sst + irow * 64 + 32 * ks + 8 * g) = w; }
#pragma unroll
    for (int mt = 0; mt < 4; ++mt) {
        const unsigned hx = (mt & 1) ? s.gh[mt >> 1].z : s.gh[mt >> 1].x, hy = (mt & 1) ? s.gh[mt >> 1].w : s.gh[mt >> 1].y;
        f32x4 c = {bflo(hx), bfhi(hx), bflo(hy), bfhi(hy)};
#pragma unroll
        for (int ks = 0; ks < 2; ++ks) c = __builtin_amdgcn_mfma_f32_16x16x32_bf16(__builtin_bit_cast(bf16x8, s.ga[mt][ks]), bfr[ks], c, 0, 0, 0);
        acc[mt] = c;
    }
}
DI void scan_item(const Params& p, int item, int lane) {
    const int i16 = lane & 15, g = lane >> 4;
    const u16* GT = (const u16*)(p.ws + W_GT); const u16* HH = (const u16*)(p.ws + W_HH); u16* SST = (u16*)(p.ws + W_SST);
    f32x4 acc[4];
    if (item < 64) {
        const int bh = item >> 2, iq = item & 3, u0 = bh * 128, irow = 16 * iq + i16;
#pragma unroll
        for (int mt = 0; mt < 4; ++mt) acc[mt] = (f32x4){0.f, 0.f, 0.f, 0.f};
        ScanSlot s0, s1, s2, s3, s4;
        scan_load(s0, GT, HH, u0, irow, i16, g); scan_load(s1, GT, HH, u0 + 1, irow, i16, g); scan_load(s2, GT, HH, u0 + 2, irow, i16, g); scan_load(s3, GT, HH, u0 + 3, irow, i16, g);
        scan_load(s4, GT, HH, u0 + 4, irow, i16, g);
        const int ul = u0 + 127;
#define PINM do { asm volatile("" ::: "memory"); __builtin_amdgcn_sched_barrier(0); } while (0)
        for (int st = 0; st < 125; st += 5) {
            const int u = u0 + st;
            scan_step(s0, acc, SST + (size_t)u * 4096, irow, g);       PINM; scan_load(s0, GT, HH, min(u + 5, ul), irow, i16, g); PINM;
            scan_step(s1, acc, SST + (size_t)(u + 1) * 4096, irow, g); PINM; scan_load(s1, GT, HH, min(u + 6, ul), irow, i16, g); PINM;
            scan_step(s2, acc, SST + (size_t)(u + 2) * 4096, irow, g); PINM; scan_load(s2, GT, HH, min(u + 7, ul), irow, i16, g); PINM;
            scan_step(s3, acc, SST + (size_t)(u + 3) * 4096, irow, g); PINM; scan_load(s3, GT, HH, min(u + 8, ul), irow, i16, g); PINM;
            scan_step(s4, acc, SST + (size_t)(u + 4) * 4096, irow, g); PINM; scan_load(s4, GT, HH, min(u + 9, ul), irow, i16, g); PINM;
        }
        scan_step(s0, acc, SST + (size_t)(u0 + 125) * 4096, irow, g); PINM;
        scan_step(s1, acc, SST + (size_t)(u0 + 126) * 4096, irow, g); PINM;
        scan_step(s2, acc, SST + (size_t)(u0 + 127) * 4096, irow, g);
#undef PINM
        float* fout = p.out + O_SP + (size_t)bh * 4096;
#pragma unroll
        for (int mt = 0; mt < 4; ++mt) *(f32x4*)(fout + irow * 64 + 16 * mt + 4 * g) = acc[mt];
    } else {
        const int s = (item - 64) >> 2, iq = item & 3, u = 2048 + s, irow = 16 * iq + i16;
        const float* st0 = p.st_wkv + (size_t)s * 4096 + irow * 64;
#pragma unroll
        for (int mt = 0; mt < 4; ++mt) acc[mt] = *(const f32x4*)(st0 + 16 * mt + 4 * g);
        ScanSlot s0; scan_load(s0, GT, HH, u, irow, i16, g);
        scan_step(s0, acc, SST + (size_t)u * 4096, irow, g);
        float* fout = p.out + O_SS + (size_t)s * 4096;
#pragma unroll
        for (int mt = 0; mt < 4; ++mt) *(f32x4*)(fout + irow * 64 + 16 * mt + 4 * g) = acc[mt];
    }
}

DI s16x4 tr16(const char* p) { return __builtin_bit_cast(s16x4, __builtin_amdgcn_ds_read_tr16_b64_v4i16((__attribute__((address_space(3))) s16x4*)p)); }

DI void attn_tile(const char* sk, const char* sv, const float* tab, const bf16x8& qf0, const bf16x8& qf1, float& m, float& l, f32x4 (&o)[4], int qpos, int dlt, int nvalid, int lane) {
    const int q = lane & 15, g = lane >> 4;
    const float C2 = 0.125f * LOG2E;
    f32x4 sc[4];
#pragma unroll
    for (int kt = 0; kt < 4; ++kt) {
        const bf16x8 a0 = *(const bf16x8*)(sk + swz(16 * kt + q, g)); const bf16x8 a1 = *(const bf16x8*)(sk + swz(16 * kt + q, 4 + g));
        f32x4 s = {0.f, 0.f, 0.f, 0.f};
        s = __builtin_amdgcn_mfma_f32_16x16x32_bf16(a0, qf0, s, 0, 0, 0); s = __builtin_amdgcn_mfma_f32_16x16x32_bf16(a1, qf1, s, 0, 0, 0);
        sc[kt] = s;
    }
    float mx = -INFINITY;
    if (dlt >= 3) {
        const float bc = tab[256];
#pragma unroll
        for (int kt = 0; kt < 4; ++kt)
#pragma unroll
            for (int e = 0; e < 4; ++e) { const float s = sc[kt][e] * C2 + bc; sc[kt][e] = s; mx = fmaxf(mx, s); }
    } else {
#pragma unroll
        for (int kt = 0; kt < 4; ++kt)
#pragma unroll
            for (int e = 0; e < 4; ++e) { const int key = 16 * kt + 4 * g + e; int rel = qpos - key + dlt * 64; rel = rel < -128 ? -128 : (rel > 128 ? 128 : rel);
                float s = sc[kt][e] * C2 + tab[rel + 128]; if (key >= nvalid) s = -INFINITY; sc[kt][e] = s; mx = fmaxf(mx, s); }
    }
    mx = xmax16(mx); mx = xmax32(mx);
    const float mn = fmaxf(m, mx); const float alpha = __builtin_amdgcn_exp2f(m - mn); m = mn;
    float ps = 0.f;
#pragma unroll
    for (int kt = 0; kt < 4; ++kt)
#pragma unroll
        for (int e = 0; e < 4; ++e) { const float pe = __builtin_amdgcn_exp2f(sc[kt][e] - mn); sc[kt][e] = pe; ps += pe; }
    l = l * alpha + ps;
#pragma unroll
    for (int dt = 0; dt < 4; ++dt) o[dt] *= alpha;
    bf16x8 pf[2];
#pragma unroll
    for (int ks = 0; ks < 2; ++ks) { uint4 w = {pack2(sc[2 * ks][0], sc[2 * ks][1]), pack2(sc[2 * ks][2], sc[2 * ks][3]), pack2(sc[2 * ks + 1][0], sc[2 * ks + 1][1]), pack2(sc[2 * ks + 1][2], sc[2 * ks + 1][3])};
        pf[ks] = __builtin_bit_cast(bf16x8, w); }
#pragma unroll
    for (int dt = 0; dt < 4; ++dt)
#pragma unroll
        for (int ks = 0; ks < 2; ++ks) {
            const int vr = 32 * ks + 4 * g + (q >> 2); const int col = 16 * dt + 4 * (q & 3);
            const s16x4 lo = tr16(sv + swz(vr, col >> 3) + (col & 7) * 2); const s16x4 hi = tr16(sv + swz(vr + 16, col >> 3) + (col & 7) * 2);
            const bf16x8 vf = {lo[0], lo[1], lo[2], lo[3], hi[0], hi[1], hi[2], hi[3]};
            o[dt] = __builtin_amdgcn_mfma_f32_16x16x32_bf16(vf, pf[ks], o[dt], 0, 0, 0);
        }
}
DI void attn_finish(const Params& p, float l, const f32x4 (&o)[4], int qrow, int h, int lane) {
    const int g = lane >> 4; const u16* proj = (const u16*)(p.ws + W_PROJ);
    l = xadd16(l); l = xadd32(l);
    const float inv = rcpf_(l);
    u16* z = (u16*)(p.ws + W_XB) + (size_t)qrow * DM + h * 64; const u16* ga = proj + (size_t)qrow * NC + C_GA + h * 64;
    uint2 w[4];
#pragma unroll
    for (int dt = 0; dt < 4; ++dt) { const int d = 16 * dt + 4 * g; const uint2 gg = *(const uint2*)(ga + d);
        w[dt].x = pack2(o[dt][0] * inv * silu(bflo(gg.x)), o[dt][1] * inv * silu(bfhi(gg.x))); w[dt].y = pack2(o[dt][2] * inv * silu(bflo(gg.y)), o[dt][3] * inv * silu(bfhi(gg.y))); }
#pragma unroll
    for (int dt = 0; dt < 4; dt += 2) *(uint4*)(z + 16 * (dt + (g & 1)) + 8 * (g >> 1)) = widen16(w[dt], w[dt + 1]);
}
DI void attn_block(const Params& p, int u, char* lds) {
    int tid = threadIdx.x; asm volatile("" : "+v"(tid));
    const int lane = tid & 63, wave = __builtin_amdgcn_readfirstlane(tid >> 6);
    const u16* proj = (const u16*)(p.ws + W_PROJ);
    const int b = u >> 10, h = (u >> 7) & 7, c = u & 127; const int qrow = b * 8192 + c * 64 + wave * 16 + (lane & 15); const int ndl = c < 8 ? c : 8;
    float* tab = (float*)(lds + 49152);
    __syncthreads();
    for (int i = tid; i < 257; i += 256) tab[i] = p.relb[h * 257 + i] * LOG2E;
    const u16* qp = proj + (size_t)qrow * NC + C_Q + h * 64 + 8 * (lane >> 4);
    const bf16x8 qf0 = *(const bf16x8*)qp, qf1 = *(const bf16x8*)(qp + 32);
    float m = -INFINITY, l = 0.f; f32x4 o[4];
#pragma unroll
    for (int dt = 0; dt < 4; ++dt) o[dt] = (f32x4){0.f, 0.f, 0.f, 0.f};
    unsigned soff[2];
#pragma unroll
    for (int i = 0; i < 2; ++i) { const int row = 8 * (i * 4 + wave) + (lane >> 3); const int ch = (lane & 7) ^ ((row >> 1) & 7); soff[i] = (unsigned)(row * NC + ch * 8); }
    const u16* kbase = proj + (size_t)(b * 8192) * NC + h * 64;
#define ASTAGE(buf, dl) do { const u16* kr = kbase + (size_t)((c - (dl)) * 64) * NC; _Pragma("unroll") for (int i = 0; i < 2; ++i) { \
        __builtin_amdgcn_global_load_lds((const unsigned*)(kr + soff[i] + C_K), (LAS unsigned*)(lds + (buf) * 8192 + (i * 4 + wave) * 1024), 16, 0, 0); \
        __builtin_amdgcn_global_load_lds((const unsigned*)(kr + soff[i] + C_V), (LAS unsigned*)(lds + 24576 + (buf) * 8192 + (i * 4 + wave) * 1024), 16, 0, 0); } } while (0)
    __syncthreads();
    ASTAGE(0, ndl); if (ndl >= 1) ASTAGE(1, ndl - 1);
    int buf = 0;
    for (int dlt = ndl; dlt >= 0; --dlt) {
        if (dlt >= 1) asm volatile("s_waitcnt vmcnt(4) lgkmcnt(0)" ::: "memory"); else asm volatile("s_waitcnt vmcnt(0) lgkmcnt(0)" ::: "memory");
        __builtin_amdgcn_s_barrier();
        asm volatile("" ::: "memory");
        const int nb2 = buf >= 1 ? buf - 1 : 2;
        if (dlt >= 2) ASTAGE(nb2, dlt - 2);
        attn_tile(lds + buf * 8192, lds + 24576 + buf * 8192, tab, qf0, qf1, m, l, o, wave * 16 + (lane & 15), dlt, 64, lane);
        buf = buf == 2 ? 0 : buf + 1;
    }
#undef ASTAGE
    attn_finish(p, l, o, qrow, h, lane);
}
struct QG { bf16x8 q0, q1; float m, l; f32x4 o[4]; };
DI void attn_softmax(f32x4 (&sc)[4], const float* tab, QG& G, int qpos, int dlt, int g, bf16x8 (&pf)[2]) {
    const float C2 = 0.125f * LOG2E;
    float mx = -INFINITY;
    if (dlt >= 3) {
        const float bc = tab[256];
#pragma unroll
        for (int kt = 0; kt < 4; ++kt)
#pragma unroll
            for (int e = 0; e < 4; ++e) { const float s = sc[kt][e] * C2 + bc; sc[kt][e] = s; mx = fmaxf(mx, s); }
    } else {
#pragma unroll
        for (int kt = 0; kt < 4; ++kt)
#pragma unroll
            for (int e = 0; e < 4; ++e) { const int key = 16 * kt + 4 * g + e; int rel = qpos - key + dlt * 64; rel = rel < -128 ? -128 : (rel > 128 ? 128 : rel);
                const float s = sc[kt][e] * C2 + tab[rel + 128]; sc[kt][e] = s; mx = fmaxf(mx, s); }
    }
    mx = xmax16(mx); mx = xmax32(mx);
    const float mn = fmaxf(G.m, mx); const float alpha = __builtin_amdgcn_exp2f(G.m - mn); G.m = mn;
    float ps = 0.f;
#pragma unroll
    for (int kt = 0; kt < 4; ++kt)
#pragma unroll
        for (int e = 0; e < 4; ++e) { const float pe = __builtin_amdgcn_exp2f(sc[kt][e] - mn); sc[kt][e] = pe; ps += pe; }
    G.l = G.l * alpha + ps;
#pragma unroll
    for (int dt = 0; dt < 4; ++dt) G.o[dt] *= alpha;
#pragma unroll
    for (int ks = 0; ks < 2; ++ks) { uint4 w = {pack2(sc[2 * ks][0], sc[2 * ks][1]), pack2(sc[2 * ks][2], sc[2 * ks][3]), pack2(sc[2 * ks + 1][0], sc[2 * ks + 1][1]), pack2(sc[2 * ks + 1][2], sc[2 * ks + 1][3])};
        pf[ks] = __builtin_bit_cast(bf16x8, w); }
}
DI void attn_tile2(const char* sk, const char* sv, const float* tab, QG& A, QG& B, int qposA, int dlt, int lane) {
    const int q = lane & 15, g = lane >> 4;
    f32x4 sa[4], sb[4];
#pragma unroll
    for (int kt = 0; kt < 4; ++kt) {
        const bf16x8 a0 = *(const bf16x8*)(sk + swz(16 * kt + q, g)); const bf16x8 a1 = *(const bf16x8*)(sk + swz(16 * kt + q, 4 + g));
        f32x4 x = {0.f, 0.f, 0.f, 0.f}, y = {0.f, 0.f, 0.f, 0.f};
        x = __builtin_amdgcn_mfma_f32_16x16x32_bf16(a0, A.q0, x, 0, 0, 0); y = __builtin_amdgcn_mfma_f32_16x16x32_bf16(a0, B.q0, y, 0, 0, 0);
        x = __builtin_amdgcn_mfma_f32_16x16x32_bf16(a1, A.q1, x, 0, 0, 0); y = __builtin_amdgcn_mfma_f32_16x16x32_bf16(a1, B.q1, y, 0, 0, 0);
        sa[kt] = x; sb[kt] = y;
    }
    bf16x8 pa[2], pb[2];
    attn_softmax(sa, tab, A, qposA, dlt, g, pa);
    attn_softmax(sb, tab, B, qposA + 16, dlt, g, pb);
#pragma unroll
    for (int dt = 0; dt < 4; ++dt)
#pragma unroll
        for (int ks = 0; ks < 2; ++ks) {
            const int vr = 32 * ks + 4 * g + (q >> 2); const int col = 16 * dt + 4 * (q & 3);
            const s16x4 lo = tr16(sv + swz(vr, col >> 3) + (col & 7) * 2); const s16x4 hi = tr16(sv + swz(vr + 16, col >> 3) + (col & 7) * 2);
            const bf16x8 vf = {lo[0], lo[1], lo[2], lo[3], hi[0], hi[1], hi[2], hi[3]};
            A.o[dt] = __builtin_amdgcn_mfma_f32_16x16x32_bf16(vf, pa[ks], A.o[dt], 0, 0, 0);
            B.o[dt] = __builtin_amdgcn_mfma_f32_16x16x32_bf16(vf, pb[ks], B.o[dt], 0, 0, 0);
        }
}
DI void attn_block2(const Params& p, int bh, int cp, char* lds) {
    int tid = threadIdx.x; asm volatile("" : "+v"(tid));
    const int lane = tid & 63, wave = __builtin_amdgcn_readfirstlane(tid >> 6);
    const u16* proj = (const u16*)(p.ws + W_PROJ);
    const int b = bh >> 3, h = bh & 7, c0 = 2 * cp, cq = c0 + (wave >> 1);
    const int qposA = (wave & 1) * 32 + (lane & 15); const int qrowA = b * 8192 + cq * 64 + qposA;
    float* tab = (float*)(lds + 49152);
    __syncthreads();
    for (int i = tid; i < 257; i += 256) tab[i] = p.relb[h * 257 + i] * LOG2E;
    QG A, B;
    { const u16* qp = proj + (size_t)qrowA * NC + C_Q + h * 64 + 8 * (lane >> 4); A.q0 = *(const bf16x8*)qp; A.q1 = *(const bf16x8*)(qp + 32);
      const u16* qb = qp + (size_t)16 * NC; B.q0 = *(const bf16x8*)qb; B.q1 = *(const bf16x8*)(qb + 32); }
    A.m = -INFINITY; A.l = 0.f; B.m = -INFINITY; B.l = 0.f;
#pragma unroll
    for (int dt = 0; dt < 4; ++dt) { A.o[dt] = (f32x4){0.f, 0.f, 0.f, 0.f}; B.o[dt] = (f32x4){0.f, 0.f, 0.f, 0.f}; }
    unsigned soff[2];
#pragma unroll
    for (int i = 0; i < 2; ++i) { const int row = 8 * (i * 4 + wave) + (lane >> 3); const int ch = (lane & 7) ^ ((row >> 1) & 7); soff[i] = (unsigned)(row * NC + ch * 8); }
    const u16* kbase = proj + (size_t)(b * 8192) * NC + h * 64;
#define ASTAGE2(buf, kc) do { const u16* kr = kbase + (size_t)((kc) * 64) * NC; _Pragma("unroll") for (int i = 0; i < 2; ++i) { \
        __builtin_amdgcn_global_load_lds((const unsigned*)(kr + soff[i] + C_K), (LAS unsigned*)(lds + (buf) * 8192 + (i * 4 + wave) * 1024), 16, 0, 0); \
        __builtin_amdgcn_global_load_lds((const unsigned*)(kr + soff[i] + C_V), (LAS unsigned*)(lds + 24576 + (buf) * 8192 + (i * 4 + wave) * 1024), 16, 0, 0); } } while (0)
    const int lo = c0 >= 8 ? c0 - 8 : 0, hi = c0 + 1;
    __syncthreads();
    ASTAGE2(0, lo); ASTAGE2(1, lo + 1);
    int buf = 0;
    for (int kc = lo; kc <= hi; ++kc) {
        if (kc < hi) asm volatile("s_waitcnt vmcnt(4) lgkmcnt(0)" ::: "memory"); else asm volatile("s_waitcnt vmcnt(0) lgkmcnt(0)" ::: "memory");
        __builtin_amdgcn_s_barrier();
        asm volatile("" ::: "memory");
        const int nb2 = buf >= 1 ? buf - 1 : 2;
        if (kc + 2 <= hi) ASTAGE2(nb2, kc + 2);
        const int dlt = cq - kc;
        if (dlt >= 0 && dlt <= 8) attn_tile2(lds + buf * 8192, lds + 24576 + buf * 8192, tab, A, B, qposA, dlt, lane);
        buf = buf == 2 ? 0 : buf + 1;
    }
#undef ASTAGE2
    attn_finish(p, A.l, A.o, qrowA, h, lane);
    attn_finish(p, B.l, B.o, qrowA + 16, h, lane);
}

DI void attn_block_sample(const Params& p, int s, char* lds) {
    int tid = threadIdx.x; asm volatile("" : "+v"(tid));
    const int lane = tid & 63, wave = __builtin_amdgcn_readfirstlane(tid >> 6);
    char* wl = lds + wave * 18432;
    char* sk = wl; char* sv = wl + 8192; float* tab = (float*)(wl + 16384);
    const u16* proj = (const u16*)(p.ws + W_PROJ);
    const int b = s >> 3, h = s & 7; const int qrow0 = NTP + b * 16;
    for (int i = lane; i < 257; i += 64) tab[i] = p.relb[h * 257 + i] * LOG2E;
    const int q = lane & 15, g = lane >> 4;
    const u16* qp = proj + (size_t)(qrow0 + q) * NC + C_Q + h * 64 + 8 * g;
    const bf16x8 qf0 = *(const bf16x8*)qp, qf1 = *(const bf16x8*)(qp + 32);
    float m = -INFINITY, l = 0.f; f32x4 o[4];
#pragma unroll
    for (int dt = 0; dt < 4; ++dt) o[dt] = (f32x4){0.f, 0.f, 0.f, 0.f};
    const int lrow = lane >> 3, lch = lane & 7;
    float4 rk[16], rv[16];
#define SLOAD(dl) do { const size_t off_ = ((size_t)(b * 8 + h) * 512 + (8 - (dl)) * 64) * 64 + lrow * 64 + lch * 8; \
        _Pragma("unroll") for (int i = 0; i < 8; ++i) { const float* a_ = p.cache_k + off_ + i * 512; const float* c_ = p.cache_v + off_ + i * 512; \
            rk[2 * i] = *(const float4*)a_; rk[2 * i + 1] = *(const float4*)(a_ + 4); rv[2 * i] = *(const float4*)c_; rv[2 * i + 1] = *(const float4*)(c_ + 4); } } while (0)
#define SWRITE() do { _Pragma("unroll") for (int i = 0; i < 8; ++i) { const int row = i * 8 + lrow; \
            uint4 kv = {pack2(rk[2 * i].x, rk[2 * i].y), pack2(rk[2 * i].z, rk[2 * i].w), pack2(rk[2 * i + 1].x, rk[2 * i + 1].y), pack2(rk[2 * i + 1].z, rk[2 * i + 1].w)}; \
            uint4 vv = {pack2(rv[2 * i].x, rv[2 * i].y), pack2(rv[2 * i].z, rv[2 * i].w), pack2(rv[2 * i + 1].x, rv[2 * i + 1].y), pack2(rv[2 * i + 1].z, rv[2 * i + 1].w)}; \
            *(uint4*)(sk + swz(row, lch)) = kv; *(uint4*)(sv + swz(row, lch)) = vv; } } while (0)
    const int d0 = 8 - 2 * wave;
    SLOAD(d0);
    asm volatile("s_waitcnt lgkmcnt(0)" ::: "memory");
    SWRITE();
    SLOAD(d0 - 1);
    asm volatile("s_waitcnt lgkmcnt(0)" ::: "memory");
    attn_tile(sk, sv, tab, qf0, qf1, m, l, o, q, d0, 64, lane);
    asm volatile("s_waitcnt lgkmcnt(0)" ::: "memory");
    SWRITE();
    asm volatile("s_waitcnt lgkmcnt(0)" ::: "memory");
    attn_tile(sk, sv, tab, qf0, qf1, m, l, o, q, d0 - 1, 64, lane);
#undef SLOAD
#undef SWRITE
    if (wave == 3) {
        asm volatile("s_waitcnt lgkmcnt(0)" ::: "memory");
#pragma unroll
        for (int i = 0; i < 8; ++i) { const int row = i * 8 + lrow; uint4 kv = {0, 0, 0, 0}, vv = {0, 0, 0, 0};
            if (row < 16) { const u16* sp = proj + (size_t)(qrow0 + row) * NC + h * 64 + lch * 8; kv = *(const uint4*)(sp + C_K); vv = *(const uint4*)(sp + C_V); }
            *(uint4*)(sk + swz(row, lch)) = kv; *(uint4*)(sv + swz(row, lch)) = vv; }
        asm volatile("s_waitcnt lgkmcnt(0)" ::: "memory");
        attn_tile(sk, sv, tab, qf0, qf1, m, l, o, q, 0, 16, lane);
    }
    l = xadd16(l); l = xadd32(l);
    asm volatile("s_waitcnt lgkmcnt(0)" ::: "memory");
    float* cm = (float*)wl; float* cl = cm + 16; float* co = cm + 32;
    if (g == 0) { cm[q] = m; cl[q] = l; }
#pragma unroll
    for (int dt = 0; dt < 4; ++dt) *(f32x4*)(co + q * 64 + 16 * dt + 4 * g) = o[dt];
    __syncthreads();
    {
        float mw[4], M = -INFINITY;
#pragma unroll
        for (int w = 0; w < 4; ++w) { mw[w] = ((const float*)(lds + w * 18432))[q]; M = fmaxf(M, mw[w]); }
        float L = 0.f; f32x4 O = {0.f, 0.f, 0.f, 0.f};
#pragma unroll
        for (int w = 0; w < 4; ++w) { const float* base = (const float*)(lds + w * 18432); const float f = __builtin_amdgcn_exp2f(mw[w] - M);
            L += base[16 + q] * f; const f32x4 ov = *(const f32x4*)(base + 32 + q * 64 + 16 * wave + 4 * g); O += ov * f; }
        const float inv = rcpf_(L); const int qrow = qrow0 + q; const int d = 16 * wave + 4 * g;
        const uint2 gg = *(const uint2*)(proj + (size_t)qrow * NC + C_GA + h * 64 + d);
        uint2 w2; w2.x = pack2(O[0] * inv * silu(bflo(gg.x)), O[1] * inv * silu(bfhi(gg.x))); w2.y = pack2(O[2] * inv * silu(bflo(gg.y)), O[3] * inv * silu(bfhi(gg.y)));
        *(uint2*)((u16*)(p.ws + W_XB) + (size_t)qrow * DM + h * 64 + d) = w2;
    }
    __syncthreads();
}

DI void phase_scan_attn(const Params& p, char* lds) {
    const int tid = threadIdx.x, lane = tid & 63, wave = __builtin_amdgcn_readfirstlane(tid >> 6);
    if (blockIdx.x < 64) {
        if (wave == 0) { const int x_ = blockIdx.x & 7, k_ = blockIdx.x >> 3;
            scan_item(p, (x_ + 8 * (k_ >> 2)) * 4 + (k_ & 3), lane); }
        else for (int it = 64 + blockIdx.x * 3 + (wave - 1); it < 64 + 1024; it += 192) scan_item(p, it, lane);
        return;
    }
    unsigned* ctr = (unsigned*)(p.ws + W_BAR) + 3456;
    volatile LAS int* slot = (volatile LAS int*)(lds + 75264);
    const int q0 = (int)((unsigned)__builtin_amdgcn_s_getreg((3 << 11) | 20) & 7u);
    for (int v = 0; v < 8; ++v) {
        const int q = (q0 + v) & 7;
        for (;;) {
            __syncthreads();
            if (tid == 0) *slot = (int)__hip_atomic_fetch_add(ctr + 16 * q, 1u, __ATOMIC_RELAXED, __HIP_MEMORY_SCOPE_AGENT);
            __syncthreads();
            const int item = *slot;
            if (item >= 32 + 128) break;
            if (item < 32) attn_block_sample(p, 32 * q + item, lds);
            else { const int j = item - 32; attn_block2(p, 2 * q + (j & 1), 63 - (j >> 1), lds); }
        }
    }
}

DI void phase_rwkv_out(const Params& p, char* lds) {
    const int tid = threadIdx.x, lane = tid & 63, wave = tid >> 6;
    float* pw = (float*)(lds + wave * 1024);
    const int gw = blockIdx.x * 4 + wave, nw = gridDim.x * 4;
    const int i16 = lane & 15, g = lane >> 4;
    const u16* proj = (const u16*)(p.ws + W_PROJ); const u16* QT = (const u16*)(p.ws + W_QT); const u16* SST = (const u16*)(p.ws + W_SST);
    const float* bonus = (const float*)(p.ws + W_BONUS);
    for (int wu = gw; wu < 8192 + 256; wu += nw) {
        int u, tg, b, h, c = 0, row0; bool prm = wu < 8192;
        if (prm) { u = wu >> 2; tg = wu & 3; b = u >> 10; h = (u >> 7) & 7; c = u & 127; row0 = b * 8192 + c * 64; }
        else { const int s = wu - 8192; u = 2048 + s; tg = 0; b = s >> 3; h = s & 7; row0 = NTP + b * 16; }
        const int t = 16 * tg + i16; const int row = row0 + t;
        u16* z = (u16*)(p.ws + W_XB) + (size_t)row * DM + 512 + h * 64;
        const u16* qt = QT + (size_t)u * 4096 + t * 64 + 8 * g; const bf16x8 bq0 = *(const bf16x8*)qt, bq1 = *(const bf16x8*)(qt + 32);
        { const float a_ = p.mix[1024 + h * 64 + lane], b_ = p.gn_g[h * 64 + lane], c_ = p.gn_b[h * 64 + lane];
            asm volatile("s_waitcnt lgkmcnt(0)" ::: "memory"); pw[lane] = a_; pw[64 + lane] = b_; pw[128 + lane] = c_; asm volatile("s_waitcnt lgkmcnt(0)" ::: "memory"); }
        const int wofs = 16 * (g & 1) + 8 * (g >> 1);
        const int mode = t > 0 ? 0 : (prm ? (c > 0 ? 0 : 1) : 2);
        uint2 ylw[4], cvw[4], grw[4], pvw[4];
        { const u16* pr_ = proj + (size_t)row * NC + h * 64 + wofs; const u16* pp_ = proj + (size_t)(mode == 0 ? row - 1 : row) * NC + C_RV + h * 64 + wofs;
#pragma unroll
            for (int mp = 0; mp < 2; ++mp) {
                unwiden16(*(const uint4*)(z + 32 * mp + wofs), ylw[2 * mp], ylw[2 * mp + 1]);
                unwiden16(*(const uint4*)(pr_ + C_RV + 32 * mp), cvw[2 * mp], cvw[2 * mp + 1]);
                unwiden16(*(const uint4*)(pr_ + C_GR + 32 * mp), grw[2 * mp], grw[2 * mp + 1]);
                unwiden16(*(const uint4*)(pp_ + 32 * mp), pvw[2 * mp], pvw[2 * mp + 1]); } }
        f32x4 y[4];
#pragma unroll
        for (int mt = 0; mt < 4; ++mt) {
            const uint2 yl = ylw[mt]; f32x4 a = {bflo(yl.x), bfhi(yl.x), bflo(yl.y), bfhi(yl.y)};
            const u16* sp = SST + (size_t)u * 4096 + (16 * mt + i16) * 64 + 8 * g;
            a = __builtin_amdgcn_mfma_f32_16x16x32_bf16(*(const bf16x8*)sp, bq0, a, 0, 0, 0); a = __builtin_amdgcn_mfma_f32_16x16x32_bf16(*(const bf16x8*)(sp + 32), bq1, a, 0, 0, 0);
            y[mt] = a;
        }
        float s1 = 0.f;
#pragma unroll
        for (int mt = 0; mt < 4; ++mt) s1 += (y[mt][0] + y[mt][1]) + (y[mt][2] + y[mt][3]);
        s1 = xadd16(s1); s1 = xadd32(s1);
        const float mu = s1 * (1.f / 64.f); float s2 = 0.f;
#pragma unroll
        for (int mt = 0; mt < 4; ++mt)
#pragma unroll
            for (int e = 0; e < 4; ++e) { const float d = y[mt][e] - mu; s2 += d * d; }
        s2 = xadd16(s2); s2 = xadd32(s2);
        const float rs = __builtin_amdgcn_rsqf(s2 * (1.f / 64.f) + 64e-5f);
        const float bon = bonus[(size_t)u * 64 + t];
        uint2 wz[4];
#pragma unroll
        for (int mt = 0; mt < 4; ++mt) {
            const int i0 = 16 * mt + 4 * g; const int hj = h * 64 + i0;
            const uint2 cvp = cvw[mt]; const float cv[4] = {bflo(cvp.x), bfhi(cvp.x), bflo(cvp.y), bfhi(cvp.y)};
            float pv[4];
            if (mode == 0) { const uint2 w = pvw[mt]; pv[0] = bflo(w.x); pv[1] = bfhi(w.x); pv[2] = bflo(w.y); pv[3] = bfhi(w.y); }
            else if (mode == 1) { pv[0] = pv[1] = pv[2] = pv[3] = 0.f; }
            else { const float4 w = *(const float4*)(p.st_shift + (size_t)b * 1664 + 1024 + hj); pv[0] = w.x; pv[1] = w.y; pv[2] = w.z; pv[3] = w.w; }
            const float4 mv = *(const float4*)(pw + i0), gg = *(const float4*)(pw + 64 + i0), gb = *(const float4*)(pw + 128 + i0);
            const float mvv[4] = {mv.x, mv.y, mv.z, mv.w}, ggv[4] = {gg.x, gg.y, gg.z, gg.w}, gbv[4] = {gb.x, gb.y, gb.z, gb.w};
            const uint2 grp = grw[mt]; const float gr[4] = {bflo(grp.x), bfhi(grp.x), bflo(grp.y), bfhi(grp.y)};
            float ov[4];
#pragma unroll
            for (int e = 0; e < 4; ++e) { const float xv = cv[e] + (pv[e] - cv[e]) * mvv[e]; const float yn = (y[mt][e] - mu) * rs * ggv[e] + gbv[e] + bon * xv; ov[e] = yn * silu(gr[e]); }
            wz[mt].x = pack2(ov[0], ov[1]); wz[mt].y = pack2(ov[2], ov[3]);
        }
#pragma unroll
        for (int mt = 0; mt < 4; mt += 2) *(uint4*)(z + 16 * (mt + (g & 1)) + 8 * (g >> 1)) = widen16(wz[mt], wz[mt + 1]);
    }
}


#define XB_TMO      128
#define XB_XCNT(j)  (256  + 64 * (j))
#define XB_XSUB(j)  (1280 + 64 * (j))
#define XB_XGEN(j)  (2304 + 64 * (j))
#define XB_TOP      3328
#define XB_TOPGEN   3392
#define XCD_BAR_WORDS 3456
#define XB_SPIN_CAP (1u << 18)
DI unsigned xb_ld(unsigned* p) { return __hip_atomic_load(p, __ATOMIC_RELAXED, __HIP_MEMORY_SCOPE_AGENT); }
DI unsigned xb_add(unsigned* p, unsigned v) { return __hip_atomic_fetch_add(p, v, __ATOMIC_RELAXED, __HIP_MEMORY_SCOPE_AGENT); }
DI unsigned xb_xcc_id() { return (unsigned)__builtin_amdgcn_s_getreg((3 << 11) | 20) & 0xFu; }
#define XB_SPIN(cond, bar) do { unsigned _sp = 0; while (cond) { __builtin_amdgcn_s_sleep(2); \
    if ((++_sp & 255u) == 0u) { if (xb_ld(&(bar)[XB_TMO])) break; if (_sp > XB_SPIN_CAP) { atomicAdd(&(bar)[XB_TMO], 1u); break; } } } } while (0)
struct XcdBarrier { unsigned* bar; unsigned x; volatile LAS unsigned* st; };
DI XcdBarrier xcd_barrier_post(unsigned* bar, volatile LAS unsigned* st) {
    XcdBarrier b; b.bar = bar; b.x = xb_xcc_id(); b.st = st;
    if (threadIdx.x == 0) (void)xb_add(&bar[XB_XCNT(b.x)], 1u);
    return b;
}
DI void xcd_barrier_complete(unsigned* bar, unsigned x, unsigned& nloc, unsigned& nx) {
    const unsigned G = gridDim.x * gridDim.y * gridDim.z;
    unsigned sum, cnt, mine, sp = 0u;
    for (;;) {
        sum = 0u; cnt = 0u; mine = 0u;
#pragma unroll
        for (unsigned j = 0; j < 16; ++j) { const unsigned c = xb_ld(&bar[XB_XCNT(j)]); sum += c; cnt += (c > 0u) ? 1u : 0u; mine = (j == x) ? c : mine; }
        if (sum == G) break;
        __builtin_amdgcn_s_sleep(1);
        if ((++sp & 255u) == 0u) { if (xb_ld(&bar[XB_TMO])) break; if (sp > XB_SPIN_CAP) { atomicAdd(&bar[XB_TMO], 1u); break; } }
    }
    nloc = mine > 0u ? mine : 1u; nx = cnt > 0u ? cnt : 1u;
}
DI void xcd_barrier(const XcdBarrier& b) {
    asm volatile("s_waitcnt vmcnt(0)" ::: "memory");
    __syncthreads();
    if (threadIdx.x == 0) {
        unsigned* bar = b.bar;
        __builtin_amdgcn_s_waitcnt(0);
        unsigned nloc = b.st[0], nx = b.st[1];
        if (nloc == 0u) { xcd_barrier_complete(bar, b.x, nloc, nx); b.st[0] = nloc; b.st[1] = nx; }
        const unsigned old = xb_add(&bar[XB_XSUB(b.x)], 1u);
        const unsigned gen = old / nloc;
        if (old + 1u == (gen + 1u) * nloc) {
            __builtin_amdgcn_fence(__ATOMIC_RELEASE, "agent");
            asm volatile("s_waitcnt vmcnt(0)" ::: "memory");
            const unsigned og = xb_add(&bar[XB_TOP], 1u);
            const unsigned tg = og / nx;
            if (og + 1u == (tg + 1u) * nx) xb_add(&bar[XB_TOPGEN], 1u);
            else XB_SPIN(xb_ld(&bar[XB_TOPGEN]) == tg, bar);
            __builtin_amdgcn_fence(__ATOMIC_ACQUIRE, "agent");
            xb_add(&bar[XB_XGEN(b.x)], 1u);
            asm volatile("s_waitcnt vmcnt(0)" ::: "memory");
        } else {
            XB_SPIN(xb_ld(&bar[XB_XGEN(b.x)]) == gen, bar);
            __builtin_amdgcn_fence(__ATOMIC_ACQUIRE, "agent");
            asm volatile("s_waitcnt vmcnt(0)" ::: "memory");
        }
    }
    __syncthreads();
}

DI void run_phase(const Params& p, char* lds, int ph) {
    if (ph == 0) phase_prep(p, lds);
    else if (ph == 1) { Epi1 e{&p}; gemm_phase((const u16*)(p.ws + W_XB), (const u16*)(p.ws + W_WINT), 132, 33, lds, e); }
    else if (ph == 2) phase_rwkv_prep(p, lds);
    else if (ph == 3) phase_scan_attn(p, lds);
    else if (ph == 4) phase_rwkv_out(p, lds);
    else gemm_out(p, lds);
}

extern "C" __global__ void __launch_bounds__(256, 2) hymba_mega(Params p, int ph_lo, int ph_hi) {
    extern __shared__ __attribute__((aligned(16))) char lds[];
#if ONE_LAUNCH
    volatile LAS unsigned* st = (volatile LAS unsigned*)(lds + 75520);
    if (threadIdx.x == 0) { st[0] = 0u; st[1] = 0u; st[2] = 0u; st[3] = 0u; }
    __syncthreads();
    const XcdBarrier xb = xcd_barrier_post((unsigned*)(p.ws + W_BAR), st);
#ifndef PROBE_REP
#define PROBE_REP -1
#endif
#define RUNP(k) do { run_phase(p, lds, k); if (PROBE_REP == k) { xcd_barrier(xb); run_phase(p, lds, k); } } while (0)
    RUNP(0); xcd_barrier(xb);
    RUNP(1); xcd_barrier(xb);
    RUNP(2); xcd_barrier(xb);
    RUNP(3); xcd_barrier(xb);
    run_phase(p, lds, 4); xcd_barrier(xb);
    RUNP(5);
#else
    run_phase(p, lds, ph_lo);
#endif
}

extern "C" void kernel_launch(void* const* d_in, const int* in_sizes, int n_in, void* d_out, int out_size, void* d_ws, size_t ws_size, hipStream_t stream) {
    Params p{};
    const float** f = (const float**)&p;
    for (int i = 0; i < 22; ++i) f[i] = (const float*)d_in[i];
    p.out = (float*)d_out; p.ws = (char*)d_ws;
    static int grid_blocks = 0;
    if (!grid_blocks) {
        hipFuncSetAttribute((const void*)hymba_mega, hipFuncAttributeMaxDynamicSharedMemorySize, LDS_BYTES);
        int dev = 0, cus = 0, per_cu = 0;
        hipGetDevice(&dev);
        hipDeviceGetAttribute(&cus, hipDeviceAttributeMultiprocessorCount, dev);
        hipOccupancyMaxActiveBlocksPerMultiprocessor(&per_cu, hymba_mega, 256, LDS_BYTES);
        if (per_cu > 2) per_cu = 2;
        if (per_cu < 1) per_cu = 1;
        grid_blocks = cus * per_cu;
    }
#if ONE_LAUNCH
    int lo = 0, hi = 5;
    (void)hipMemsetAsync((char*)d_ws + W_BAR, 0, (XCD_BAR_WORDS + 128) * 4, stream);
    void* args[] = {&p, &lo, &hi};
    hipError_t e = hipLaunchCooperativeKernel((void*)hymba_mega, dim3(grid_blocks), dim3(256), args, LDS_BYTES, stream);
    if (e != hipSuccess) fprintf(stderr, "cooperative launch failed: %s (grid %d)\n", hipGetErrorString(e), grid_blocks);
#else
    for (int ph = 0; ph < 6; ++ph) hipLaunchKernelGGL(hymba_mega, dim3(grid_blocks), dim3(256), LDS_BYTES, stream, p, ph, ph);
#endif
}
```

```cpp
#include <hip/hip_runtime.h>
#include <hip/hip_cooperative_groups.h>
#include <cstdio>
#include <cstdint>
namespace cg = cooperative_groups;

#ifndef ONE_LAUNCH
#define ONE_LAUNCH 1
#endif

#define DI __device__ __forceinline__
#define LAS __attribute__((address_space(3)))
typedef unsigned short u16;
typedef short bf16x8 __attribute__((ext_vector_type(8)));
typedef short s16x4 __attribute__((ext_vector_type(4)));
typedef float f32x4 __attribute__((ext_vector_type(4)));
typedef float f32x16 __attribute__((ext_vector_type(16)));
typedef float f32x2_t __attribute__((ext_vector_type(2)));
typedef __bf16 bf16x2_t __attribute__((ext_vector_type(2)));
typedef __attribute__((address_space(3))) s16x4 lds_s16x4;

constexpr int DM = 1024, NC = 4224, NTP = 16384, NTS = 512, NTOK = 16896;
constexpr int C_Q = 0, C_K = 512, C_V = 1024, C_GA = 1536, C_R = 2048, C_RK = 2560, C_RV = 3072, C_WD = 3584, C_AD = 3648, C_GR = 3712;
constexpr int NUNIT = 2304;
constexpr size_t O_YP = 0, O_YS = 16777216, O_KP = 17301504, O_VP = 17825792, O_KS = 18350080, O_VS = 18612224,
                 O_SP = 18874368, O_SS = 18939904, O_SHP = 19988480, O_SHS = 19991808;
constexpr size_t W_XB = 0, W_WINT = 34603008, W_WOUTT = 43253760, W_WUPT = 45350912, W_AUPT = 45416448, W_RSTD = 45481984,
                 W_BONUS = 264339456  , W_PROJ = 46090240, W_GT = 188827648, W_HH = 207702016, W_QT = 226576384, W_SST = 245450752, W_BAR = 264325120;
constexpr int LDS_BYTES = 75776;
constexpr float LOG2E = 1.4426950408889634f;

struct Params {
    const float *x_p, *x_s, *cache_k, *cache_v, *st_wkv, *st_shift, *norm_g, *w_in, *q_g, *k_g, *relb, *mix, *w0, *w_up, *a0, *a_up,
        *k_k, *k_a, *r_k, *gn_g, *gn_b, *w_out;
    float* out;
    char* ws;
};

DI unsigned pack2(float lo, float hi) { f32x2_t v = {lo, hi}; bf16x2_t b = __builtin_convertvector(v, bf16x2_t); return __builtin_bit_cast(unsigned, b); }
DI u16 f2bf(float f) { return (u16)(pack2(f, 0.f) & 0xffffu); }
DI float bflo(unsigned u) { return __uint_as_float(u << 16); }
DI float bfhi(unsigned u) { return __uint_as_float(u & 0xffff0000u); }
DI float bf2f(u16 h) { return __uint_as_float((unsigned)h << 16); }
DI int swz(int row, int ch) { return row * 128 + ((ch ^ ((row >> 1) & 7)) << 4); }
DI float dpp_add(float v, const int ctrl_sel) {
    int x = __float_as_int(v), y;
    if (ctrl_sel == 0) y = __builtin_amdgcn_update_dpp(0, x, 0xB1, 0xf, 0xf, true);
    else if (ctrl_sel == 1) y = __builtin_amdgcn_update_dpp(0, x, 0x4E, 0xf, 0xf, true);
    else if (ctrl_sel == 2) y = __builtin_amdgcn_update_dpp(0, x, 0x141, 0xf, 0xf, true);
    else y = __builtin_amdgcn_update_dpp(0, x, 0x140, 0xf, 0xf, true);
    return v + __int_as_float(y);
}
DI float wave_sum(float v) {
    v = dpp_add(v, 0); v = dpp_add(v, 1); v = dpp_add(v, 2); v = dpp_add(v, 3);
    const int x = __float_as_int(v);
    const float a = __int_as_float(__builtin_amdgcn_readlane(x, 0)), b = __int_as_float(__builtin_amdgcn_readlane(x, 16)),
                c = __int_as_float(__builtin_amdgcn_readlane(x, 32)), d = __int_as_float(__builtin_amdgcn_readlane(x, 48));
    return (a + b) + (c + d);
}
DI float rcpf_(float x) { return __builtin_amdgcn_rcpf(x); }
DI float silu(float x) { return x * rcpf_(1.f + __expf(-x)); }
DI float xadd16(float v) { const unsigned x = __float_as_uint(v); auto r = __builtin_amdgcn_permlane16_swap(x, x, false, false); return __uint_as_float(r[0]) + __uint_as_float(r[1]); }
DI float xadd32(float v) { const unsigned x = __float_as_uint(v); auto r = __builtin_amdgcn_permlane32_swap(x, x, false, false); return __uint_as_float(r[0]) + __uint_as_float(r[1]); }
DI float xmax16(float v) { const unsigned x = __float_as_uint(v); auto r = __builtin_amdgcn_permlane16_swap(x, x, false, false); return fmaxf(__uint_as_float(r[0]), __uint_as_float(r[1])); }
DI uint4 widen16(uint2 w0, uint2 w1) {
    auto rx = __builtin_amdgcn_permlane16_swap(w0.x, w1.x, false, false); auto ry = __builtin_amdgcn_permlane16_swap(w0.y, w1.y, false, false);
    return (uint4){rx[0], ry[0], rx[1], ry[1]};
}
DI void unwiden16(uint4 L, uint2& w0, uint2& w1) {
    auto rx = __builtin_amdgcn_permlane16_swap(L.x, L.z, false, false); auto ry = __builtin_amdgcn_permlane16_swap(L.y, L.w, false, false);
    w0 = (uint2){rx[0], ry[0]}; w1 = (uint2){rx[1], ry[1]};
}
DI float xmax32(float v) { const unsigned x = __float_as_uint(v); auto r = __builtin_amdgcn_permlane32_swap(x, x, false, false); return fmaxf(__uint_as_float(r[0]), __uint_as_float(r[1])); }
DI void unpack8(uint4 u, float* o) {
    o[0] = bflo(u.x); o[1] = bfhi(u.x); o[2] = bflo(u.y); o[3] = bfhi(u.y); o[4] = bflo(u.z); o[5] = bfhi(u.z); o[6] = bflo(u.w); o[7] = bfhi(u.w);
}

DI void transpose_tile(const float* W, int K, int N, const float* gain, u16* dst, float* tile, int t) {
    const int nkt = K / 64; const int kt = t % nkt, nt = t / nkt; const int k0 = kt * 64, n0 = nt * 64;
    const int tid = threadIdx.x, lane = tid & 63, wave = tid >> 6;
    float4 wv[4];
#pragma unroll
    for (int i = 0; i < 4; ++i) { const int idx = tid + 256 * i; wv[i] = *(const float4*)(W + (size_t)(k0 + (idx >> 4)) * N + n0 + 4 * (idx & 15)); }
    const float gl = gain ? gain[k0 + lane] : 1.f;
#pragma unroll
    for (int i = 0; i < 4; ++i) { const int kr = 16 * i + 4 * wave + (lane >> 4);
        const float g = __shfl(gl, kr); float* tp = tile + kr * 65 + 4 * (lane & 15);
        tp[0] = wv[i].x * g; tp[1] = wv[i].y * g; tp[2] = wv[i].z * g; tp[3] = wv[i].w * g; }
    __syncthreads();
#pragma unroll 4
    for (int i = 0; i < 8; ++i) { const int n = i * 8 + (tid >> 5); const int kp = tid & 31;
        const unsigned v = pack2(tile[(2 * kp) * 65 + n], tile[(2 * kp + 1) * 65 + n]); *(unsigned*)(dst + (size_t)(n0 + n) * K + k0 + 2 * kp) = v; }
    __syncthreads();
}
DI void phase_prep(const Params& p, char* lds) {
    const int tid = threadIdx.x, lane = tid & 63, wave = tid >> 6;
    u16* xb = (u16*)(p.ws + W_XB); float* rstd = (float*)(p.ws + W_RSTD);
    for (int rg = blockIdx.x * 4 + wave; rg < NTOK / 4; rg += gridDim.x * 4) {
        float4 v[4][4]; float ss[4];
#pragma unroll
        for (int k = 0; k < 4; ++k) { const int row = rg * 4 + k; const float* src = row < NTP ? p.x_p + (size_t)row * DM : p.x_s + (size_t)(row - NTP) * DM;
#pragma unroll
            for (int i = 0; i < 4; ++i) v[k][i] = ((const float4*)src)[i * 64 + lane]; }
#pragma unroll
        for (int k = 0; k < 4; ++k) { float a = 0.f;
#pragma unroll
            for (int i = 0; i < 4; ++i) a += v[k][i].x * v[k][i].x + v[k][i].y * v[k][i].y + v[k][i].z * v[k][i].z + v[k][i].w * v[k][i].w;
            ss[k] = wave_sum(a); }
#pragma unroll
        for (int k = 0; k < 4; ++k) { const int row = rg * 4 + k;
            if (lane == 0) rstd[row] = rsqrtf(ss[k] * (1.f / 1024.f) + 1e-6f);
#pragma unroll
            for (int i = 0; i < 4; ++i) { uint2 w; w.x = pack2(v[k][i].x, v[k][i].y); w.y = pack2(v[k][i].z, v[k][i].w); *(uint2*)(xb + (size_t)row * DM + (i * 64 + lane) * 4) = w; } }
    }
    float* tile = (float*)lds;
    for (int t = blockIdx.x; t < 1056 + 256 + 16; t += gridDim.x) {
        if (t < 1056) transpose_tile(p.w_in, 1024, NC, p.norm_g, (u16*)(p.ws + W_WINT), tile, t);
        else if (t < 1312) transpose_tile(p.w_out, 1024, 1024, nullptr, (u16*)(p.ws + W_WOUTT), tile, t - 1056);
        else if (t < 1320) transpose_tile(p.w_up, 64, 512, nullptr, (u16*)(p.ws + W_WUPT), tile, t - 1312);
        else transpose_tile(p.a_up, 64, 512, nullptr, (u16*)(p.ws + W_AUPT), tile, t - 1320);
    }
}

template <class Epi>
DI void gemm_phase(const u16* __restrict__ A, const u16* __restrict__ B, int mtiles, int ntiles, char* lds, const Epi& epi) {
    const int ntile = mtiles * ntiles;
    const int vb = (blockIdx.x & 7) * (gridDim.x >> 3) + (blockIdx.x >> 3);
    const int npan = ntiles >> 3;
    int tile = vb; if (tile >= ntile) return;
#define TILE_MN(t, M0, N0) do { int pan_ = (t) / (mtiles * 8); if (pan_ >= npan) pan_ = npan - 1; const int pw_ = (pan_ == npan - 1) ? ntiles - 8 * pan_ : 8; const int loc_ = (t) - pan_ * mtiles * 8; \
        M0 = (loc_ / pw_) * 128; N0 = (8 * pan_ + loc_ % pw_) * 128; } while (0)
#define GSTAGE(buf, kt, GA, GB) do { _Pragma("unroll") for (int i = 0; i < 4; ++i) { \
            __builtin_amdgcn_global_load_lds((const unsigned*)((GA) + soff[i] + (kt) * 64), (LAS unsigned*)(lds + (buf) * 32768 + (i * 4 + wave) * 1024), 16, 0, 0); \
            __builtin_amdgcn_global_load_lds((const unsigned*)((GB) + soff[i] + (kt) * 64), (LAS unsigned*)(lds + (buf) * 32768 + 16384 + (i * 4 + wave) * 1024), 16, 0, 0); } } while (0)
    int m0, n0; TILE_MN(tile, m0, n0);
    {
        const int lane = threadIdx.x & 63, wave = __builtin_amdgcn_readfirstlane(threadIdx.x >> 6);
        unsigned soff[4];
#pragma unroll
        for (int i = 0; i < 4; ++i) { const int row = 8 * (i * 4 + wave) + (lane >> 3); const int ch = (lane & 7) ^ ((row >> 1) & 7); soff[i] = (unsigned)(row * 1024 + ch * 8); }
        GSTAGE(0, 0, A + (size_t)m0 * 1024, B + (size_t)n0 * 1024);
    }
    for (;;) {
        int tid = threadIdx.x; asm volatile("" : "+v"(tid));
        const int lane = tid & 63, wave = __builtin_amdgcn_readfirstlane(tid >> 6); const int wn = wave >> 1, wm = wave & 1; const int r = lane & 31, h = lane >> 5;
        f32x16 acc[2][2];
#pragma unroll
        for (int a = 0; a < 2; ++a)
#pragma unroll
            for (int b = 0; b < 2; ++b)
#pragma unroll
                for (int e = 0; e < 16; ++e) acc[a][b][e] = 0.f;
        unsigned soff[4];
#pragma unroll
        for (int i = 0; i < 4; ++i) { const int row = 8 * (i * 4 + wave) + (lane >> 3); const int ch = (lane & 7) ^ ((row >> 1) & 7); soff[i] = (unsigned)(row * 1024 + ch * 8); }
        const u16* ga = A + (size_t)m0 * 1024; const u16* gb = B + (size_t)n0 * 1024;
        __syncthreads();
        for (int kt = 0; kt < 16; ++kt) {
            if (kt + 1 < 16) GSTAGE((kt + 1) & 1, kt + 1, ga, gb);
            const char* sa = lds + (kt & 1) * 32768; const char* sb = sa + 16384;
#pragma unroll
            for (int ks = 0; ks < 4; ++ks) {
                bf16x8 fw[2], fx[2];
#pragma unroll
                for (int ct = 0; ct < 2; ++ct) fw[ct] = *(const bf16x8*)(sb + swz(wn * 64 + ct * 32 + r, 2 * ks + h));
#pragma unroll
                for (int tt = 0; tt < 2; ++tt) fx[tt] = *(const bf16x8*)(sa + swz(wm * 64 + tt * 32 + r, 2 * ks + h));
#pragma unroll
                for (int ct = 0; ct < 2; ++ct)
#pragma unroll
                    for (int tt = 0; tt < 2; ++tt) acc[ct][tt] = __builtin_amdgcn_mfma_f32_32x32x16_bf16(fw[ct], fx[tt], acc[ct][tt], 0, 0, 0);
            }
            __syncthreads();
        }
        const int nxt = tile + (int)gridDim.x; int m1 = 0, n1 = 0;
        if (nxt < ntile) { TILE_MN(nxt, m1, n1); GSTAGE(0, 0, A + (size_t)m1 * 1024, B + (size_t)n1 * 1024); }
        epi(acc, m0 + wm * 64, n0 + wn * 64, lane);
        if (nxt >= ntile) break;
        tile = nxt; m0 = m1; n0 = n1;
    }
#undef GSTAGE
#undef TILE_MN
}

struct Epi1 {
    const Params* p;
    DI void operator()(f32x16 (&acc)[2][2], int mrow0, int ncol0, int lane) const {
        const int r = lane & 31, h = lane >> 5; const int cb = ncol0 >> 6;
        u16* proj = (u16*)(p->ws + W_PROJ); const float* rstd = (const float*)(p->ws + W_RSTD); float* out = p->out;
#pragma unroll
        for (int tt = 0; tt < 2; ++tt) {
            const int row = mrow0 + tt * 32 + r; const float rs = rstd[row];
            float v[2][16];
#pragma unroll
            for (int ct = 0; ct < 2; ++ct)
#pragma unroll
                for (int e = 0; e < 16; ++e) v[ct][e] = acc[ct][tt][e] * rs;
            if (cb < 16) {
                float ss = 0.f;
#pragma unroll
                for (int ct = 0; ct < 2; ++ct)
#pragma unroll
                    for (int e = 0; e < 16; ++e) ss += v[ct][e] * v[ct][e];
                ss = xadd32(ss);
                const float inv = __builtin_amdgcn_rsqf(ss * (1.f / 64.f) + 1e-6f);
                const float* g = cb < 8 ? p->q_g : p->k_g;
#pragma unroll
                for (int ct = 0; ct < 2; ++ct)
#pragma unroll
                    for (int gq = 0; gq < 4; ++gq) { const float4 gg = *(const float4*)(g + ct * 32 + 8 * gq + 4 * h);
                        v[ct][4 * gq] *= inv * gg.x; v[ct][4 * gq + 1] *= inv * gg.y; v[ct][4 * gq + 2] *= inv * gg.z; v[ct][4 * gq + 3] *= inv * gg.w; }
            }
#pragma unroll
            for (int ct = 0; ct < 2; ++ct)
#pragma unroll
                for (int gq = 0; gq < 4; gq += 2) {
                    unsigned ax = pack2(v[ct][4 * gq], v[ct][4 * gq + 1]), ay = pack2(v[ct][4 * gq + 2], v[ct][4 * gq + 3]);
                    unsigned bx = pack2(v[ct][4 * gq + 4], v[ct][4 * gq + 5]), by = pack2(v[ct][4 * gq + 6], v[ct][4 * gq + 7]);
                    { auto rr = __builtin_amdgcn_permlane32_swap(ax, bx, false, false); ax = rr[0]; bx = rr[1]; }
                    { auto rr = __builtin_amdgcn_permlane32_swap(ay, by, false, false); ay = rr[0]; by = rr[1]; }
                    *(uint4*)(proj + (size_t)row * NC + ncol0 + ct * 32 + 8 * gq + 8 * h) = (uint4){ax, ay, bx, by};
                }
            float* dst = nullptr;
            if (cb >= 8 && cb < 24) {
                const int hh = cb & 7;
                if (row < NTP) { const int b = row >> 13, t = row & 8191; if (t >= 7680) dst = out + (cb < 16 ? O_KP : O_VP) + ((size_t)(b * 8 + hh) * 512 + (t - 7680)) * 64; }
                else { const int s = row - NTP; const int b = s >> 4, t = s & 15; dst = out + (cb < 16 ? O_KS : O_VS) + ((size_t)(b * 8 + hh) * 16 + t) * 64; }
            } else if (cb >= 32 && cb < 58) {
                if (row < NTP) { if ((row & 8191) == 8191) dst = out + O_SHP + (size_t)(row >> 13) * 1664 + (cb - 32) * 64; }
                else { const int s = row - NTP; if ((s & 15) == 15) dst = out + O_SHS + (size_t)(s >> 4) * 1664 + (cb - 32) * 64; }
            }
            if (dst) {
#pragma unroll
                for (int ct = 0; ct < 2; ++ct)
#pragma unroll
                    for (int gq = 0; gq < 4; ++gq) { float4 w = {v[ct][4 * gq], v[ct][4 * gq + 1], v[ct][4 * gq + 2], v[ct][4 * gq + 3]}; *(float4*)(dst + ct * 32 + 8 * gq + 4 * h) = w; }
            }
        }
    }
};
struct Epi2 {
    const Params* p;
    DI void operator()(f32x16 (&acc)[2][2], int mrow0, int ncol0, int lane) const {
        const int r = lane & 31, h = lane >> 5;
#pragma unroll
        for (int tt = 0; tt < 2; ++tt) {
            const int row = mrow0 + tt * 32 + r;
            const float* xr = row < NTP ? p->x_p + (size_t)row * DM : p->x_s + (size_t)(row - NTP) * DM;
            float* o = p->out + (size_t)row * DM;
#pragma unroll
            for (int ct = 0; ct < 2; ++ct)
#pragma unroll
                for (int gq = 0; gq < 4; ++gq) { const int col = ncol0 + ct * 32 + 8 * gq + 4 * h; const float4 xv = *(const float4*)(xr + col);
                    float4 w = {xv.x + acc[ct][tt][4 * gq], xv.y + acc[ct][tt][4 * gq + 1], xv.z + acc[ct][tt][4 * gq + 2], xv.w + acc[ct][tt][4 * gq + 3]}; *(float4*)(o + col) = w; }
        }
    }
};

DI void gemm_out(const Params& p, char* lds) {
    const u16* __restrict__ A = (const u16*)(p.ws + W_XB); const u16* __restrict__ B = (const u16*)(p.ws + W_WOUTT);
    const int ntile = 176 * 8;
    const int vb = (blockIdx.x & 7) * (gridDim.x >> 3) + (blockIdx.x >> 3);
    for (int tile = vb; tile < ntile; tile += gridDim.x) {
        int tid = threadIdx.x; asm volatile("" : "+v"(tid));
        const int lane = tid & 63, wave = __builtin_amdgcn_readfirstlane(tid >> 6); const int wn = wave >> 1, wm = wave & 1; const int q = lane & 15, g = lane >> 4;
        const int mt = tile >> 3, nt = tile & 7; const int m0 = mt * 96, n0 = nt * 128;
        f32x4 acc[4][3];
#pragma unroll
        for (int a = 0; a < 4; ++a)
#pragma unroll
            for (int b = 0; b < 3; ++b) acc[a][b] = (f32x4){0.f, 0.f, 0.f, 0.f};
        unsigned soffb[4], soffa[3];
#pragma unroll
        for (int i = 0; i < 4; ++i) { const int row = 8 * (i * 4 + wave) + (lane >> 3); const int ch = (lane & 7) ^ ((row >> 1) & 7); soffb[i] = (unsigned)(row * 1024 + ch * 8); }
#pragma unroll
        for (int i = 0; i < 3; ++i) { const int row = 8 * (i * 4 + wave) + (lane >> 3); const int ch = (lane & 7) ^ ((row >> 1) & 7); soffa[i] = (unsigned)(row * 1024 + ch * 8); }
        const u16* ga = A + (size_t)m0 * 1024; const u16* gb = B + (size_t)n0 * 1024;
#define OSTAGE(buf, kt) do { _Pragma("unroll") for (int i = 0; i < 4; ++i) \
            __builtin_amdgcn_global_load_lds((const unsigned*)(gb + soffb[i] + (kt) * 64), (LAS unsigned*)(lds + (buf) * 28672 + (i * 4 + wave) * 1024), 16, 0, 0); \
        _Pragma("unroll") for (int i = 0; i < 3; ++i) \
            __builtin_amdgcn_global_load_lds((const unsigned*)(ga + soffa[i] + (kt) * 64), (LAS unsigned*)(lds + (buf) * 28672 + 16384 + (i * 4 + wave) * 1024), 16, 0, 0); } while (0)
        OSTAGE(0, 0);
        float4 xres[3][4];
#pragma unroll
        for (int tt = 0; tt < 3; ++tt) { const int row = m0 + wm * 48 + tt * 16 + q; const float* xr = row < NTP ? p.x_p + (size_t)row * DM : p.x_s + (size_t)(row - NTP) * DM;
#pragma unroll
            for (int ct = 0; ct < 4; ++ct) xres[tt][ct] = *(const float4*)(xr + n0 + wn * 64 + ct * 16 + 4 * g); }
        __syncthreads();
        for (int kt = 0; kt < 16; ++kt) {
            if (kt + 1 < 16) OSTAGE((kt + 1) & 1, kt + 1);
            const char* sb = lds + (kt & 1) * 28672; const char* sa = sb + 16384;
#pragma unroll
            for (int ks = 0; ks < 2; ++ks) {
                bf16x8 fw[4], fx[3];
#pragma unroll
                for (int ct = 0; ct < 4; ++ct) fw[ct] = *(const bf16x8*)(sb + swz(wn * 64 + ct * 16 + q, 4 * ks + g));
#pragma unroll
                for (int tt = 0; tt < 3; ++tt) fx[tt] = *(const bf16x8*)(sa + swz(wm * 48 + tt * 16 + q, 4 * ks + g));
#pragma unroll
                for (int ct = 0; ct < 4; ++ct)
#pragma unroll
                    for (int tt = 0; tt < 3; ++tt) acc[ct][tt] = __builtin_amdgcn_mfma_f32_16x16x32_bf16(fw[ct], fx[tt], acc[ct][tt], 0, 0, 0);
            }
            __syncthreads();
        }
#undef OSTAGE
#pragma unroll
        for (int tt = 0; tt < 3; ++tt) {
            const int row = m0 + wm * 48 + tt * 16 + q;
            const float* xr = row < NTP ? p.x_p + (size_t)row * DM : p.x_s + (size_t)(row - NTP) * DM;
            float* o = p.out + (size_t)row * DM;
#pragma unroll
            for (int ct = 0; ct < 4; ++ct) { const int col = n0 + wn * 64 + ct * 16 + 4 * g; const float4 xv = xres[tt][ct];
                float4 w = {xv.x + acc[ct][tt][0], xv.y + acc[ct][tt][1], xv.z + acc[ct][tt][2], xv.w + acc[ct][tt][3]}; *(float4*)(o + col) = w; }
        }
    }
}

DI f32x16 mmq(const char* X, const char* Y, int qm, int qn, f32x16 acc, int lane) {
    const int r = lane & 31, h = lane >> 5;
#pragma unroll
    for (int ks = 0; ks < 4; ++ks) {
        const bf16x8 a = *(const bf16x8*)(X + swz(32 * qm + r, 2 * ks + h));
        const bf16x8 b = *(const bf16x8*)(Y + swz(32 * qn + r, 2 * ks + h));
        acc = __builtin_amdgcn_mfma_f32_32x32x16_bf16(a, b, acc, 0, 0, 0);
    }
    return acc;
}
DI void st_nat(char* img, const f32x16& a, int qm, int qn, int lane) {
    const int n = 32 * qn + (lane & 31), h = lane >> 5;
#pragma unroll
    for (int g = 0; g < 4; ++g) { const int m = 32 * qm + 8 * g + 4 * h; uint2 w; w.x = pack2(a[4 * g], a[4 * g + 1]); w.y = pack2(a[4 * g + 2], a[4 * g + 3]);
        *(uint2*)(img + swz(n, m >> 3) + (m & 7) * 2) = w; }
}
DI void st_nat_g(u16* gimg, const f32x16& a, int qm, int qn, int lane) {
    const int n = 32 * qn + (lane & 31), h = lane >> 5;
#pragma unroll
    for (int g = 0; g < 4; ++g) { const int m = 32 * qm + 8 * g + 4 * h; uint2 w; w.x = pack2(a[4 * g], a[4 * g + 1]); w.y = pack2(a[4 * g + 2], a[4 * g + 3]);
        *(uint2*)(gimg + n * 64 + m) = w; }
}
DI void st_nat_gp(u16* gimg, const f32x16& a, int qm, int qn, int lane) {
    const int n = 32 * qn + (lane & 31), h = lane >> 5;
#pragma unroll
    for (int g = 0; g < 2; ++g) { const int m = 32 * qm + 8 * g + 4 * h; const int mp = (m & ~0x1c) | ((m & 0xc) << 1) | ((m & 0x10) >> 2);
        uint4 w; w.x = pack2(a[4 * g], a[4 * g + 1]); w.y = pack2(a[4 * g + 2], a[4 * g + 3]); w.z = pack2(a[4 * g + 8], a[4 * g + 9]); w.w = pack2(a[4 * g + 10], a[4 * g + 11]);
        *(uint4*)(gimg + n * 64 + mp) = w; }
}
DI void st_sc(char* img, const f32x16& a, int qm, int qn, int lane) {
    const int n = 32 * qn + (lane & 31), h = lane >> 5;
#pragma unroll
    for (int e = 0; e < 16; ++e) { const int m = 32 * qm + (e & 3) + 8 * (e >> 2) + 4 * h; *(u16*)(img + swz(m, n >> 3) + (n & 7) * 2) = f2bf(a[e]); }
}
DI f32x16 ld_nat(const char* img, int qm, int qn, int lane) {
    const int n = 32 * qn + (lane & 31), h = lane >> 5; f32x16 a;
#pragma unroll
    for (int g = 0; g < 4; ++g) { const int m = 32 * qm + 8 * g + 4 * h; const uint2 w = *(const uint2*)(img + swz(n, m >> 3) + (m & 7) * 2);
        a[4 * g] = bflo(w.x); a[4 * g + 1] = bfhi(w.x); a[4 * g + 2] = bflo(w.y); a[4 * g + 3] = bfhi(w.y); }
    return a;
}
DI void ld_cur_prev8(const Params& p, int row, int col, int mode, int sb, float* cur, float* prev) {
    const u16* proj = (const u16*)(p.ws + W_PROJ);
    unpack8(*(const uint4*)(proj + (size_t)row * NC + col), cur);
    if (mode == 0) unpack8(*(const uint4*)(proj + (size_t)(row - 1) * NC + col), prev);
    else if (mode == 1) { for (int i = 0; i < 8; ++i) prev[i] = 0.f; }
    else { const float* s = p.st_shift + (size_t)sb * 1664 + (col - C_R); const float4 a = *(const float4*)s, b = *(const float4*)(s + 4);
        prev[0] = a.x; prev[1] = a.y; prev[2] = a.z; prev[3] = a.w; prev[4] = b.x; prev[5] = b.y; prev[6] = b.z; prev[7] = b.w; }
}
DI float ld_prev1(const Params& p, int row, int col, int mode, int sb) {
    const u16* proj = (const u16*)(p.ws + W_PROJ);
    if (mode == 0) return bf2f(proj[(size_t)(row - 1) * NC + col]);
    if (mode == 1) return 0.f;
    return p.st_shift[(size_t)sb * 1664 + (col - C_R)];
}

DI void phase_rwkv_prep(const Params& p, char* lds) {
    const u16* proj = (const u16*)(p.ws + W_PROJ);
    char* R0 = lds; char* R1 = lds + 8192; char* R2 = lds + 2 * 8192; char* R3 = lds + 3 * 8192; char* R4 = lds + 4 * 8192; char* R5 = lds + 5 * 8192;
    char* R6 = lds + 6 * 8192; char* R7 = lds + 7 * 8192; char* R8 = lds + 8 * 8192;
    float* tot = (float*)(lds + 9 * 8192); float* gam = tot + 256;
    for (int u = blockIdx.x; u < NUNIT; u += gridDim.x) {
        int tid = threadIdx.x; asm volatile("" : "+v"(tid));
        const int lane = tid & 63, wave = __builtin_amdgcn_readfirstlane(tid >> 6); const int qm = wave >> 1, qn = wave & 1; const int r = lane & 31, h5 = lane >> 5;
        int b, h, c, row0, ntok; bool prm = u < 2048;
        if (prm) { b = u >> 10; h = (u >> 7) & 7; c = u & 127; row0 = b * 8192 + c * 64; ntok = 64; }
        else { const int s = u - 2048; b = s >> 3; h = s & 7; c = 0; row0 = NTP + b * 16; ntok = 16; }
        const int mode0 = prm ? (c > 0 ? 0 : 1) : 2;
        uint4 wr_[2], wk_[2], wv_[2];
#pragma unroll
        for (int i = 0; i < 2; ++i) { wr_[i] = (uint4){0, 0, 0, 0}; wk_[i] = wr_[i]; wv_[i] = wr_[i];
            if (16 * wave < ntok) { const u16* src = proj + (size_t)(row0 + 16 * wave + 8 * i + (lane >> 3)) * NC + h * 64 + 8 * (lane & 7);
                wr_[i] = *(const uint4*)(src + C_R); wk_[i] = *(const uint4*)(src + C_RK); wv_[i] = *(const uint4*)(src + C_RV); } }
        {
            const int t = tid >> 2, q = tid & 3;
#pragma unroll
            for (int half = 0; half < 2; ++half) {
                const int cw = q * 16 + half * 8;
                uint4 ow = {0, 0, 0, 0}, oa = {0, 0, 0, 0};
                if (t < ntok) {
                    const int mode = t > 0 ? 0 : mode0; float cur[8], prv[8], xw[8], xa[8];
                    ld_cur_prev8(p, row0 + t, C_WD + cw, mode, b, cur, prv);
                    { const float4 ma = *(const float4*)(p.mix + 1536 + cw), mb = *(const float4*)(p.mix + 1540 + cw); const float mx_[8] = {ma.x, ma.y, ma.z, ma.w, mb.x, mb.y, mb.z, mb.w};
#pragma unroll
                    for (int i = 0; i < 8; ++i) { const float x = cur[i] + (prv[i] - cur[i]) * mx_[i]; const float e2 = __expf(2.f * x); xw[i] = 1.f - 2.f * rcpf_(e2 + 1.f); } }
                    ld_cur_prev8(p, row0 + t, C_AD + cw, mode, b, cur, prv);
                    { const float4 ma = *(const float4*)(p.mix + 1600 + cw), mb = *(const float4*)(p.mix + 1604 + cw); const float mx_[8] = {ma.x, ma.y, ma.z, ma.w, mb.x, mb.y, mb.z, mb.w};
#pragma unroll
                    for (int i = 0; i < 8; ++i) xa[i] = cur[i] + (prv[i] - cur[i]) * mx_[i]; }
                    ow.x = pack2(xw[0], xw[1]); ow.y = pack2(xw[2], xw[3]); ow.z = pack2(xw[4], xw[5]); ow.w = pack2(xw[6], xw[7]);
                    oa.x = pack2(xa[0], xa[1]); oa.y = pack2(xa[2], xa[3]); oa.z = pack2(xa[4], xa[5]); oa.w = pack2(xa[6], xa[7]);
                }
                *(uint4*)(R0 + swz(t, 2 * q + half)) = ow; *(uint4*)(R1 + swz(t, 2 * q + half)) = oa;
            }
        }
        __syncthreads();
        {
            f32x16 adw, ada;
#pragma unroll
            for (int e = 0; e < 16; ++e) { adw[e] = 0.f; ada[e] = 0.f; }
            const u16* wup = (const u16*)(p.ws + W_WUPT) + (size_t)(h * 64 + 32 * qn + r) * 64; const u16* aup = (const u16*)(p.ws + W_AUPT) + (size_t)(h * 64 + 32 * qn + r) * 64;
#pragma unroll
            for (int ks = 0; ks < 4; ++ks) {
                const bf16x8 xa = *(const bf16x8*)(R0 + swz(32 * qm + r, 2 * ks + h5)); const bf16x8 xb = *(const bf16x8*)(R1 + swz(32 * qm + r, 2 * ks + h5));
                const bf16x8 ya = *(const bf16x8*)(wup + 16 * ks + 8 * h5); const bf16x8 yb = *(const bf16x8*)(aup + 16 * ks + 8 * h5);
                adw = __builtin_amdgcn_mfma_f32_32x32x16_bf16(xa, ya, adw, 0, 0, 0); ada = __builtin_amdgcn_mfma_f32_32x32x16_bf16(xb, yb, ada, 0, 0, 0);
            }
            float* DW = (float*)R4; float* DA = (float*)R6; const int n = 32 * qn + r;
#pragma unroll
            for (int e = 0; e < 16; ++e) { const int m = 32 * qm + (e & 3) + 8 * (e >> 2) + 4 * h5; DW[m * 64 + n] = adw[e]; DA[m * 64 + n] = ada[e]; }
        }
        __syncthreads();
        {
            const int tg = wave, j = lane, hj = h * 64 + j;
            float* DW = (float*)R4; const float* DA = (const float*)R6;
            { const float w0j = p.w0[hj];
                float run = 0.f;
#pragma unroll 4
                for (int i = 0; i < 16; ++i) { const int t = 16 * tg + i; const float x = w0j + DW[t * 64 + j];
                    const float z = -x; const float sp = fmaxf(z, 0.f) + __logf(1.f + __expf(-fabsf(z))); float l = -__expf(-sp - 0.5f); if (t >= ntok) l = 0.f; DW[t * 64 + j] = l; run += l; }
                tot[tg * 64 + j] = run;
            }
            __syncthreads();
            float prefix = 0.f, ctot = 0.f;
#pragma unroll
            for (int g = 0; g < 4; ++g) { const float v = tot[g * 64 + j]; if (g < tg) prefix += v; ctot += v; }
            if (tg == 0) gam[j] = __expf(ctot);
            const float a0j = p.a0[hj], kkj = p.k_k[hj], kaj = p.k_a[hj], rkj = p.r_k[hj];
            const float mr = p.mix[hj], mk = p.mix[512 + hj], mv = p.mix[1024 + hj];
            float* bonus = (float*)(p.ws + W_BONUS);
            float mybon = 0.f;
            u16 gcr[16], gck[16], gcv[16];
            { char* tb = R8 + wave * 2048; char* wp = tb + (lane >> 3) * 128 + (lane & 7) * 16; const char* rp = tb + lane * 2;
#define XPOSE16(W, OUT) do { asm volatile("s_waitcnt lgkmcnt(0)" ::: "memory"); *(uint4*)wp = W[0]; *(uint4*)(wp + 1024) = W[1]; asm volatile("s_waitcnt lgkmcnt(0)" ::: "memory"); \
                    _Pragma("unroll") for (int tt = 0; tt < 16; ++tt) OUT[tt] = *(const u16*)(rp + tt * 128); } while (0)
                XPOSE16(wr_, gcr); XPOSE16(wk_, gck); XPOSE16(wv_, gcv);
#undef XPOSE16
            }
            float pr = 0.f, pk = 0.f, pv = 0.f;
            { const int t0 = 16 * tg; if (t0 < ntok) { const int mode = t0 > 0 ? 0 : mode0; pr = ld_prev1(p, row0 + t0, C_R + hj, mode, b); pk = ld_prev1(p, row0 + t0, C_RK + hj, mode, b); pv = ld_prev1(p, row0 + t0, C_RV + hj, mode, b); } }
            float ecl = __expf(prefix); const float etot = __expf(ctot);
            unsigned pAt[8], pV[8], pKb[8], pBb[8]; float hAt = 0.f, hV = 0.f, hKb = 0.f, hBb = 0.f;
#pragma unroll
            for (int i = 0; i < 16; ++i) {
                const int t = 16 * tg + i; const bool valid = t < ntok;
                float xr = 0.f, xk = 0.f, xv = 0.f;
                if (valid) { const float cr = bf2f(gcr[i]), ck = bf2f(gck[i]), cv = bf2f(gcv[i]);
                    xr = cr + (pr - cr) * mr; xk = ck + (pk - ck) * mk; xv = cv + (pv - cv) * mv; pr = cr; pk = ck; pv = cv; }
                const float a = rcpf_(1.f + __expf(-(a0j + DA[t * 64 + j])));
                const float kx = xk * kkj; const float ss = wave_sum(kx * kx); const float kk = kx * __builtin_amdgcn_rsqf(fmaxf(ss, 1e-24f));
                const float kmod = xk * (1.f + (a - 1.f) * kaj);
                const float bon = wave_sum(xr * kmod * rkj);
                if (lane == i) mybon = bon;
                const float e_ce = ecl; ecl *= __expf(DW[t * 64 + j]);
                const float e_cl = ecl, e_n = rcpf_(ecl), e_t = etot * e_n;
                const float vAt = -kk * e_ce, vRt = xr * e_cl, vBt = kk * a * e_n, vKt = kmod * e_n, vBb = kk * a * e_t, vKb = kmod * e_t;
                const int so = swz(t, j >> 3) + (j & 7) * 2;
                *(u16*)(R0 + so) = f2bf(vAt); *(u16*)(R1 + so) = f2bf(vRt); *(u16*)(R2 + so) = f2bf(vBt); *(u16*)(R3 + so) = f2bf(vKt);
                if (i & 1) { pAt[i >> 1] = pack2(hAt, vAt); pV[i >> 1] = pack2(hV, xv); pKb[i >> 1] = pack2(hKb, vKb); pBb[i >> 1] = pack2(hBb, vBb); }
                else { hAt = vAt; hV = xv; hKb = vKb; hBb = vBb; }
            }
            if (lane < 16) bonus[(size_t)u * 64 + 16 * tg + lane] = mybon;
            __syncthreads();
#pragma unroll
            for (int half = 0; half < 2; ++half) { const int o = swz(j, 2 * tg + half);
                *(uint4*)(R4 + o) = (uint4){pAt[4 * half], pAt[4 * half + 1], pAt[4 * half + 2], pAt[4 * half + 3]};
                *(uint4*)(R5 + o) = (uint4){pV[4 * half], pV[4 * half + 1], pV[4 * half + 2], pV[4 * half + 3]};
                *(uint4*)(R6 + o) = (uint4){pKb[4 * half], pKb[4 * half + 1], pKb[4 * half + 2], pKb[4 * half + 3]};
                *(uint4*)(R7 + o) = (uint4){pBb[4 * half], pBb[4 * half + 1], pBb[4 * half + 2], pBb[4 * half + 3]}; }
        }
        __syncthreads();
        f32x16 z16;
#pragma unroll
        for (int e = 0; e < 16; ++e) z16[e] = 0.f;
        f32x16 aN = mmq(R2, R0, qm, qn, z16, lane);
        f32x16 aKa = mmq(R3, R0, qm, qn, z16, lane);
        f32x16 aW1 = mmq(R2, R1, qm, qn, z16, lane);
        f32x16 aKr = mmq(R3, R1, qm, qn, z16, lane);
        {
            const int n = 32 * qn + r;
#pragma unroll
            for (int e = 0; e < 16; ++e) { const int m = 32 * qm + (e & 3) + 8 * (e >> 2) + 4 * h5;
                if (!(m < n)) { aN[e] = 0.f; aKa[e] = 0.f; } if (!(m <= n)) { aW1[e] = 0.f; aKr[e] = 0.f; } }
        }
        f32x16 aW2 = ld_nat(R7, qm, qn, lane);
        __syncthreads();
        st_sc(R0, aN, qm, qn, lane);
        st_nat(R2, aN, qm, qn, lane);
        st_sc(R3, aKa, qm, qn, lane);
        st_nat(R8, aW1, qm, qn, lane);
        __syncthreads();
        for (int it = 0; it < 6; ++it) {
            aW1 = mmq(R0, R8, qm, qn, aW1, lane);
            aW2 = mmq(R0, R7, qm, qn, aW2, lane);
            if (it < 5) aN = mmq(R0, R2, qm, qn, z16, lane);
            __syncthreads();
            st_nat(R8, aW1, qm, qn, lane); st_nat(R7, aW2, qm, qn, lane);
            if (it < 5) { st_sc(R0, aN, qm, qn, lane); st_nat(R2, aN, qm, qn, lane); }
            __syncthreads();
        }
        {
            f32x16 aG = mmq(R4, R7, qm, qn, z16, lane);
            { const int n = 32 * qn + r; const float gn = gam[n];
#pragma unroll
                for (int e = 0; e < 16; ++e) { const int m = 32 * qm + (e & 3) + 8 * (e >> 2) + 4 * h5; if (m == n) aG[e] += gn; } }
            st_nat_gp((u16*)(p.ws + W_GT) + (size_t)u * 4096, aG, qm, qn, lane);
            f32x16 aQ = ld_nat(R1, qm, qn, lane);
            aQ = mmq(R4, R8, qm, qn, aQ, lane);
            st_nat_gp((u16*)(p.ws + W_QT) + (size_t)u * 4096, aQ, qm, qn, lane);
            f32x16 aP1 = ld_nat(R6, qm, qn, lane);
            aP1 = mmq(R3, R7, qm, qn, aP1, lane);
            aKr = mmq(R3, R8, qm, qn, aKr, lane);
            st_nat(R0, aP1, qm, qn, lane);
            st_nat(R2, aKr, qm, qn, lane);
        }
        __syncthreads();
        {
            f32x16 aH = mmq(R0, R5, qm, qn, z16, lane);
            st_nat_gp((u16*)(p.ws + W_HH) + (size_t)u * 4096, aH, qm, qn, lane);
            f32x16 aY = mmq(R5, R2, qm, qn, z16, lane);
            const int n = 32 * qn + r;

#pragma unroll
            for (int g = 0; g < 4; g += 2) {
                unsigned ax = pack2(aY[4 * g], aY[4 * g + 1]), ay = pack2(aY[4 * g + 2], aY[4 * g + 3]), bx = pack2(aY[4 * g + 4], aY[4 * g + 5]), by = pack2(aY[4 * g + 6], aY[4 * g + 7]);
                { auto rr = __builtin_amdgcn_permlane32_swap(ax, bx, false, false); ax = rr[0]; bx = rr[1]; }
                { auto rr = __builtin_amdgcn_permlane32_swap(ay, by, false, false); ay = rr[0]; by = rr[1]; }
                if (n < ntok) *(uint4*)((u16*)(p.ws + W_XB) + (size_t)(row0 + n) * DM + 512 + h * 64 + 32 * qm + 8 * g + 8 * h5) = (uint4){ax, ay, bx, by};
            }
        }
        __syncthreads();
    }
}

struct ScanSlot { uint4 ga[4][2]; uint4 gh[2]; };
DI void scan_load(ScanSlot& s, const u16* GT, const u16* HH, int u, int irow, int i16, int g) {
    const u16* gt = GT + (size_t)u * 4096; const u16* hh = HH + (size_t)u * 4096 + irow * 64;
#pragma unroll
    for (int mt = 0; mt < 4; ++mt) {
#pragma unroll
        for (int ks = 0; ks < 2; ++ks) s.ga[mt][ks] = *(const uint4*)(gt + (16 * mt + i16) * 64 + 32 * ks + 8 * g);
    }
#pragma unroll
    for (int ks = 0; ks < 2; ++ks) s.gh[ks] = *(const uint4*)(hh + 32 * ks + 8 * g);
}
DI void scan_step(const ScanSlot& s, f32x4 (&acc)[4], u16* sst, int irow, int g) {
    unsigned pk[4][2];
#pragma unroll
    for (int mt = 0; mt < 4; ++mt) { pk[mt][0] = pack2(acc[mt][0], acc[mt][1]); pk[mt][1] = pack2(acc[mt][2], acc[mt][3]); }
    bf16x8 bfr[2];
#pragma unroll
    for (int ks = 0; ks < 2; ++ks) { uint4 w = {pk[2 * ks][0], pk[2 * ks][1], pk[2 * ks + 1][0], pk[2 * ks + 1][1]}; bfr[ks] = __builtin_bit_cast(bf16x8, w);
        *(uint4*)(sst + irow * 64 + 32 * ks + 8 * g) = w; }
#pragma unroll
    for (int mt = 0; mt < 4; ++mt) {
        const unsigned hx = (mt & 1) ? s.gh[mt >> 1].z : s.gh[mt >> 1].x, hy = (mt & 1) ? s.gh[mt >> 1].w : s.gh[mt >> 1].y;
        f32x4 c = {bflo(hx), bfhi(hx), bflo(hy), bfhi(hy)};
#pragma unroll
        for (int ks = 0; ks < 2; ++ks) c = __builtin_amdgcn_mfma_f32_16x16x32_bf16(__builtin_bit_cast(bf16x8, s.ga[mt][ks]), bfr[ks], c, 0, 0, 0);
        acc[mt] = c;
    }
}
DI void scan_item(const Params& p, int item, int lane) {
    const int i16 = lane & 15, g = lane >> 4;
    const u16* GT = (const u16*)(p.ws + W_GT); const u16* HH = (const u16*)(p.ws + W_HH); u16* SST = (u16*)(p.ws + W_SST);
    f32x4 acc[4];
    if (item < 64) {
        const int bh = item >> 2, iq = item & 3, u0 = bh * 128, irow = 16 * iq + i16;
#pragma unroll
        for (int mt = 0; mt < 4; ++mt) acc[mt] = (f32x4){0.f, 0.f, 0.f, 0.f};
        ScanSlot s0, s1, s2, s3, s4;
        scan_load(s0, GT, HH, u0, irow, i16, g); scan_load(s1, GT, HH, u0 + 1, irow, i16, g); scan_load(s2, GT, HH, u0 + 2, irow, i16, g); scan_load(s3, GT, HH, u0 + 3, irow, i16, g);
        scan_load(s4, GT, HH, u0 + 4, irow, i16, g);
        const int ul = u0 + 127;
#define PINM do { asm volatile("" ::: "memory"); __builtin_amdgcn_sched_barrier(0); } while (0)
        for (int st = 0; st < 125; st += 5) {
            const int u = u0 + st;
            scan_step(s0, acc, SST + (size_t)u * 4096, irow, g);       PINM; scan_load(s0, GT, HH, min(u + 5, ul), irow, i16, g); PINM;
            scan_step(s1, acc, SST + (size_t)(u + 1) * 4096, irow, g); PINM; scan_load(s1, GT, HH, min(u + 6, ul), irow, i16, g); PINM;
            scan_step(s2, acc, SST + (size_t)(u + 2) * 4096, irow, g); PINM; scan_load(s2, GT, HH, min(u + 7, ul), irow, i16, g); PINM;
            scan_step(s3, acc, SST + (size_t)(u + 3) * 4096, irow, g); PINM; scan_load(s3, GT, HH, min(u + 8, ul), irow, i16, g); PINM;
            scan_step(s4, acc, SST + (size_t)(u + 4) * 4096, irow, g); PINM; scan_load(s4, GT, HH, min(u + 9, ul), irow, i16, g); PINM;
        }
        scan_step(s0, acc, SST + (size_t)(u0 + 125) * 4096, irow, g); PINM;
        scan_step(s1, acc, SST + (size_t)(u0 + 126) * 4096, irow, g); PINM;
        scan_step(s2, acc, SST + (size_t)(u0 + 127) * 4096, irow, g);
#undef PINM
        float* fout = p.out + O_SP + (size_t)bh * 4096;
#pragma unroll
        for (int mt = 0; mt < 4; ++mt) *(f32x4*)(fout + irow * 64 + 16 * mt + 4 * g) = acc[mt];
    } else {
        const int s = (item - 64) >> 2, iq = item & 3, u = 2048 + s, irow = 16 * iq + i16;
        const float* st0 = p.st_wkv + (size_t)s * 4096 + irow * 64;
#pragma unroll
        for (int mt = 0; mt < 4; ++mt) acc[mt] = *(const f32x4*)(st0 + 16 * mt + 4 * g);
        ScanSlot s0; scan_load(s0, GT, HH, u, irow, i16, g);
        scan_step(s0, acc, SST + (size_t)u * 4096, irow, g);
        float* fout = p.out + O_SS + (size_t)s * 4096;
#pragma unroll
        for (int mt = 0; mt < 4; ++mt) *(f32x4*)(fout + irow * 64 + 16 * mt + 4 * g) = acc[mt];
    }
}

DI s16x4 tr16(const char* p) { return __builtin_bit_cast(s16x4, __builtin_amdgcn_ds_read_tr16_b64_v4i16((__attribute__((address_space(3))) s16x4*)p)); }

DI void attn_tile(const char* sk, const char* sv, const float* tab, const bf16x8& qf0, const bf16x8& qf1, float& m, float& l, f32x4 (&o)[4], int qpos, int dlt, int nvalid, int lane) {
    const int q = lane & 15, g = lane >> 4;
    const float C2 = 0.125f * LOG2E;
    f32x4 sc[4];
#pragma unroll
    for (int kt = 0; kt < 4; ++kt) {
        const bf16x8 a0 = *(const bf16x8*)(sk + swz(16 * kt + q, g)); const bf16x8 a1 = *(const bf16x8*)(sk + swz(16 * kt + q, 4 + g));
        f32x4 s = {0.f, 0.f, 0.f, 0.f};
        s = __builtin_amdgcn_mfma_f32_16x16x32_bf16(a0, qf0, s, 0, 0, 0); s = __builtin_amdgcn_mfma_f32_16x16x32_bf16(a1, qf1, s, 0, 0, 0);
        sc[kt] = s;
    }
    float mx = -INFINITY;
    if (dlt >= 3) {
        const float bc = tab[256];
#pragma unroll
        for (int kt = 0; kt < 4; ++kt)
#pragma unroll
            for (int e = 0; e < 4; ++e) { const float s = sc[kt][e] * C2 + bc; sc[kt][e] = s; mx = fmaxf(mx, s); }
    } else {
#pragma unroll
        for (int kt = 0; kt < 4; ++kt)
#pragma unroll
            for (int e = 0; e < 4; ++e) { const int key = 16 * kt + 4 * g + e; int rel = qpos - key + dlt * 64; rel = rel < -128 ? -128 : (rel > 128 ? 128 : rel);
                float s = sc[kt][e] * C2 + tab[rel + 128]; if (key >= nvalid) s = -INFINITY; sc[kt][e] = s; mx = fmaxf(mx, s); }
    }
    mx = xmax16(mx); mx = xmax32(mx);
    const float mn = fmaxf(m, mx); const float alpha = __builtin_amdgcn_exp2f(m - mn); m = mn;
    float ps = 0.f;
#pragma unroll
    for (int kt = 0; kt < 4; ++kt)
#pragma unroll
        for (int e = 0; e < 4; ++e) { const float pe = __builtin_amdgcn_exp2f(sc[kt][e] - mn); sc[kt][e] = pe; ps += pe; }
    l = l * alpha + ps;
#pragma unroll
    for (int dt = 0; dt < 4; ++dt) o[dt] *= alpha;
    bf16x8 pf[2];
#pragma unroll
    for (int ks = 0; ks < 2; ++ks) { uint4 w = {pack2(sc[2 * ks][0], sc[2 * ks][1]), pack2(sc[2 * ks][2], sc[2 * ks][3]), pack2(sc[2 * ks + 1][0], sc[2 * ks + 1][1]), pack2(sc[2 * ks + 1][2], sc[2 * ks + 1][3])};
        pf[ks] = __builtin_bit_cast(bf16x8, w); }
#pragma unroll
    for (int dt = 0; dt < 4; ++dt)
#pragma unroll
        for (int ks = 0; ks < 2; ++ks) {
            const int vr = 32 * ks + 4 * g + (q >> 2); const int col = 16 * dt + 4 * (q & 3);
            const s16x4 lo = tr16(sv + swz(vr, col >> 3) + (col & 7) * 2); const s16x4 hi = tr16(sv + swz(vr + 16, col >> 3) + (col & 7) * 2);
            const bf16x8 vf = {lo[0], lo[1], lo[2], lo[3], hi[0], hi[1], hi[2], hi[3]};
            o[dt] = __builtin_amdgcn_mfma_f32_16x16x32_bf16(vf, pf[ks], o[dt], 0, 0, 0);
        }
}
DI void attn_finish(const Params& p, float l, const f32x4 (&o)[4], int qrow, int h, int lane) {
    const int g = lane >> 4; const u16* proj = (const u16*)(p.ws + W_PROJ);
    l = xadd16(l); l = xadd32(l);
    const float inv = rcpf_(l);
    u16* z = (u16*)(p.ws + W_XB) + (size_t)qrow * DM + h * 64; const u16* ga = proj + (size_t)qrow * NC + C_GA + h * 64;
    uint2 w[4];
#pragma unroll
    for (int dt = 0; dt < 4; ++dt) { const int d = 16 * dt + 4 * g; const uint2 gg = *(const uint2*)(ga + d);
        w[dt].x = pack2(o[dt][0] * inv * silu(bflo(gg.x)), o[dt][1] * inv * silu(bfhi(gg.x))); w[dt].y = pack2(o[dt][2] * inv * silu(bflo(gg.y)), o[dt][3] * inv * silu(bfhi(gg.y))); }
#pragma unroll
    for (int dt = 0; dt < 4; dt += 2) *(uint4*)(z + 16 * (dt + (g & 1)) + 8 * (g >> 1)) = widen16(w[dt], w[dt + 1]);
}
DI void attn_block(const Params& p, int u, char* lds) {
    int tid = threadIdx.x; asm volatile("" : "+v"(tid));
    const int lane = tid & 63, wave = __builtin_amdgcn_readfirstlane(tid >> 6);
    const u16* proj = (const u16*)(p.ws + W_PROJ);
    const int b = u >> 10, h = (u >> 7) & 7, c = u & 127; const int qrow = b * 8192 + c * 64 + wave * 16 + (lane & 15); const int ndl = c < 8 ? c : 8;
    float* tab = (float*)(lds + 49152);
    __syncthreads();
    for (int i = tid; i < 257; i += 256) tab[i] = p.relb[h * 257 + i] * LOG2E;
    const u16* qp = proj + (size_t)qrow * NC + C_Q + h * 64 + 8 * (lane >> 4);
    const bf16x8 qf0 = *(const bf16x8*)qp, qf1 = *(const bf16x8*)(qp + 32);
    float m = -INFINITY, l = 0.f; f32x4 o[4];
#pragma unroll
    for (int dt = 0; dt < 4; ++dt) o[dt] = (f32x4){0.f, 0.f, 0.f, 0.f};
    unsigned soff[2];
#pragma unroll
    for (int i = 0; i < 2; ++i) { const int row = 8 * (i * 4 + wave) + (lane >> 3); const int ch = (lane & 7) ^ ((row >> 1) & 7); soff[i] = (unsigned)(row * NC + ch * 8); }
    const u16* kbase = proj + (size_t)(b * 8192) * NC + h * 64;
#define ASTAGE(buf, dl) do { const u16* kr = kbase + (size_t)((c - (dl)) * 64) * NC; _Pragma("unroll") for (int i = 0; i < 2; ++i) { \
        __builtin_amdgcn_global_load_lds((const unsigned*)(kr + soff[i] + C_K), (LAS unsigned*)(lds + (buf) * 8192 + (i * 4 + wave) * 1024), 16, 0, 0); \
        __builtin_amdgcn_global_load_lds((const unsigned*)(kr + soff[i] + C_V), (LAS unsigned*)(lds + 24576 + (buf) * 8192 + (i * 4 + wave) * 1024), 16, 0, 0); } } while (0)
    __syncthreads();
    ASTAGE(0, ndl); if (ndl >= 1) ASTAGE(1, ndl - 1);
    int buf = 0;
    for (int dlt = ndl; dlt >= 0; --dlt) {
        if (dlt >= 1) asm volatile("s_waitcnt vmcnt(4) lgkmcnt(0)" ::: "memory"); else asm volatile("s_waitcnt vmcnt(0) lgkmcnt(0)" ::: "memory");
        __builtin_amdgcn_s_barrier();
        asm volatile("" ::: "memory");
        const int nb2 = buf >= 1 ? buf - 1 : 2;
        if (dlt >= 2) ASTAGE(nb2, dlt - 2);
        attn_tile(lds + buf * 8192, lds + 24576 + buf * 8192, tab, qf0, qf1, m, l, o, wave * 16 + (lane & 15), dlt, 64, lane);
        buf = buf == 2 ? 0 : buf + 1;
    }
#undef ASTAGE
    attn_finish(p, l, o, qrow, h, lane);
}
struct QG { bf16x8 q0, q1; float m, l; f32x4 o[4]; };
DI void attn_softmax(f32x4 (&sc)[4], const float* tab, QG& G, int qpos, int dlt, int g, bf16x8 (&pf)[2]) {
    const float C2 = 0.125f * LOG2E;
    float mx = -INFINITY;
    if (dlt >= 3) {
        const float bc = tab[256];
#pragma unroll
        for (int kt = 0; kt < 4; ++kt)
#pragma unroll
            for (int e = 0; e < 4; ++e) { const float s = sc[kt][e] * C2 + bc; sc[kt][e] = s; mx = fmaxf(mx, s); }
    } else {
#pragma unroll
        for (int kt = 0; kt < 4; ++kt)
#pragma unroll
            for (int e = 0; e < 4; ++e) { const int key = 16 * kt + 4 * g + e; int rel = qpos - key + dlt * 64; rel = rel < -128 ? -128 : (rel > 128 ? 128 : rel);
                const float s = sc[kt][e] * C2 + tab[rel + 128]; sc[kt][e] = s; mx = fmaxf(mx, s); }
    }
    mx = xmax16(mx); mx = xmax32(mx);
    const float mn = fmaxf(G.m, mx); const float alpha = __builtin_amdgcn_exp2f(G.m - mn); G.m = mn;
    float ps = 0.f;
#pragma unroll
    for (int kt = 0; kt < 4; ++kt)
#pragma unroll
        for (int e = 0; e < 4; ++e) { const float pe = __builtin_amdgcn_exp2f(sc[kt][e] - mn); sc[kt][e] = pe; ps += pe; }
    G.l = G.l * alpha + ps;
#pragma unroll
    for (int dt = 0; dt < 4; ++dt) G.o[dt] *= alpha;
#pragma unroll
    for (int ks = 0; ks < 2; ++ks) { uint4 w = {pack2(sc[2 * ks][0], sc[2 * ks][1]), pack2(sc[2 * ks][2], sc[2 * ks][3]), pack2(sc[2 * ks + 1][0], sc[2 * ks + 1][1]), pack2(sc[2 * ks + 1][2], sc[2 * ks + 1][3])};
        pf[ks] = __builtin_bit_cast(bf16x8, w); }
}
DI void attn_tile2(const char* sk, const char* sv, const float* tab, QG& A, QG& B, int qposA, int dlt, int lane) {
    const int q = lane & 15, g = lane >> 4;
    f32x4 sa[4], sb[4];
#pragma unroll
    for (int kt = 0; kt < 4; ++kt) {
        const bf16x8 a0 = *(const bf16x8*)(sk + swz(16 * kt + q, g)); const bf16x8 a1 = *(const bf16x8*)(sk + swz(16 * kt + q, 4 + g));
        f32x4 x = {0.f, 0.f, 0.f, 0.f}, y = {0.f, 0.f, 0.f, 0.f};
        x = __builtin_amdgcn_mfma_f32_16x16x32_bf16(a0, A.q0, x, 0, 0, 0); y = __builtin_amdgcn_mfma_f32_16x16x32_bf16(a0, B.q0, y, 0, 0, 0);
        x = __builtin_amdgcn_mfma_f32_16x16x32_bf16(a1, A.q1, x, 0, 0, 0); y = __builtin_amdgcn_mfma_f32_16x16x32_bf16(a1, B.q1, y, 0, 0, 0);
        sa[kt] = x; sb[kt] = y;
    }
    bf16x8 pa[2], pb[2];
    attn_softmax(sa, tab, A, qposA, dlt, g, pa);
    attn_softmax(sb, tab, B, qposA + 16, dlt, g, pb);
#pragma unroll
    for (int dt = 0; dt < 4; ++dt)
#pragma unroll
        for (int ks = 0; ks < 2; ++ks) {
            const int vr = 32 * ks + 4 * g + (q >> 2); const int col = 16 * dt + 4 * (q & 3);
            const s16x4 lo = tr16(sv + swz(vr, col >> 3) + (col & 7) * 2); const s16x4 hi = tr16(sv + swz(vr + 16, col >> 3) + (col & 7) * 2);
            const bf16x8 vf = {lo[0], lo[1], lo[2], lo[3], hi[0], hi[1], hi[2], hi[3]};
            A.o[dt] = __builtin_amdgcn_mfma_f32_16x16x32_bf16(vf, pa[ks], A.o[dt], 0, 0, 0);
            B.o[dt] = __builtin_amdgcn_mfma_f32_16x16x32_bf16(vf, pb[ks], B.o[dt], 0, 0, 0);
        }
}
DI void attn_block2(const Params& p, int bh, int cp, char* lds) {
    int tid = threadIdx.x; asm volatile("" : "+v"(tid));
    const int lane = tid & 63, wave = __builtin_amdgcn_readfirstlane(tid >> 6);
    const u16* proj = (const u16*)(p.ws + W_PROJ);
    const int b = bh >> 3, h = bh & 7, c0 = 2 * cp, cq = c0 + (wave >> 1);
    const int qposA = (wave & 1) * 32 + (lane & 15); const int qrowA = b * 8192 + cq * 64 + qposA;
    float* tab = (float*)(lds + 49152);
    __syncthreads();
    for (int i = tid; i < 257; i += 256) tab[i] = p.relb[h * 257 + i] * LOG2E;
    QG A, B;
    { const u16* qp = proj + (size_t)qrowA * NC + C_Q + h * 64 + 8 * (lane >> 4); A.q0 = *(const bf16x8*)qp; A.q1 = *(const bf16x8*)(qp + 32);
      const u16* qb = qp + (size_t)16 * NC; B.q0 = *(const bf16x8*)qb; B.q1 = *(const bf16x8*)(qb + 32); }
    A.m = -INFINITY; A.l = 0.f; B.m = -INFINITY; B.l = 0.f;
#pragma unroll
    for (int dt = 0; dt < 4; ++dt) { A.o[dt] = (f32x4){0.f, 0.f, 0.f, 0.f}; B.o[dt] = (f32x4){0.f, 0.f, 0.f, 0.f}; }
    unsigned soff[2];
#pragma unroll
    for (int i = 0; i < 2; ++i) { const int row = 8 * (i * 4 + wave) + (lane >> 3); const int ch = (lane & 7) ^ ((row >> 1) & 7); soff[i] = (unsigned)(row * NC + ch * 8); }
    const u16* kbase = proj + (size_t)(b * 8192) * NC + h * 64;
#define ASTAGE2(buf, kc) do { const u16* kr = kbase + (size_t)((kc) * 64) * NC; _Pragma("unroll") for (int i = 0; i < 2; ++i) { \
        __builtin_amdgcn_global_load_lds((const unsigned*)(kr + soff[i] + C_K), (LAS unsigned*)(lds + (buf) * 8192 + (i * 4 + wave) * 1024), 16, 0, 0); \
        __builtin_amdgcn_global_load_lds((const unsigned*)(kr + soff[i] + C_V), (LAS unsigned*)(lds + 24576 + (buf) * 8192 + (i * 4 + wave) * 1024), 16, 0, 0); } } while (0)
    const int lo = c0 >= 8 ? c0 - 8 : 0, hi = c0 + 1;
    __syncthreads();
    ASTAGE2(0, lo); ASTAGE2(1, lo + 1);
    int buf = 0;
    for (int kc = lo; kc <= hi; ++kc) {
        if (kc < hi) asm volatile("s_waitcnt vmcnt(4) lgkmcnt(0)" ::: "memory"); else asm volatile("s_waitcnt vmcnt(0) lgkmcnt(0)" ::: "memory");
        __builtin_amdgcn_s_barrier();
        asm volatile("" ::: "memory");
        const int nb2 = buf >= 1 ? buf - 1 : 2;
        if (kc + 2 <= hi) ASTAGE2(nb2, kc + 2);
        const int dlt = cq - kc;
        if (dlt >= 0 && dlt <= 8) attn_tile2(lds + buf * 8192, lds + 24576 + buf * 8192, tab, A, B, qposA, dlt, lane);
        buf = buf == 2 ? 0 : buf + 1;
    }
#undef ASTAGE2
    attn_finish(p, A.l, A.o, qrowA, h, lane);
    attn_finish(p, B.l, B.o, qrowA + 16, h, lane);
}

DI void attn_block_sample(const Params& p, int s, char* lds) {
    int tid = threadIdx.x; asm volatile("" : "+v"(tid));
    const int lane = tid & 63, wave = __builtin_amdgcn_readfirstlane(tid >> 6);
    char* wl = lds + wave * 18432;
    char* sk = wl; char* sv = wl + 8192; float* tab = (float*)(wl + 16384);
    const u16* proj = (const u16*)(p.ws + W_PROJ);
    const int b = s >> 3, h = s & 7; const int qrow0 = NTP + b * 16;
    for (int i = lane; i < 257; i += 64) tab[i] = p.relb[h * 257 + i] * LOG2E;
    const int q = lane & 15, g = lane >> 4;
    const u16* qp = proj + (size_t)(qrow0 + q) * NC + C_Q + h * 64 + 8 * g;
    const bf16x8 qf0 = *(const bf16x8*)qp, qf1 = *(const bf16x8*)(qp + 32);
    float m = -INFINITY, l = 0.f; f32x4 o[4];
#pragma unroll
    for (int dt = 0; dt < 4; ++dt) o[dt] = (f32x4){0.f, 0.f, 0.f, 0.f};
    const int lrow = lane >> 3, lch = lane & 7;
    float4 rk[16], rv[16];
#define SLOAD(dl) do { const size_t off_ = ((size_t)(b * 8 + h) * 512 + (8 - (dl)) * 64) * 64 + lrow * 64 + lch * 8; \
        _Pragma("unroll") for (int i = 0; i < 8; ++i) { const float* a_ = p.cache_k + off_ + i * 512; const float* c_ = p.cache_v + off_ + i * 512; \
            rk[2 * i] = *(const float4*)a_; rk[2 * i + 1] = *(const float4*)(a_ + 4); rv[2 * i] = *(const float4*)c_; rv[2 * i + 1] = *(const float4*)(c_ + 4); } } while (0)
#define SWRITE() do { _Pragma("unroll") for (int i = 0; i < 8; ++i) { const int row = i * 8 + lrow; \
            uint4 kv = {pack2(rk[2 * i].x, rk[2 * i].y), pack2(rk[2 * i].z, rk[2 * i].w), pack2(rk[2 * i + 1].x, rk[2 * i + 1].y), pack2(rk[2 * i + 1].z, rk[2 * i + 1].w)}; \
            uint4 vv = {pack2(rv[2 * i].x, rv[2 * i].y), pack2(rv[2 * i].z, rv[2 * i].w), pack2(rv[2 * i + 1].x, rv[2 * i + 1].y), pack2(rv[2 * i + 1].z, rv[2 * i + 1].w)}; \
            *(uint4*)(sk + swz(row, lch)) = kv; *(uint4*)(sv + swz(row, lch)) = vv; } } while (0)
    const int d0 = 8 - 2 * wave;
    SLOAD(d0);
    asm volatile("s_waitcnt lgkmcnt(0)" ::: "memory");
    SWRITE();
    SLOAD(d0 - 1);
    asm volatile("s_waitcnt lgkmcnt(0)" ::: "memory");
    attn_tile(sk, sv, tab, qf0, qf1, m, l, o, q, d0, 64, lane);
    asm volatile("s_waitcnt lgkmcnt(0)" ::: "memory");
    SWRITE();
    asm volatile("s_waitcnt lgkmcnt(0)" ::: "memory");
    attn_tile(sk, sv, tab, qf0, qf1, m, l, o, q, d0 - 1, 64, lane);
#undef SLOAD
#undef SWRITE
    if (wave == 3) {
        asm volatile("s_waitcnt lgkmcnt(0)" ::: "memory");
#pragma unroll
        for (int i = 0; i < 8; ++i) { const int row = i * 8 + lrow; uint4 kv = {0, 0, 0, 0}, vv = {0, 0, 0, 0};
            if (row < 16) { const u16* sp = proj + (size_t)(qrow0 + row) * NC + h * 64 + lch * 8; kv = *(const uint4*)(sp + C_K); vv = *(const uint4*)(sp + C_V); }
            *(uint4*)(sk + swz(row, lch)) = kv; *(uint4*)(sv + swz(row, lch)) = vv; }
        asm volatile("s_waitcnt lgkmcnt(0)" ::: "memory");
        attn_tile(sk, sv, tab, qf0, qf1, m, l, o, q, 0, 16, lane);
    }
    l = xadd16(l); l = xadd32(l);
    asm volatile("s_waitcnt lgkmcnt(0)" ::: "memory");
    float* cm = (float*)wl; float* cl = cm + 16; float* co = cm + 32;
    if (g == 0) { cm[q] = m; cl[q] = l; }
#pragma unroll
    for (int dt = 0; dt < 4; ++dt) *(f32x4*)(co + q * 64 + 16 * dt + 4 * g) = o[dt];
    __syncthreads();
    {
        float mw[4], M = -INFINITY;
#pragma unroll
        for (int w = 0; w < 4; ++w) { mw[w] = ((const float*)(lds + w * 18432))[q]; M = fmaxf(M, mw[w]); }
        float L = 0.f; f32x4 O = {0.f, 0.f, 0.f, 0.f};
#pragma unroll
        for (int w = 0; w < 4; ++w) { const float* base = (const float*)(lds + w * 18432); const float f = __builtin_amdgcn_exp2f(mw[w] - M);
            L += base[16 + q] * f; const f32x4 ov = *(const f32x4*)(base + 32 + q * 64 + 16 * wave + 4 * g); O += ov * f; }
        const float inv = rcpf_(L); const int qrow = qrow0 + q; const int d = 16 * wave + 4 * g;
        const uint2 gg = *(const uint2*)(proj + (size_t)qrow * NC + C_GA + h * 64 + d);
        uint2 w2; w2.x = pack2(O[0] * inv * silu(bflo(gg.x)), O[1] * inv * silu(bfhi(gg.x))); w2.y = pack2(O[2] * inv * silu(bflo(gg.y)), O[3] * inv * silu(bfhi(gg.y)));
        *(uint2*)((u16*)(p.ws + W_XB) + (size_t)qrow * DM + h * 64 + d) = w2;
    }
    __syncthreads();
}

DI void phase_scan_attn(const Params& p, char* lds) {
    const int tid = threadIdx.x, lane = tid & 63, wave = __builtin_amdgcn_readfirstlane(tid >> 6);
    if (blockIdx.x < 64) {
        if (wave == 0) { const int x_ = blockIdx.x & 7, k_ = blockIdx.x >> 3;
            scan_item(p, (x_ + 8 * (k_ >> 2)) * 4 + (k_ & 3), lane); }
        return;
    }
    unsigned* ctr = (unsigned*)(p.ws + W_BAR) + 3456;
    volatile LAS int* slot = (volatile LAS int*)(lds + 75264);
    const int q0 = (int)((unsigned)__builtin_amdgcn_s_getreg((3 << 11) | 20) & 7u);
    for (int v = 0; v < 8; ++v) {
        const int q = (q0 + v) & 7;
        for (;;) {
            __syncthreads();
            if (tid == 0) *slot = (int)__hip_atomic_fetch_add(ctr + 16 * q, 1u, __ATOMIC_RELAXED, __HIP_MEMORY_SCOPE_AGENT);
            __syncthreads();
            const int item = *slot;
            if (item >= 32 + 128 + 32) break;
            if (item < 32) attn_block_sample(p, 32 * q + item, lds);
            else if (item < 160) { const int j = item - 32; attn_block2(p, 2 * q + (j & 1), 63 - (j >> 1), lds); }
            else scan_item(p, 64 + (32 * q + item - 160) * 4 + wave, lane);
        }
    }
}

DI void phase_rwkv_out(const Params& p, char* lds) {
    const int tid = threadIdx.x, lane = tid & 63, wave = tid >> 6;
    float* pw = (float*)(lds + wave * 1024);
    const int gw = blockIdx.x * 4 + wave, nw = gridDim.x * 4;
    const int i16 = lane & 15, g = lane >> 4;
    const u16* proj = (const u16*)(p.ws + W_PROJ); const u16* QT = (const u16*)(p.ws + W_QT); const u16* SST = (const u16*)(p.ws + W_SST);
    const float* bonus = (const float*)(p.ws + W_BONUS);
    for (int wu = gw; wu < 8192 + 256; wu += nw) {
        int u, tg, b, h, c = 0, row0; bool prm = wu < 8192;
        if (prm) { u = wu >> 2; tg = wu & 3; b = u >> 10; h = (u >> 7) & 7; c = u & 127; row0 = b * 8192 + c * 64; }
        else { const int s = wu - 8192; u = 2048 + s; tg = 0; b = s >> 3; h = s & 7; row0 = NTP + b * 16; }
        const int t = 16 * tg + i16; const int row = row0 + t;
        u16* z = (u16*)(p.ws + W_XB) + (size_t)row * DM + 512 + h * 64;
        const u16* qt = QT + (size_t)u * 4096 + t * 64 + 8 * g; const bf16x8 bq0 = *(const bf16x8*)qt, bq1 = *(const bf16x8*)(qt + 32);
        { const float a_ = p.mix[1024 + h * 64 + lane], b_ = p.gn_g[h * 64 + lane], c_ = p.gn_b[h * 64 + lane];
            asm volatile("s_waitcnt lgkmcnt(0)" ::: "memory"); pw[lane] = a_; pw[64 + lane] = b_; pw[128 + lane] = c_; asm volatile("s_waitcnt lgkmcnt(0)" ::: "memory"); }
        const int wofs = 16 * (g & 1) + 8 * (g >> 1);
        const int mode = t > 0 ? 0 : (prm ? (c > 0 ? 0 : 1) : 2);
        uint2 ylw[4], cvw[4], grw[4], pvw[4];
        { const u16* pr_ = proj + (size_t)row * NC + h * 64 + wofs; const u16* pp_ = proj + (size_t)(mode == 0 ? row - 1 : row) * NC + C_RV + h * 64 + wofs;
#pragma unroll
            for (int mp = 0; mp < 2; ++mp) {
                unwiden16(*(const uint4*)(z + 32 * mp + wofs), ylw[2 * mp], ylw[2 * mp + 1]);
                unwiden16(*(const uint4*)(pr_ + C_RV + 32 * mp), cvw[2 * mp], cvw[2 * mp + 1]);
                unwiden16(*(const uint4*)(pr_ + C_GR + 32 * mp), grw[2 * mp], grw[2 * mp + 1]);
                unwiden16(*(const uint4*)(pp_ + 32 * mp), pvw[2 * mp], pvw[2 * mp + 1]); } }
        f32x4 y[4];
#pragma unroll
        for (int mt = 0; mt < 4; ++mt) {
            const uint2 yl = ylw[mt]; f32x4 a = {bflo(yl.x), bfhi(yl.x), bflo(yl.y), bfhi(yl.y)};
            const u16* sp = SST + (size_t)u * 4096 + (16 * mt + i16) * 64 + 8 * g;
            a = __builtin_amdgcn_mfma_f32_16x16x32_bf16(*(const bf16x8*)sp, bq0, a, 0, 0, 0); a = __builtin_amdgcn_mfma_f32_16x16x32_bf16(*(const bf16x8*)(sp + 32), bq1, a, 0, 0, 0);
            y[mt] = a;
        }
        float s1 = 0.f;
#pragma unroll
        for (int mt = 0; mt < 4; ++mt) s1 += (y[mt][0] + y[mt][1]) + (y[mt][2] + y[mt][3]);
        s1 = xadd16(s1); s1 = xadd32(s1);
        const float mu = s1 * (1.f / 64.f); float s2 = 0.f;
#pragma unroll
        for (int mt = 0; mt < 4; ++mt)
#pragma unroll
            for (int e = 0; e < 4; ++e) { const float d = y[mt][e] - mu; s2 += d * d; }
        s2 = xadd16(s2); s2 = xadd32(s2);
        const float rs = __builtin_amdgcn_rsqf(s2 * (1.f / 64.f) + 64e-5f);
        const float bon = bonus[(size_t)u * 64 + t];
        uint2 wz[4];
#pragma unroll
        for (int mt = 0; mt < 4; ++mt) {
            const int i0 = 16 * mt + 4 * g; const int hj = h * 64 + i0;
            const uint2 cvp = cvw[mt]; const float cv[4] = {bflo(cvp.x), bfhi(cvp.x), bflo(cvp.y), bfhi(cvp.y)};
            float pv[4];
            if (mode == 0) { const uint2 w = pvw[mt]; pv[0] = bflo(w.x); pv[1] = bfhi(w.x); pv[2] = bflo(w.y); pv[3] = bfhi(w.y); }
            else if (mode == 1) { pv[0] = pv[1] = pv[2] = pv[3] = 0.f; }
            else { const float4 w = *(const float4*)(p.st_shift + (size_t)b * 1664 + 1024 + hj); pv[0] = w.x; pv[1] = w.y; pv[2] = w.z; pv[3] = w.w; }
            const float4 mv = *(const float4*)(pw + i0), gg = *(const float4*)(pw + 64 + i0), gb = *(const float4*)(pw + 128 + i0);
            const float mvv[4] = {mv.x, mv.y, mv.z, mv.w}, ggv[4] = {gg.x, gg.y, gg.z, gg.w}, gbv[4] = {gb.x, gb.y, gb.z, gb.w};
            const uint2 grp = grw[mt]; const float gr[4] = {bflo(grp.x), bfhi(grp.x), bflo(grp.y), bfhi(grp.y)};
            float ov[4];
#pragma unroll
            for (int e = 0; e < 4; ++e) { const float xv = cv[e] + (pv[e] - cv[e]) * mvv[e]; const float yn = (y[mt][e] - mu) * rs * ggv[e] + gbv[e] + bon * xv; ov[e] = yn * silu(gr[e]); }
            wz[mt].x = pack2(ov[0], ov[1]); wz[mt].y = pack2(ov[2], ov[3]);
        }
#pragma unroll
        for (int mt = 0; mt < 4; mt += 2) *(uint4*)(z + 16 * (mt + (g & 1)) + 8 * (g >> 1)) = widen16(wz[mt], wz[mt + 1]);
    }
}


#define XB_TMO      128
#define XB_XCNT(j)  (256  + 64 * (j))
#define XB_XSUB(j)  (1280 + 64 * (j))
#define XB_XGEN(j)  (2304 + 64 * (j))
#define XB_TOP      3328
#define XB_TOPGEN   3392
#define XCD_BAR_WORDS 3456
#define XB_SPIN_CAP (1u << 18)
DI unsigned xb_ld(unsigned* p) { return __hip_atomic_load(p, __ATOMIC_RELAXED, __HIP_MEMORY_SCOPE_AGENT); }
DI unsigned xb_add(unsigned* p, unsigned v) { return __hip_atomic_fetch_add(p, v, __ATOMIC_RELAXED, __HIP_MEMORY_SCOPE_AGENT); }
DI unsigned xb_xcc_id() { return (unsigned)__builtin_amdgcn_s_getreg((3 << 11) | 20) & 0xFu; }
#define XB_SPIN(cond, bar) do { unsigned _sp = 0; while (cond) { __builtin_amdgcn_s_sleep(2); \
    if ((++_sp & 255u) == 0u) { if (xb_ld(&(bar)[XB_TMO])) break; if (_sp > XB_SPIN_CAP) { atomicAdd(&(bar)[XB_TMO], 1u); break; } } } } while (0)
struct XcdBarrier { unsigned* bar; unsigned x; volatile LAS unsigned* st; };
DI XcdBarrier xcd_barrier_post(unsigned* bar, volatile LAS unsigned* st) {
    XcdBarrier b; b.bar = bar; b.x = xb_xcc_id(); b.st = st;
    if (threadIdx.x == 0) (void)xb_add(&bar[XB_XCNT(b.x)], 1u);
    return b;
}
DI void xcd_barrier_complete(unsigned* bar, unsigned x, unsigned& nloc, unsigned& nx) {
    const unsigned G = gridDim.x * gridDim.y * gridDim.z;
    unsigned sum, cnt, mine, sp = 0u;
    for (;;) {
        sum = 0u; cnt = 0u; mine = 0u;
#pragma unroll
        for (unsigned j = 0; j < 16; ++j) { const unsigned c = xb_ld(&bar[XB_XCNT(j)]); sum += c; cnt += (c > 0u) ? 1u : 0u; mine = (j == x) ? c : mine; }
        if (sum == G) break;
        __builtin_amdgcn_s_sleep(1);
        if ((++sp & 255u) == 0u) { if (xb_ld(&bar[XB_TMO])) break; if (sp > XB_SPIN_CAP) { atomicAdd(&bar[XB_TMO], 1u); break; } }
    }
    nloc = mine > 0u ? mine : 1u; nx = cnt > 0u ? cnt : 1u;
}
DI void xcd_barrier(const XcdBarrier& b) {
    asm volatile("s_waitcnt vmcnt(0)" ::: "memory");
    __syncthreads();
    if (threadIdx.x == 0) {
        unsigned* bar = b.bar;
        __builtin_amdgcn_s_waitcnt(0);
        unsigned nloc = b.st[0], nx = b.st[1];
        if (nloc == 0u) { xcd_barrier_complete(bar, b.x, nloc, nx); b.st[0] = nloc; b.st[1] = nx; }
        const unsigned old = xb_add(&bar[XB_XSUB(b.x)], 1u);
        const unsigned gen = old / nloc;
        if (old + 1u == (gen + 1u) * nloc) {
            __builtin_amdgcn_fence(__ATOMIC_RELEASE, "agent");
            asm volatile("s_waitcnt vmcnt(0)" ::: "memory");
            const unsigned og = xb_add(&bar[XB_TOP], 1u);
            const unsigned tg = og / nx;
            if (og + 1u == (tg + 1u) * nx) xb_add(&bar[XB_TOPGEN], 1u);
            else XB_SPIN(xb_ld(&bar[XB_TOPGEN]) == tg, bar);
            __builtin_amdgcn_fence(__ATOMIC_ACQUIRE, "agent");
            xb_add(&bar[XB_XGEN(b.x)], 1u);
            asm volatile("s_waitcnt vmcnt(0)" ::: "memory");
        } else {
            XB_SPIN(xb_ld(&bar[XB_XGEN(b.x)]) == gen, bar);
            __builtin_amdgcn_fence(__ATOMIC_ACQUIRE, "agent");
            asm volatile("s_waitcnt vmcnt(0)" ::: "memory");
        }
    }
    __syncthreads();
}

DI void run_phase(const Params& p, char* lds, int ph) {
    if (ph == 0) phase_prep(p, lds);
    else if (ph == 1) { Epi1 e{&p}; gemm_phase((const u16*)(p.ws + W_XB), (const u16*)(p.ws + W_WINT), 132, 33, lds, e); }
    else if (ph == 2) phase_rwkv_prep(p, lds);
    else if (ph == 3) phase_scan_attn(p, lds);
    else if (ph == 4) phase_rwkv_out(p, lds);
    else gemm_out(p, lds);
}

extern "C" __global__ void __launch_bounds__(256, 2) hymba_mega(Params p, int ph_lo, int ph_hi) {
    extern __shared__ __attribute__((aligned(16))) char lds[];
#if ONE_LAUNCH
    volatile LAS unsigned* st = (volatile LAS unsigned*)(lds + 75520);
    if (threadIdx.x == 0) { st[0] = 0u; st[1] = 0u; st[2] = 0u; st[3] = 0u; }
    __syncthreads();
    const XcdBarrier xb = xcd_barrier_post((unsigned*)(p.ws + W_BAR), st);
#ifndef PROBE_REP
#define PROBE_REP -1
#endif
#define RUNP(k) do { run_phase(p, lds, k); if (PROBE_REP == k) { xcd_barrier(xb); run_phase(p, lds, k); } } while (0)
    RUNP(0); xcd_barrier(xb);
    RUNP(1); xcd_barrier(xb);
    RUNP(2); xcd_barrier(xb);
    RUNP(3); xcd_barrier(xb);
    run_phase(p, lds, 4); xcd_barrier(xb);
    RUNP(5);
#else
    run_phase(p, lds, ph_lo);
#endif
}

extern "C" void kernel_launch(void* const* d_in, const int* in_sizes, int n_in, void* d_out, int out_size, void* d_ws, size_t ws_size, hipStream_t stream) {
    Params p{};
    const float** f = (const float**)&p;
    for (int i = 0; i < 22; ++i) f[i] = (const float*)d_in[i];
    p.out = (float*)d_out; p.ws = (char*)d_ws;
    static int grid_blocks = 0;
    if (!grid_blocks) {
        hipFuncSetAttribute((const void*)hymba_mega, hipFuncAttributeMaxDynamicSharedMemorySize, LDS_BYTES);
        int dev = 0, cus = 0, per_cu = 0;
        hipGetDevice(&dev);
        hipDeviceGetAttribute(&cus, hipDeviceAttributeMultiprocessorCount, dev);
        hipOccupancyMaxActiveBlocksPerMultiprocessor(&per_cu, hymba_mega, 256, LDS_BYTES);
        if (per_cu > 2) per_cu = 2;
        if (per_cu < 1) per_cu = 1;
        grid_blocks = cus * per_cu;
    }
#if ONE_LAUNCH
    int lo = 0, hi = 5;
    (void)hipMemsetAsync((char*)d_ws + W_BAR, 0, (XCD_BAR_WORDS + 128) * 4, stream);
    void* args[] = {&p, &lo, &hi};
    hipError_t e = hipLaunchCooperativeKernel((void*)hymba_mega, dim3(grid_blocks), dim3(256), args, LDS_BYTES, stream);
    if (e != hipSuccess) fprintf(stderr, "cooperative launch failed: %s (grid %d)\n", hipGetErrorString(e), grid_blocks);
#else
    for (int ph = 0; ph < 6; ++ph) hipLaunchKernelGGL(hymba_mega, dim3(grid_blocks), dim3(256), LDS_BYTES, stream, p, ph, ph);
#endif
}
```

```cpp
#include <hip/hip_runtime.h>
#include <hip/hip_cooperative_groups.h>
#include <cstdio>
#include <cstdint>
namespace cg = cooperative_groups;

#ifndef ONE_LAUNCH
#define ONE_LAUNCH 1
#endif

#define DI __device__ __forceinline__
#define LAS __attribute__((address_space(3)))
typedef unsigned short u16;
typedef short bf16x8 __attribute__((ext_vector_type(8)));
typedef short s16x4 __attribute__((ext_vector_type(4)));
typedef float f32x4 __attribute__((ext_vector_type(4)));
typedef float f32x16 __attribute__((ext_vector_type(16)));
typedef float f32x2_t __attribute__((ext_vector_type(2)));
typedef __bf16 bf16x2_t __attribute__((ext_vector_type(2)));
typedef __attribute__((address_space(3))) s16x4 lds_s16x4;

constexpr int DM = 1024, NC = 4224, NTP = 16384, NTS = 512, NTOK = 16896;
constexpr int C_Q = 0, C_K = 512, C_V = 1024, C_GA = 1536, C_R = 2048, C_RK = 2560, C_RV = 3072, C_WD = 3584, C_AD = 3648, C_GR = 3712;
constexpr int NUNIT = 2304;
constexpr size_t O_YP = 0, O_YS = 16777216, O_KP = 17301504, O_VP = 17825792, O_KS = 18350080, O_VS = 18612224,
                 O_SP = 18874368, O_SS = 18939904, O_SHP = 19988480, O_SHS = 19991808;
constexpr size_t W_XB = 0, W_WINT = 34603008, W_WOUTT = 43253760, W_WUPT = 45350912, W_AUPT = 45416448, W_RSTD = 45481984,
                 W_BONUS = 264339456  , W_PROJ = 46090240, W_GT = 188827648, W_HH = 207702016, W_QT = 226576384, W_SST = 245450752, W_BAR = 264325120;
constexpr int LDS_BYTES = 75776;
constexpr float LOG2E = 1.4426950408889634f;

struct Params {
    const float *x_p, *x_s, *cache_k, *cache_v, *st_wkv, *st_shift, *norm_g, *w_in, *q_g, *k_g, *relb, *mix, *w0, *w_up, *a0, *a_up,
        *k_k, *k_a, *r_k, *gn_g, *gn_b, *w_out;
    float* out;
    char* ws;
};

DI unsigned pack2(float lo, float hi) { f32x2_t v = {lo, hi}; bf16x2_t b = __builtin_convertvector(v, bf16x2_t); return __builtin_bit_cast(unsigned, b); }
DI u16 f2bf(float f) { return (u16)(pack2(f, 0.f) & 0xffffu); }
DI float bflo(unsigned u) { return __uint_as_float(u << 16); }
DI float bfhi(unsigned u) { return __uint_as_float(u & 0xffff0000u); }
DI float bf2f(u16 h) { return __uint_as_float((unsigned)h << 16); }
DI int swz(int row, int ch) { return row * 128 + ((ch ^ ((row >> 1) & 7)) << 4); }
DI float dpp_add(float v, const int ctrl_sel) {
    int x = __float_as_int(v), y;
    if (ctrl_sel == 0) y = __builtin_amdgcn_update_dpp(0, x, 0xB1, 0xf, 0xf, true);
    else if (ctrl_sel == 1) y = __builtin_amdgcn_update_dpp(0, x, 0x4E, 0xf, 0xf, true);
    else if (ctrl_sel == 2) y = __builtin_amdgcn_update_dpp(0, x, 0x141, 0xf, 0xf, true);
    else y = __builtin_amdgcn_update_dpp(0, x, 0x140, 0xf, 0xf, true);
    return v + __int_as_float(y);
}
DI float wave_sum(float v) {
    v = dpp_add(v, 0); v = dpp_add(v, 1); v = dpp_add(v, 2); v = dpp_add(v, 3);
    const int x = __float_as_int(v);
    const float a = __int_as_float(__builtin_amdgcn_readlane(x, 0)), b = __int_as_float(__builtin_amdgcn_readlane(x, 16)),
                c = __int_as_float(__builtin_amdgcn_readlane(x, 32)), d = __int_as_float(__builtin_amdgcn_readlane(x, 48));
    return (a + b) + (c + d);
}
DI float rcpf_(float x) { return __builtin_amdgcn_rcpf(x); }
DI float4 ntld4(const float* p) { const f32x4 v = __builtin_nontemporal_load((const f32x4*)p); return (float4){v[0], v[1], v[2], v[3]}; }
DI float silu(float x) { return x * rcpf_(1.f + __expf(-x)); }
DI float xadd16(float v) { const unsigned x = __float_as_uint(v); auto r = __builtin_amdgcn_permlane16_swap(x, x, false, false); return __uint_as_float(r[0]) + __uint_as_float(r[1]); }
DI float xadd32(float v) { const unsigned x = __float_as_uint(v); auto r = __builtin_amdgcn_permlane32_swap(x, x, false, false); return __uint_as_float(r[0]) + __uint_as_float(r[1]); }
DI float xmax16(float v) { const unsigned x = __float_as_uint(v); auto r = __builtin_amdgcn_permlane16_swap(x, x, false, false); return fmaxf(__uint_as_float(r[0]), __uint_as_float(r[1])); }
DI uint4 widen16(uint2 w0, uint2 w1) {
    auto rx = __builtin_amdgcn_permlane16_swap(w0.x, w1.x, false, false); auto ry = __builtin_amdgcn_permlane16_swap(w0.y, w1.y, false, false);
    return (uint4){rx[0], ry[0], rx[1], ry[1]};
}
DI void unwiden16(uint4 L, uint2& w0, uint2& w1) {
    auto rx = __builtin_amdgcn_permlane16_swap(L.x, L.z, false, false); auto ry = __builtin_amdgcn_permlane16_swap(L.y, L.w, false, false);
    w0 = (uint2){rx[0], ry[0]}; w1 = (uint2){rx[1], ry[1]};
}
DI float xmax32(float v) { const unsigned x = __float_as_uint(v); auto r = __builtin_amdgcn_permlane32_swap(x, x, false, false); return fmaxf(__uint_as_float(r[0]), __uint_as_float(r[1])); }
DI void unpack8(uint4 u, float* o) {
    o[0] = bflo(u.x); o[1] = bfhi(u.x); o[2] = bflo(u.y); o[3] = bfhi(u.y); o[4] = bflo(u.z); o[5] = bfhi(u.z); o[6] = bflo(u.w); o[7] = bfhi(u.w);
}

DI void transpose_tile(const float* W, int K, int N, const float* gain, u16* dst, float* tile, int t) {
    const int nkt = K / 64; const int kt = t % nkt, nt = t / nkt; const int k0 = kt * 64, n0 = nt * 64;
    const int tid = threadIdx.x, lane = tid & 63, wave = tid >> 6;
    float4 wv[4];
#pragma unroll
    for (int i = 0; i < 4; ++i) { const int idx = tid + 256 * i; wv[i] = *(const float4*)(W + (size_t)(k0 + (idx >> 4)) * N + n0 + 4 * (idx & 15)); }
    const float gl = gain ? gain[k0 + lane] : 1.f;
#pragma unroll
    for (int i = 0; i < 4; ++i) { const int kr = 16 * i + 4 * wave + (lane >> 4);
        const float g = __shfl(gl, kr); float* tp = tile + kr * 65 + 4 * (lane & 15);
        tp[0] = wv[i].x * g; tp[1] = wv[i].y * g; tp[2] = wv[i].z * g; tp[3] = wv[i].w * g; }
    __syncthreads();
#pragma unroll 4
    for (int i = 0; i < 8; ++i) { const int n = i * 8 + (tid >> 5); const int kp = tid & 31;
        const unsigned v = pack2(tile[(2 * kp) * 65 + n], tile[(2 * kp + 1) * 65 + n]); *(unsigned*)(dst + (size_t)(n0 + n) * K + k0 + 2 * kp) = v; }
    __syncthreads();
}
DI void phase_prep(const Params& p, char* lds) {
    const int tid = threadIdx.x, lane = tid & 63, wave = tid >> 6;
    u16* xb = (u16*)(p.ws + W_XB); float* rstd = (float*)(p.ws + W_RSTD);
    for (int rg = blockIdx.x * 4 + wave; rg < NTOK / 4; rg += gridDim.x * 4) {
        float4 v[4][4]; float ss[4];
#pragma unroll
        for (int k = 0; k < 4; ++k) { const int row = rg * 4 + k; const float* src = row < NTP ? p.x_p + (size_t)row * DM : p.x_s + (size_t)(row - NTP) * DM;
#pragma unroll
            for (int i = 0; i < 4; ++i) v[k][i] = ((const float4*)src)[i * 64 + lane]; }
#pragma unroll
        for (int k = 0; k < 4; ++k) { float a = 0.f;
#pragma unroll
            for (int i = 0; i < 4; ++i) a += v[k][i].x * v[k][i].x + v[k][i].y * v[k][i].y + v[k][i].z * v[k][i].z + v[k][i].w * v[k][i].w;
            ss[k] = wave_sum(a); }
#pragma unroll
        for (int k = 0; k < 4; ++k) { const int row = rg * 4 + k;
            if (lane == 0) rstd[row] = rsqrtf(ss[k] * (1.f / 1024.f) + 1e-6f);
#pragma unroll
            for (int i = 0; i < 4; ++i) { uint2 w; w.x = pack2(v[k][i].x, v[k][i].y); w.y = pack2(v[k][i].z, v[k][i].w); *(uint2*)(xb + (size_t)row * DM + (i * 64 + lane) * 4) = w; } }
    }
    float* tile = (float*)lds;
    for (int t = blockIdx.x; t < 1056 + 256 + 16; t += gridDim.x) {
        if (t < 1056) transpose_tile(p.w_in, 1024, NC, p.norm_g, (u16*)(p.ws + W_WINT), tile, t);
        else if (t < 1312) transpose_tile(p.w_out, 1024, 1024, nullptr, (u16*)(p.ws + W_WOUTT), tile, t - 1056);
        else if (t < 1320) transpose_tile(p.w_up, 64, 512, nullptr, (u16*)(p.ws + W_WUPT), tile, t - 1312);
        else transpose_tile(p.a_up, 64, 512, nullptr, (u16*)(p.ws + W_AUPT), tile, t - 1320);
    }
}

template <class Epi>
DI void gemm_phase(const u16* __restrict__ A, const u16* __restrict__ B, int mtiles, int ntiles, char* lds, const Epi& epi) {
    const int ntile = mtiles * ntiles;
    const int vb = (blockIdx.x & 7) * (gridDim.x >> 3) + (blockIdx.x >> 3);
    const int npan = ntiles >> 3;
    int tile = vb; if (tile >= ntile) return;
#define TILE_MN(t, M0, N0) do { int pan_ = (t) / (mtiles * 8); if (pan_ >= npan) pan_ = npan - 1; const int pw_ = (pan_ == npan - 1) ? ntiles - 8 * pan_ : 8; const int loc_ = (t) - pan_ * mtiles * 8; \
        M0 = (loc_ / pw_) * 128; N0 = (8 * pan_ + loc_ % pw_) * 128; } while (0)
#define GSTAGE(buf, kt, GA, GB) do { _Pragma("unroll") for (int i = 0; i < 4; ++i) { \
            __builtin_amdgcn_global_load_lds((const unsigned*)((GA) + soff[i] + (kt) * 64), (LAS unsigned*)(lds + (buf) * 32768 + (i * 4 + wave) * 1024), 16, 0, 0); \
            __builtin_amdgcn_global_load_lds((const unsigned*)((GB) + soff[i] + (kt) * 64), (LAS unsigned*)(lds + (buf) * 32768 + 16384 + (i * 4 + wave) * 1024), 16, 0, 0); } } while (0)
    int m0, n0; TILE_MN(tile, m0, n0);
    {
        const int lane = threadIdx.x & 63, wave = __builtin_amdgcn_readfirstlane(threadIdx.x >> 6);
        unsigned soff[4];
#pragma unroll
        for (int i = 0; i < 4; ++i) { const int row = 8 * (i * 4 + wave) + (lane >> 3); const int ch = (lane & 7) ^ ((row >> 1) & 7); soff[i] = (unsigned)(row * 1024 + ch * 8); }
        GSTAGE(0, 0, A + (size_t)m0 * 1024, B + (size_t)n0 * 1024);
    }
    for (;;) {
        int tid = threadIdx.x; asm volatile("" : "+v"(tid));
        const int lane = tid & 63, wave = __builtin_amdgcn_readfirstlane(tid >> 6); const int wn = wave >> 1, wm = wave & 1; const int r = lane & 31, h = lane >> 5;
        f32x16 acc[2][2];
#pragma unroll
        for (int a = 0; a < 2; ++a)
#pragma unroll
            for (int b = 0; b < 2; ++b)
#pragma unroll
                for (int e = 0; e < 16; ++e) acc[a][b][e] = 0.f;
        unsigned soff[4];
#pragma unroll
        for (int i = 0; i < 4; ++i) { const int row = 8 * (i * 4 + wave) + (lane >> 3); const int ch = (lane & 7) ^ ((row >> 1) & 7); soff[i] = (unsigned)(row * 1024 + ch * 8); }
        const u16* ga = A + (size_t)m0 * 1024; const u16* gb = B + (size_t)n0 * 1024;
        __syncthreads();
        for (int kt = 0; kt < 16; ++kt) {
            if (kt + 1 < 16) GSTAGE((kt + 1) & 1, kt + 1, ga, gb);
            const char* sa = lds + (kt & 1) * 32768; const char* sb = sa + 16384;
#pragma unroll
            for (int ks = 0; ks < 4; ++ks) {
                bf16x8 fw[2], fx[2];
#pragma unroll
                for (int ct = 0; ct < 2; ++ct) fw[ct] = *(const bf16x8*)(sb + swz(wn * 64 + ct * 32 + r, 2 * ks + h));
#pragma unroll
                for (int tt = 0; tt < 2; ++tt) fx[tt] = *(const bf16x8*)(sa + swz(wm * 64 + tt * 32 + r, 2 * ks + h));
#pragma unroll
                for (int ct = 0; ct < 2; ++ct)
#pragma unroll
                    for (int tt = 0; tt < 2; ++tt) acc[ct][tt] = __builtin_amdgcn_mfma_f32_32x32x16_bf16(fw[ct], fx[tt], acc[ct][tt], 0, 0, 0);
            }
            __syncthreads();
        }
        const int nxt = tile + (int)gridDim.x; int m1 = 0, n1 = 0;
        if (nxt < ntile) { TILE_MN(nxt, m1, n1); GSTAGE(0, 0, A + (size_t)m1 * 1024, B + (size_t)n1 * 1024); }
        epi(acc, m0 + wm * 64, n0 + wn * 64, lane);
        if (nxt >= ntile) break;
        tile = nxt; m0 = m1; n0 = n1;
    }
#undef GSTAGE
#undef TILE_MN
}

struct Epi1 {
    const Params* p;
    DI void operator()(f32x16 (&acc)[2][2], int mrow0, int ncol0, int lane) const {
        const int r = lane & 31, h = lane >> 5; const int cb = ncol0 >> 6;
        u16* proj = (u16*)(p->ws + W_PROJ); const float* rstd = (const float*)(p->ws + W_RSTD); float* out = p->out;
#pragma unroll
        for (int tt = 0; tt < 2; ++tt) {
            const int row = mrow0 + tt * 32 + r; const float rs = rstd[row];
            float v[2][16];
#pragma unroll
            for (int ct = 0; ct < 2; ++ct)
#pragma unroll
                for (int e = 0; e < 16; ++e) v[ct][e] = acc[ct][tt][e] * rs;
            if (cb < 16) {
                float ss = 0.f;
#pragma unroll
                for (int ct = 0; ct < 2; ++ct)
#pragma unroll
                    for (int e = 0; e < 16; ++e) ss += v[ct][e] * v[ct][e];
                ss = xadd32(ss);
                const float inv = __builtin_amdgcn_rsqf(ss * (1.f / 64.f) + 1e-6f);
                const float* g = cb < 8 ? p->q_g : p->k_g;
#pragma unroll
                for (int ct = 0; ct < 2; ++ct)
#pragma unroll
                    for (int gq = 0; gq < 4; ++gq) { const float4 gg = *(const float4*)(g + ct * 32 + 8 * gq + 4 * h);
                        v[ct][4 * gq] *= inv * gg.x; v[ct][4 * gq + 1] *= inv * gg.y; v[ct][4 * gq + 2] *= inv * gg.z; v[ct][4 * gq + 3] *= inv * gg.w; }
            }
#pragma unroll
            for (int ct = 0; ct < 2; ++ct)
#pragma unroll
                for (int gq = 0; gq < 4; gq += 2) {
                    unsigned ax = pack2(v[ct][4 * gq], v[ct][4 * gq + 1]), ay = pack2(v[ct][4 * gq + 2], v[ct][4 * gq + 3]);
                    unsigned bx = pack2(v[ct][4 * gq + 4], v[ct][4 * gq + 5]), by = pack2(v[ct][4 * gq + 6], v[ct][4 * gq + 7]);
                    { auto rr = __builtin_amdgcn_permlane32_swap(ax, bx, false, false); ax = rr[0]; bx = rr[1]; }
                    { auto rr = __builtin_amdgcn_permlane32_swap(ay, by, false, false); ay = rr[0]; by = rr[1]; }
                    *(uint4*)(proj + (size_t)row * NC + ncol0 + ct * 32 + 8 * gq + 8 * h) = (uint4){ax, ay, bx, by};
                }
            float* dst = nullptr;
            if (cb >= 8 && cb < 24) {
                const int hh = cb & 7;
                if (row < NTP) { const int b = row >> 13, t = row & 8191; if (t >= 7680) dst = out + (cb < 16 ? O_KP : O_VP) + ((size_t)(b * 8 + hh) * 512 + (t - 7680)) * 64; }
                else { const int s = row - NTP; const int b = s >> 4, t = s & 15; dst = out + (cb < 16 ? O_KS : O_VS) + ((size_t)(b * 8 + hh) * 16 + t) * 64; }
            } else if (cb >= 32 && cb < 58) {
                if (row < NTP) { if ((row & 8191) == 8191) dst = out + O_SHP + (size_t)(row >> 13) * 1664 + (cb - 32) * 64; }
                else { const int s = row - NTP; if ((s & 15) == 15) dst = out + O_SHS + (size_t)(s >> 4) * 1664 + (cb - 32) * 64; }
            }
            if (dst) {
#pragma unroll
                for (int ct = 0; ct < 2; ++ct)
#pragma unroll
                    for (int gq = 0; gq < 4; ++gq) { float4 w = {v[ct][4 * gq], v[ct][4 * gq + 1], v[ct][4 * gq + 2], v[ct][4 * gq + 3]}; *(float4*)(dst + ct * 32 + 8 * gq + 4 * h) = w; }
            }
        }
    }
};
struct Epi2 {
    const Params* p;
    DI void operator()(f32x16 (&acc)[2][2], int mrow0, int ncol0, int lane) const {
        const int r = lane & 31, h = lane >> 5;
#pragma unroll
        for (int tt = 0; tt < 2; ++tt) {
            const int row = mrow0 + tt * 32 + r;
            const float* xr = row < NTP ? p->x_p + (size_t)row * DM : p->x_s + (size_t)(row - NTP) * DM;
            float* o = p->out + (size_t)row * DM;
#pragma unroll
            for (int ct = 0; ct < 2; ++ct)
#pragma unroll
                for (int gq = 0; gq < 4; ++gq) { const int col = ncol0 + ct * 32 + 8 * gq + 4 * h; const float4 xv = *(const float4*)(xr + col);
                    float4 w = {xv.x + acc[ct][tt][4 * gq], xv.y + acc[ct][tt][4 * gq + 1], xv.z + acc[ct][tt][4 * gq + 2], xv.w + acc[ct][tt][4 * gq + 3]}; *(float4*)(o + col) = w; }
        }
    }
};

DI void gemm_out(const Params& p, char* lds) {
    const u16* __restrict__ A = (const u16*)(p.ws + W_XB); const u16* __restrict__ B = (const u16*)(p.ws + W_WOUTT);
    const int ntile = 176 * 8;
    const int vb = (blockIdx.x & 7) * (gridDim.x >> 3) + (blockIdx.x >> 3);
    for (int tile = vb; tile < ntile; tile += gridDim.x) {
        int tid = threadIdx.x; asm volatile("" : "+v"(tid));
        const int lane = tid & 63, wave = __builtin_amdgcn_readfirstlane(tid >> 6); const int wn = wave >> 1, wm = wave & 1; const int q = lane & 15, g = lane >> 4;
        const int mt = tile >> 3, nt = tile & 7; const int m0 = mt * 96, n0 = nt * 128;
        f32x4 acc[4][3];
#pragma unroll
        for (int a = 0; a < 4; ++a)
#pragma unroll
            for (int b = 0; b < 3; ++b) acc[a][b] = (f32x4){0.f, 0.f, 0.f, 0.f};
        unsigned soffb[4], soffa[3];
#pragma unroll
        for (int i = 0; i < 4; ++i) { const int row = 8 * (i * 4 + wave) + (lane >> 3); const int ch = (lane & 7) ^ ((row >> 1) & 7); soffb[i] = (unsigned)(row * 1024 + ch * 8); }
#pragma unroll
        for (int i = 0; i < 3; ++i) { const int row = 8 * (i * 4 + wave) + (lane >> 3); const int ch = (lane & 7) ^ ((row >> 1) & 7); soffa[i] = (unsigned)(row * 1024 + ch * 8); }
        const u16* ga = A + (size_t)m0 * 1024; const u16* gb = B + (size_t)n0 * 1024;
#define OSTAGE(buf, kt) do { _Pragma("unroll") for (int i = 0; i < 4; ++i) \
            __builtin_amdgcn_global_load_lds((const unsigned*)(gb + soffb[i] + (kt) * 64), (LAS unsigned*)(lds + (buf) * 28672 + (i * 4 + wave) * 1024), 16, 0, 0); \
        _Pragma("unroll") for (int i = 0; i < 3; ++i) \
            __builtin_amdgcn_global_load_lds((const unsigned*)(ga + soffa[i] + (kt) * 64), (LAS unsigned*)(lds + (buf) * 28672 + 16384 + (i * 4 + wave) * 1024), 16, 0, 0); } while (0)
        OSTAGE(0, 0);
        float4 xres[3][4];
#pragma unroll
        for (int tt = 0; tt < 3; ++tt) { const int row = m0 + wm * 48 + tt * 16 + q; const float* xr = row < NTP ? p.x_p + (size_t)row * DM : p.x_s + (size_t)(row - NTP) * DM;
#pragma unroll
            for (int ct = 0; ct < 4; ++ct) xres[tt][ct] = *(const float4*)(xr + n0 + wn * 64 + ct * 16 + 4 * g); }
        __syncthreads();
        for (int kt = 0; kt < 16; ++kt) {
            if (kt + 1 < 16) OSTAGE((kt + 1) & 1, kt + 1);
            const char* sb = lds + (kt & 1) * 28672; const char* sa = sb + 16384;
#pragma unroll
            for (int ks = 0; ks < 2; ++ks) {
                bf16x8 fw[4], fx[3];
#pragma unroll
                for (int ct = 0; ct < 4; ++ct) fw[ct] = *(const bf16x8*)(sb + swz(wn * 64 + ct * 16 + q, 4 * ks + g));
#pragma unroll
                for (int tt = 0; tt < 3; ++tt) fx[tt] = *(const bf16x8*)(sa + swz(wm * 48 + tt * 16 + q, 4 * ks + g));
#pragma unroll
                for (int ct = 0; ct < 4; ++ct)
#pragma unroll
                    for (int tt = 0; tt < 3; ++tt) acc[ct][tt] = __builtin_amdgcn_mfma_f32_16x16x32_bf16(fw[ct], fx[tt], acc[ct][tt], 0, 0, 0);
            }
            __syncthreads();
        }
#undef OSTAGE
#pragma unroll
        for (int tt = 0; tt < 3; ++tt) {
            const int row = m0 + wm * 48 + tt * 16 + q;
            const float* xr = row < NTP ? p.x_p + (size_t)row * DM : p.x_s + (size_t)(row - NTP) * DM;
            float* o = p.out + (size_t)row * DM;
#pragma unroll
            for (int ct = 0; ct < 4; ++ct) { const int col = n0 + wn * 64 + ct * 16 + 4 * g; const float4 xv = xres[tt][ct];
                float4 w = {xv.x + acc[ct][tt][0], xv.y + acc[ct][tt][1], xv.z + acc[ct][tt][2], xv.w + acc[ct][tt][3]}; *(float4*)(o + col) = w; }
        }
    }
}

DI f32x16 mmq(const char* X, const char* Y, int qm, int qn, f32x16 acc, int lane) {
    const int r = lane & 31, h = lane >> 5;
#pragma unroll
    for (int ks = 0; ks < 4; ++ks) {
        const bf16x8 a = *(const bf16x8*)(X + swz(32 * qm + r, 2 * ks + h));
        const bf16x8 b = *(const bf16x8*)(Y + swz(32 * qn + r, 2 * ks + h));
        acc = __builtin_amdgcn_mfma_f32_32x32x16_bf16(a, b, acc, 0, 0, 0);
    }
    return acc;
}
DI void st_nat(char* img, const f32x16& a, int qm, int qn, int lane) {
    const int n = 32 * qn + (lane & 31), h = lane >> 5;
#pragma unroll
    for (int g = 0; g < 4; ++g) { const int m = 32 * qm + 8 * g + 4 * h; uint2 w; w.x = pack2(a[4 * g], a[4 * g + 1]); w.y = pack2(a[4 * g + 2], a[4 * g + 3]);
        *(uint2*)(img + swz(n, m >> 3) + (m & 7) * 2) = w; }
}
DI void st_nat_g(u16* gimg, const f32x16& a, int qm, int qn, int lane) {
    const int n = 32 * qn + (lane & 31), h = lane >> 5;
#pragma unroll
    for (int g = 0; g < 4; ++g) { const int m = 32 * qm + 8 * g + 4 * h; uint2 w; w.x = pack2(a[4 * g], a[4 * g + 1]); w.y = pack2(a[4 * g + 2], a[4 * g + 3]);
        *(uint2*)(gimg + n * 64 + m) = w; }
}
DI void st_nat_gp(u16* gimg, const f32x16& a, int qm, int qn, int lane) {
    const int n = 32 * qn + (lane & 31), h = lane >> 5;
#pragma unroll
    for (int g = 0; g < 2; ++g) { const int m = 32 * qm + 8 * g + 4 * h; const int mp = (m & ~0x1c) | ((m & 0xc) << 1) | ((m & 0x10) >> 2);
        uint4 w; w.x = pack2(a[4 * g], a[4 * g + 1]); w.y = pack2(a[4 * g + 2], a[4 * g + 3]); w.z = pack2(a[4 * g + 8], a[4 * g + 9]); w.w = pack2(a[4 * g + 10], a[4 * g + 11]);
        *(uint4*)(gimg + n * 64 + mp) = w; }
}
DI void st_sc(char* img, const f32x16& a, int qm, int qn, int lane) {
    const int n = 32 * qn + (lane & 31), h = lane >> 5;
#pragma unroll
    for (int e = 0; e < 16; ++e) { const int m = 32 * qm + (e & 3) + 8 * (e >> 2) + 4 * h; *(u16*)(img + swz(m, n >> 3) + (n & 7) * 2) = f2bf(a[e]); }
}
DI f32x16 ld_nat(const char* img, int qm, int qn, int lane) {
    const int n = 32 * qn + (lane & 31), h = lane >> 5; f32x16 a;
#pragma unroll
    for (int g = 0; g < 4; ++g) { const int m = 32 * qm + 8 * g + 4 * h; const uint2 w = *(const uint2*)(img + swz(n, m >> 3) + (m & 7) * 2);
        a[4 * g] = bflo(w.x); a[4 * g + 1] = bfhi(w.x); a[4 * g + 2] = bflo(w.y); a[4 * g + 3] = bfhi(w.y); }
    return a;
}
DI void ld_cur_prev8(const Params& p, int row, int col, int mode, int sb, float* cur, float* prev) {
    const u16* proj = (const u16*)(p.ws + W_PROJ);
    unpack8(*(const uint4*)(proj + (size_t)row * NC + col), cur);
    if (mode == 0) unpack8(*(const uint4*)(proj + (size_t)(row - 1) * NC + col), prev);
    else if (mode == 1) { for (int i = 0; i < 8; ++i) prev[i] = 0.f; }
    else { const float* s = p.st_shift + (size_t)sb * 1664 + (col - C_R); const float4 a = *(const float4*)s, b = *(const float4*)(s + 4);
        prev[0] = a.x; prev[1] = a.y; prev[2] = a.z; prev[3] = a.w; prev[4] = b.x; prev[5] = b.y; prev[6] = b.z; prev[7] = b.w; }
}
DI float ld_prev1(const Params& p, int row, int col, int mode, int sb) {
    const u16* proj = (const u16*)(p.ws + W_PROJ);
    if (mode == 0) return bf2f(proj[(size_t)(row - 1) * NC + col]);
    if (mode == 1) return 0.f;
    return p.st_shift[(size_t)sb * 1664 + (col - C_R)];
}

DI void phase_rwkv_prep(const Params& p, char* lds) {
    const u16* proj = (const u16*)(p.ws + W_PROJ);
    char* R0 = lds; char* R1 = lds + 8192; char* R2 = lds + 2 * 8192; char* R3 = lds + 3 * 8192; char* R4 = lds + 4 * 8192; char* R5 = lds + 5 * 8192;
    char* R6 = lds + 6 * 8192; char* R7 = lds + 7 * 8192; char* R8 = lds + 8 * 8192;
    float* tot = (float*)(lds + 9 * 8192); float* gam = tot + 256;
    for (int u = blockIdx.x; u < NUNIT; u += gridDim.x) {
        int tid = threadIdx.x; asm volatile("" : "+v"(tid));
        const int lane = tid & 63, wave = __builtin_amdgcn_readfirstlane(tid >> 6); const int qm = wave >> 1, qn = wave & 1; const int r = lane & 31, h5 = lane >> 5;
        int b, h, c, row0, ntok; bool prm = u < 2048;
        if (prm) { b = u >> 10; h = (u >> 7) & 7; c = u & 127; row0 = b * 8192 + c * 64; ntok = 64; }
        else { const int s = u - 2048; b = s >> 3; h = s & 7; c = 0; row0 = NTP + b * 16; ntok = 16; }
        const int mode0 = prm ? (c > 0 ? 0 : 1) : 2;
        uint4 wr_[2], wk_[2], wv_[2];
#pragma unroll
        for (int i = 0; i < 2; ++i) { wr_[i] = (uint4){0, 0, 0, 0}; wk_[i] = wr_[i]; wv_[i] = wr_[i];
            if (16 * wave < ntok) { const u16* src = proj + (size_t)(row0 + 16 * wave + 8 * i + (lane >> 3)) * NC + h * 64 + 8 * (lane & 7);
                wr_[i] = *(const uint4*)(src + C_R); wk_[i] = *(const uint4*)(src + C_RK); wv_[i] = *(const uint4*)(src + C_RV); } }
        {
            const int t = tid >> 2, q = tid & 3;
#pragma unroll
            for (int half = 0; half < 2; ++half) {
                const int cw = q * 16 + half * 8;
                uint4 ow = {0, 0, 0, 0}, oa = {0, 0, 0, 0};
                if (t < ntok) {
                    const int mode = t > 0 ? 0 : mode0; float cur[8], prv[8], xw[8], xa[8];
                    ld_cur_prev8(p, row0 + t, C_WD + cw, mode, b, cur, prv);
                    { const float4 ma = *(const float4*)(p.mix + 1536 + cw), mb = *(const float4*)(p.mix + 1540 + cw); const float mx_[8] = {ma.x, ma.y, ma.z, ma.w, mb.x, mb.y, mb.z, mb.w};
#pragma unroll
                    for (int i = 0; i < 8; ++i) { const float x = cur[i] + (prv[i] - cur[i]) * mx_[i]; const float e2 = __expf(2.f * x); xw[i] = 1.f - 2.f * rcpf_(e2 + 1.f); } }
                    ld_cur_prev8(p, row0 + t, C_AD + cw, mode, b, cur, prv);
                    { const float4 ma = *(const float4*)(p.mix + 1600 + cw), mb = *(const float4*)(p.mix + 1604 + cw); const float mx_[8] = {ma.x, ma.y, ma.z, ma.w, mb.x, mb.y, mb.z, mb.w};
#pragma unroll
                    for (int i = 0; i < 8; ++i) xa[i] = cur[i] + (prv[i] - cur[i]) * mx_[i]; }
                    ow.x = pack2(xw[0], xw[1]); ow.y = pack2(xw[2], xw[3]); ow.z = pack2(xw[4], xw[5]); ow.w = pack2(xw[6], xw[7]);
                    oa.x = pack2(xa[0], xa[1]); oa.y = pack2(xa[2], xa[3]); oa.z = pack2(xa[4], xa[5]); oa.w = pack2(xa[6], xa[7]);
                }
                *(uint4*)(R0 + swz(t, 2 * q + half)) = ow; *(uint4*)(R1 + swz(t, 2 * q + half)) = oa;
            }
        }
        __syncthreads();
        {
            f32x16 adw, ada;
#pragma unroll
            for (int e = 0; e < 16; ++e) { adw[e] = 0.f; ada[e] = 0.f; }
            const u16* wup = (const u16*)(p.ws + W_WUPT) + (size_t)(h * 64 + 32 * qn + r) * 64; const u16* aup = (const u16*)(p.ws + W_AUPT) + (size_t)(h * 64 + 32 * qn + r) * 64;
#pragma unroll
            for (int ks = 0; ks < 4; ++ks) {
                const bf16x8 xa = *(const bf16x8*)(R0 + swz(32 * qm + r, 2 * ks + h5)); const bf16x8 xb = *(const bf16x8*)(R1 + swz(32 * qm + r, 2 * ks + h5));
                const bf16x8 ya = *(const bf16x8*)(wup + 16 * ks + 8 * h5); const bf16x8 yb = *(const bf16x8*)(aup + 16 * ks + 8 * h5);
                adw = __builtin_amdgcn_mfma_f32_32x32x16_bf16(xa, ya, adw, 0, 0, 0); ada = __builtin_amdgcn_mfma_f32_32x32x16_bf16(xb, yb, ada, 0, 0, 0);
            }
            float* DW = (float*)R4; float* DA = (float*)R6; const int n = 32 * qn + r;
#pragma unroll
            for (int e = 0; e < 16; ++e) { const int m = 32 * qm + (e & 3) + 8 * (e >> 2) + 4 * h5; DW[m * 64 + n] = adw[e]; DA[m * 64 + n] = ada[e]; }
        }
        __syncthreads();
        {
            const int tg = wave, j = lane, hj = h * 64 + j;
            float* DW = (float*)R4; const float* DA = (const float*)R6;
            { const float w0j = p.w0[hj];
                float run = 0.f;
#pragma unroll 4
                for (int i = 0; i < 16; ++i) { const int t = 16 * tg + i; const float x = w0j + DW[t * 64 + j];
                    const float z = -x; const float sp = fmaxf(z, 0.f) + __logf(1.f + __expf(-fabsf(z))); float l = -__expf(-sp - 0.5f); if (t >= ntok) l = 0.f; DW[t * 64 + j] = l; run += l; }
                tot[tg * 64 + j] = run;
            }
            __syncthreads();
            float prefix = 0.f, ctot = 0.f;
#pragma unroll
            for (int g = 0; g < 4; ++g) { const float v = tot[g * 64 + j]; if (g < tg) prefix += v; ctot += v; }
            if (tg == 0) gam[j] = __expf(ctot);
            const float a0j = p.a0[hj], kkj = p.k_k[hj], kaj = p.k_a[hj], rkj = p.r_k[hj];
            const float mr = p.mix[hj], mk = p.mix[512 + hj], mv = p.mix[1024 + hj];
            float* bonus = (float*)(p.ws + W_BONUS);
            float mybon = 0.f;
            u16 gcr[16], gck[16], gcv[16];
            { char* tb = R8 + wave * 2048; char* wp = tb + (lane >> 3) * 128 + (lane & 7) * 16; const char* rp = tb + lane * 2;
#define XPOSE16(W, OUT) do { asm volatile("s_waitcnt lgkmcnt(0)" ::: "memory"); *(uint4*)wp = W[0]; *(uint4*)(wp + 1024) = W[1]; asm volatile("s_waitcnt lgkmcnt(0)" ::: "memory"); \
                    _Pragma("unroll") for (int tt = 0; tt < 16; ++tt) OUT[tt] = *(const u16*)(rp + tt * 128); } while (0)
                XPOSE16(wr_, gcr); XPOSE16(wk_, gck); XPOSE16(wv_, gcv);
#undef XPOSE16
            }
            float pr = 0.f, pk = 0.f, pv = 0.f;
            { const int t0 = 16 * tg; if (t0 < ntok) { const int mode = t0 > 0 ? 0 : mode0; pr = ld_prev1(p, row0 + t0, C_R + hj, mode, b); pk = ld_prev1(p, row0 + t0, C_RK + hj, mode, b); pv = ld_prev1(p, row0 + t0, C_RV + hj, mode, b); } }
            float ecl = __expf(prefix); const float etot = __expf(ctot);
            unsigned pAt[8], pV[8], pKb[8], pBb[8]; float hAt = 0.f, hV = 0.f, hKb = 0.f, hBb = 0.f;
#pragma unroll
            for (int i = 0; i < 16; ++i) {
                const int t = 16 * tg + i; const bool valid = t < ntok;
                float xr = 0.f, xk = 0.f, xv = 0.f;
                if (valid) { const float cr = bf2f(gcr[i]), ck = bf2f(gck[i]), cv = bf2f(gcv[i]);
                    xr = cr + (pr - cr) * mr; xk = ck + (pk - ck) * mk; xv = cv + (pv - cv) * mv; pr = cr; pk = ck; pv = cv; }
                const float a = rcpf_(1.f + __expf(-(a0j + DA[t * 64 + j])));
                const float kx = xk * kkj; const float ss = wave_sum(kx * kx); const float kk = kx * __builtin_amdgcn_rsqf(fmaxf(ss, 1e-24f));
                const float kmod = xk * (1.f + (a - 1.f) * kaj);
                const float bon = wave_sum(xr * kmod * rkj);
                if (lane == i) mybon = bon;
                const float e_ce = ecl; ecl *= __expf(DW[t * 64 + j]);
                const float e_cl = ecl, e_n = rcpf_(ecl), e_t = etot * e_n;
                const float vAt = -kk * e_ce, vRt = xr * e_cl, vBt = kk * a * e_n, vKt = kmod * e_n, vBb = kk * a * e_t, vKb = kmod * e_t;
                const int so = swz(t, j >> 3) + (j & 7) * 2;
                *(u16*)(R0 + so) = f2bf(vAt); *(u16*)(R1 + so) = f2bf(vRt); *(u16*)(R2 + so) = f2bf(vBt); *(u16*)(R3 + so) = f2bf(vKt);
                if (i & 1) { pAt[i >> 1] = pack2(hAt, vAt); pV[i >> 1] = pack2(hV, xv); pKb[i >> 1] = pack2(hKb, vKb); pBb[i >> 1] = pack2(hBb, vBb); }
                else { hAt = vAt; hV = xv; hKb = vKb; hBb = vBb; }
            }
            if (lane < 16) bonus[(size_t)u * 64 + 16 * tg + lane] = mybon;
            __syncthreads();
#pragma unroll
            for (int half = 0; half < 2; ++half) { const int o = swz(j, 2 * tg + half);
                *(uint4*)(R4 + o) = (uint4){pAt[4 * half], pAt[4 * half + 1], pAt[4 * half + 2], pAt[4 * half + 3]};
                *(uint4*)(R5 + o) = (uint4){pV[4 * half], pV[4 * half + 1], pV[4 * half + 2], pV[4 * half + 3]};
                *(uint4*)(R6 + o) = (uint4){pKb[4 * half], pKb[4 * half + 1], pKb[4 * half + 2], pKb[4 * half + 3]};
                *(uint4*)(R7 + o) = (uint4){pBb[4 * half], pBb[4 * half + 1], pBb[4 * half + 2], pBb[4 * half + 3]}; }
        }
        __syncthreads();
        f32x16 z16;
#pragma unroll
        for (int e = 0; e < 16; ++e) z16[e] = 0.f;
        f32x16 aN = mmq(R2, R0, qm, qn, z16, lane);
        f32x16 aKa = mmq(R3, R0, qm, qn, z16, lane);
        f32x16 aW1 = mmq(R2, R1, qm, qn, z16, lane);
        f32x16 aKr = mmq(R3, R1, qm, qn, z16, lane);
        {
            const int n = 32 * qn + r;
#pragma unroll
            for (int e = 0; e < 16; ++e) { const int m = 32 * qm + (e & 3) + 8 * (e >> 2) + 4 * h5;
                if (!(m < n)) { aN[e] = 0.f; aKa[e] = 0.f; } if (!(m <= n)) { aW1[e] = 0.f; aKr[e] = 0.f; } }
        }
        f32x16 aW2 = ld_nat(R7, qm, qn, lane);
        __syncthreads();
        st_sc(R0, aN, qm, qn, lane);
        st_nat(R2, aN, qm, qn, lane);
        st_sc(R3, aKa, qm, qn, lane);
        st_nat(R8, aW1, qm, qn, lane);
        __syncthreads();
        for (int it = 0; it < 6; ++it) {
            aW1 = mmq(R0, R8, qm, qn, aW1, lane);
            aW2 = mmq(R0, R7, qm, qn, aW2, lane);
            if (it < 5) aN = mmq(R0, R2, qm, qn, z16, lane);
            __syncthreads();
            st_nat(R8, aW1, qm, qn, lane); st_nat(R7, aW2, qm, qn, lane);
            if (it < 5) { st_sc(R0, aN, qm, qn, lane); st_nat(R2, aN, qm, qn, lane); }
            __syncthreads();
        }
        {
            f32x16 aG = mmq(R4, R7, qm, qn, z16, lane);
            { const int n = 32 * qn + r; const float gn = gam[n];
#pragma unroll
                for (int e = 0; e < 16; ++e) { const int m = 32 * qm + (e & 3) + 8 * (e >> 2) + 4 * h5; if (m == n) aG[e] += gn; } }
            st_nat_gp((u16*)(p.ws + W_GT) + (size_t)u * 4096, aG, qm, qn, lane);
            f32x16 aQ = ld_nat(R1, qm, qn, lane);
            aQ = mmq(R4, R8, qm, qn, aQ, lane);
            st_nat_gp((u16*)(p.ws + W_QT) + (size_t)u * 4096, aQ, qm, qn, lane);
            f32x16 aP1 = ld_nat(R6, qm, qn, lane);
            aP1 = mmq(R3, R7, qm, qn, aP1, lane);
            aKr = mmq(R3, R8, qm, qn, aKr, lane);
            st_nat(R0, aP1, qm, qn, lane);
            st_nat(R2, aKr, qm, qn, lane);
        }
        __syncthreads();
        {
            f32x16 aH = mmq(R0, R5, qm, qn, z16, lane);
            st_nat_gp((u16*)(p.ws + W_HH) + (size_t)u * 4096, aH, qm, qn, lane);
            f32x16 aY = mmq(R5, R2, qm, qn, z16, lane);
            const int n = 32 * qn + r;

#pragma unroll
            for (int g = 0; g < 4; g += 2) {
                unsigned ax = pack2(aY[4 * g], aY[4 * g + 1]), ay = pack2(aY[4 * g + 2], aY[4 * g + 3]), bx = pack2(aY[4 * g + 4], aY[4 * g + 5]), by = pack2(aY[4 * g + 6], aY[4 * g + 7]);
                { auto rr = __builtin_amdgcn_permlane32_swap(ax, bx, false, false); ax = rr[0]; bx = rr[1]; }
                { auto rr = __builtin_amdgcn_permlane32_swap(ay, by, false, false); ay = rr[0]; by = rr[1]; }
                if (n < ntok) *(uint4*)((u16*)(p.ws + W_XB) + (size_t)(row0 + n) * DM + 512 + h * 64 + 32 * qm + 8 * g + 8 * h5) = (uint4){ax, ay, bx, by};
            }
        }
        __syncthreads();
    }
}

struct ScanSlot { uint4 ga[4][2]; uint4 gh[2]; };
DI void scan_load(ScanSlot& s, const u16* GT, const u16* HH, int u, int irow, int i16, int g) {
    const u16* gt = GT + (size_t)u * 4096; const u16* hh = HH + (size_t)u * 4096 + irow * 64;
#pragma unroll
    for (int mt = 0; mt < 4; ++mt) {
#pragma unroll
        for (int ks = 0; ks < 2; ++ks) s.ga[mt][ks] = *(const uint4*)(gt + (16 * mt + i16) * 64 + 32 * ks + 8 * g);
    }
#pragma unroll
    for (int ks = 0; ks < 2; ++ks) s.gh[ks] = *(const uint4*)(hh + 32 * ks + 8 * g);
}
DI void scan_step(const ScanSlot& s, f32x4 (&acc)[4], u16* sst, int irow, int g) {
    unsigned pk[4][2];
#pragma unroll
    for (int mt = 0; mt < 4; ++mt) { pk[mt][0] = pack2(acc[mt][0], acc[mt][1]); pk[mt][1] = pack2(acc[mt][2], acc[mt][3]); }
    bf16x8 bfr[2];
#pragma unroll
    for (int ks = 0; ks < 2; ++ks) { uint4 w = {pk[2 * ks][0], pk[2 * ks][1], pk[2 * ks + 1][0], pk[2 * ks + 1][1]}; bfr[ks] = __builtin_bit_cast(bf16x8, w);
        *(uint4*)(sst + irow * 64 + 32 * ks + 8 * g) = w; }
#pragma unroll
    for (int mt = 0; mt < 4; ++mt) {
        const unsigned hx = (mt & 1) ? s.gh[mt >> 1].z : s.gh[mt >> 1].x, hy = (mt & 1) ? s.gh[mt >> 1].w : s.gh[mt >> 1].y;
        f32x4 c = {bflo(hx), bfhi(hx), bflo(hy), bfhi(hy)};
#pragma unroll
        for (int ks = 0; ks < 2; ++ks) c = __builtin_amdgcn_mfma_f32_16x16x32_bf16(__builtin_bit_cast(bf16x8, s.ga[mt][ks]), bfr[ks], c, 0, 0, 0);
        acc[mt] = c;
    }
}
DI void scan_item(const Params& p, int item, int lane) {
    const int i16 = lane & 15, g = lane >> 4;
    const u16* GT = (const u16*)(p.ws + W_GT); const u16* HH = (const u16*)(p.ws + W_HH); u16* SST = (u16*)(p.ws + W_SST);
    f32x4 acc[4];
    if (item < 64) {
        const int bh = item >> 2, iq = item & 3, u0 = bh * 128, irow = 16 * iq + i16;
#pragma unroll
        for (int mt = 0; mt < 4; ++mt) acc[mt] = (f32x4){0.f, 0.f, 0.f, 0.f};
        ScanSlot s0, s1, s2, s3, s4;
        scan_load(s0, GT, HH, u0, irow, i16, g); scan_load(s1, GT, HH, u0 + 1, irow, i16, g); scan_load(s2, GT, HH, u0 + 2, irow, i16, g); scan_load(s3, GT, HH, u0 + 3, irow, i16, g);
        scan_load(s4, GT, HH, u0 + 4, irow, i16, g);
        const int ul = u0 + 127;
#define PINM do { asm volatile("" ::: "memory"); __builtin_amdgcn_sched_barrier(0); } while (0)
        for (int st = 0; st < 125; st += 5) {
            const int u = u0 + st;
            scan_step(s0, acc, SST + (size_t)u * 4096, irow, g);       PINM; scan_load(s0, GT, HH, min(u + 5, ul), irow, i16, g); PINM;
            scan_step(s1, acc, SST + (size_t)(u + 1) * 4096, irow, g); PINM; scan_load(s1, GT, HH, min(u + 6, ul), irow, i16, g); PINM;
            scan_step(s2, acc, SST + (size_t)(u + 2) * 4096, irow, g); PINM; scan_load(s2, GT, HH, min(u + 7, ul), irow, i16, g); PINM;
            scan_step(s3, acc, SST + (size_t)(u + 3) * 4096, irow, g); PINM; scan_load(s3, GT, HH, min(u + 8, ul), irow, i16, g); PINM;
            scan_step(s4, acc, SST + (size_t)(u + 4) * 4096, irow, g); PINM; scan_load(s4, GT, HH, min(u + 9, ul), irow, i16, g); PINM;
        }
        scan_step(s0, acc, SST + (size_t)(u0 + 125) * 4096, irow, g); PINM;
        scan_step(s1, acc, SST + (size_t)(u0 + 126) * 4096, irow, g); PINM;
        scan_step(s2, acc, SST + (size_t)(u0 + 127) * 4096, irow, g);
#undef PINM
        float* fout = p.out + O_SP + (size_t)bh * 4096;
#pragma unroll
        for (int mt = 0; mt < 4; ++mt) *(f32x4*)(fout + irow * 64 + 16 * mt + 4 * g) = acc[mt];
    } else {
        const int s = (item - 64) >> 2, iq = item & 3, u = 2048 + s, irow = 16 * iq + i16;
        const float* st0 = p.st_wkv + (size_t)s * 4096 + irow * 64;
#pragma unroll
        for (int mt = 0; mt < 4; ++mt) acc[mt] = *(const f32x4*)(st0 + 16 * mt + 4 * g);
        ScanSlot s0; scan_load(s0, GT, HH, u, irow, i16, g);
        scan_step(s0, acc, SST + (size_t)u * 4096, irow, g);
        float* fout = p.out + O_SS + (size_t)s * 4096;
#pragma unroll
        for (int mt = 0; mt < 4; ++mt) *(f32x4*)(fout + irow * 64 + 16 * mt + 4 * g) = acc[mt];
    }
}

DI s16x4 tr16(const char* p) { return __builtin_bit_cast(s16x4, __builtin_amdgcn_ds_read_tr16_b64_v4i16((__attribute__((address_space(3))) s16x4*)p)); }

DI void attn_tile(const char* sk, const char* sv, const float* tab, const bf16x8& qf0, const bf16x8& qf1, float& m, float& l, f32x4 (&o)[4], int qpos, int dlt, int nvalid, int lane) {
    const int q = lane & 15, g = lane >> 4;
    const float C2 = 0.125f * LOG2E;
    f32x4 sc[4];
#pragma unroll
    for (int kt = 0; kt < 4; ++kt) {
        const bf16x8 a0 = *(const bf16x8*)(sk + swz(16 * kt + q, g)); const bf16x8 a1 = *(const bf16x8*)(sk + swz(16 * kt + q, 4 + g));
        f32x4 s = {0.f, 0.f, 0.f, 0.f};
        s = __builtin_amdgcn_mfma_f32_16x16x32_bf16(a0, qf0, s, 0, 0, 0); s = __builtin_amdgcn_mfma_f32_16x16x32_bf16(a1, qf1, s, 0, 0, 0);
        sc[kt] = s;
    }
    float mx = -INFINITY;
    if (dlt >= 3) {
        const float bc = tab[256];
#pragma unroll
        for (int kt = 0; kt < 4; ++kt)
#pragma unroll
            for (int e = 0; e < 4; ++e) { const float s = sc[kt][e] * C2 + bc; sc[kt][e] = s; mx = fmaxf(mx, s); }
    } else {
#pragma unroll
        for (int kt = 0; kt < 4; ++kt)
#pragma unroll
            for (int e = 0; e < 4; ++e) { const int key = 16 * kt + 4 * g + e; int rel = qpos - key + dlt * 64; rel = rel < -128 ? -128 : (rel > 128 ? 128 : rel);
                float s = sc[kt][e] * C2 + tab[rel + 128]; if (key >= nvalid) s = -INFINITY; sc[kt][e] = s; mx = fmaxf(mx, s); }
    }
    mx = xmax16(mx); mx = xmax32(mx);
    const float mn = fmaxf(m, mx); const float alpha = __builtin_amdgcn_exp2f(m - mn); m = mn;
    float ps = 0.f;
#pragma unroll
    for (int kt = 0; kt < 4; ++kt)
#pragma unroll
        for (int e = 0; e < 4; ++e) { const float pe = __builtin_amdgcn_exp2f(sc[kt][e] - mn); sc[kt][e] = pe; ps += pe; }
    l = l * alpha + ps;
#pragma unroll
    for (int dt = 0; dt < 4; ++dt) o[dt] *= alpha;
    bf16x8 pf[2];
#pragma unroll
    for (int ks = 0; ks < 2; ++ks) { uint4 w = {pack2(sc[2 * ks][0], sc[2 * ks][1]), pack2(sc[2 * ks][2], sc[2 * ks][3]), pack2(sc[2 * ks + 1][0], sc[2 * ks + 1][1]), pack2(sc[2 * ks + 1][2], sc[2 * ks + 1][3])};
        pf[ks] = __builtin_bit_cast(bf16x8, w); }
#pragma unroll
    for (int dt = 0; dt < 4; ++dt)
#pragma unroll
        for (int ks = 0; ks < 2; ++ks) {
            const int vr = 32 * ks + 4 * g + (q >> 2); const int col = 16 * dt + 4 * (q & 3);
            const s16x4 lo = tr16(sv + swz(vr, col >> 3) + (col & 7) * 2); const s16x4 hi = tr16(sv + swz(vr + 16, col >> 3) + (col & 7) * 2);
            const bf16x8 vf = {lo[0], lo[1], lo[2], lo[3], hi[0], hi[1], hi[2], hi[3]};
            o[dt] = __builtin_amdgcn_mfma_f32_16x16x32_bf16(vf, pf[ks], o[dt], 0, 0, 0);
        }
}
DI void attn_finish(const Params& p, float l, const f32x4 (&o)[4], int qrow, int h, int lane) {
    const int g = lane >> 4; const u16* proj = (const u16*)(p.ws + W_PROJ);
    l = xadd16(l); l = xadd32(l);
    const float inv = rcpf_(l);
    u16* z = (u16*)(p.ws + W_XB) + (size_t)qrow * DM + h * 64; const u16* ga = proj + (size_t)qrow * NC + C_GA + h * 64;
    uint2 w[4];
#pragma unroll
    for (int dt = 0; dt < 4; ++dt) { const int d = 16 * dt + 4 * g; const uint2 gg = *(const uint2*)(ga + d);
        w[dt].x = pack2(o[dt][0] * inv * silu(bflo(gg.x)), o[dt][1] * inv * silu(bfhi(gg.x))); w[dt].y = pack2(o[dt][2] * inv * silu(bflo(gg.y)), o[dt][3] * inv * silu(bfhi(gg.y))); }
#pragma unroll
    for (int dt = 0; dt < 4; dt += 2) *(uint4*)(z + 16 * (dt + (g & 1)) + 8 * (g >> 1)) = widen16(w[dt], w[dt + 1]);
}
DI void attn_block(const Params& p, int u, char* lds) {
    int tid = threadIdx.x; asm volatile("" : "+v"(tid));
    const int lane = tid & 63, wave = __builtin_amdgcn_readfirstlane(tid >> 6);
    const u16* proj = (const u16*)(p.ws + W_PROJ);
    const int b = u >> 10, h = (u >> 7) & 7, c = u & 127; const int qrow = b * 8192 + c * 64 + wave * 16 + (lane & 15); const int ndl = c < 8 ? c : 8;
    float* tab = (float*)(lds + 49152);
    __syncthreads();
    for (int i = tid; i < 257; i += 256) tab[i] = p.relb[h * 257 + i] * LOG2E;
    const u16* qp = proj + (size_t)qrow * NC + C_Q + h * 64 + 8 * (lane >> 4);
    const bf16x8 qf0 = *(const bf16x8*)qp, qf1 = *(const bf16x8*)(qp + 32);
    float m = -INFINITY, l = 0.f; f32x4 o[4];
#pragma unroll
    for (int dt = 0; dt < 4; ++dt) o[dt] = (f32x4){0.f, 0.f, 0.f, 0.f};
    unsigned soff[2];
#pragma unroll
    for (int i = 0; i < 2; ++i) { const int row = 8 * (i * 4 + wave) + (lane >> 3); const int ch = (lane & 7) ^ ((row >> 1) & 7); soff[i] = (unsigned)(row * NC + ch * 8); }
    const u16* kbase = proj + (size_t)(b * 8192) * NC + h * 64;
#define ASTAGE(buf, dl) do { const u16* kr = kbase + (size_t)((c - (dl)) * 64) * NC; _Pragma("unroll") for (int i = 0; i < 2; ++i) { \
        __builtin_amdgcn_global_load_lds((const unsigned*)(kr + soff[i] + C_K), (LAS unsigned*)(lds + (buf) * 8192 + (i * 4 + wave) * 1024), 16, 0, 0); \
        __builtin_amdgcn_global_load_lds((const unsigned*)(kr + soff[i] + C_V), (LAS unsigned*)(lds + 24576 + (buf) * 8192 + (i * 4 + wave) * 1024), 16, 0, 0); } } while (0)
    __syncthreads();
    ASTAGE(0, ndl); if (ndl >= 1) ASTAGE(1, ndl - 1);
    int buf = 0;
    for (int dlt = ndl; dlt >= 0; --dlt) {
        if (dlt >= 1) asm volatile("s_waitcnt vmcnt(4) lgkmcnt(0)" ::: "memory"); else asm volatile("s_waitcnt vmcnt(0) lgkmcnt(0)" ::: "memory");
        __builtin_amdgcn_s_barrier();
        asm volatile("" ::: "memory");
        const int nb2 = buf >= 1 ? buf - 1 : 2;
        if (dlt >= 2) ASTAGE(nb2, dlt - 2);
        attn_tile(lds + buf * 8192, lds + 24576 + buf * 8192, tab, qf0, qf1, m, l, o, wave * 16 + (lane & 15), dlt, 64, lane);
        buf = buf == 2 ? 0 : buf + 1;
    }
#undef ASTAGE
    attn_finish(p, l, o, qrow, h, lane);
}
struct QG { bf16x8 q0, q1; float m, l; f32x4 o[4]; };
DI void attn_softmax(f32x4 (&sc)[4], const float* tab, QG& G, int qpos, int dlt, int g, bf16x8 (&pf)[2]) {
    const float C2 = 0.125f * LOG2E;
    float mx = -INFINITY;
    if (dlt >= 3) {
        const float bc = tab[256];
#pragma unroll
        for (int kt = 0; kt < 4; ++kt)
#pragma unroll
            for (int e = 0; e < 4; ++e) { const float s = sc[kt][e] * C2 + bc; sc[kt][e] = s; mx = fmaxf(mx, s); }
    } else {
#pragma unroll
        for (int kt = 0; kt < 4; ++kt)
#pragma unroll
            for (int e = 0; e < 4; ++e) { const int key = 16 * kt + 4 * g + e; int rel = qpos - key + dlt * 64; rel = rel < -128 ? -128 : (rel > 128 ? 128 : rel);
                const float s = sc[kt][e] * C2 + tab[rel + 128]; sc[kt][e] = s; mx = fmaxf(mx, s); }
    }
    mx = xmax16(mx); mx = xmax32(mx);
    const float mn = fmaxf(G.m, mx); const float alpha = __builtin_amdgcn_exp2f(G.m - mn); G.m = mn;
    float ps = 0.f;
#pragma unroll
    for (int kt = 0; kt < 4; ++kt)
#pragma unroll
        for (int e = 0; e < 4; ++e) { const float pe = __builtin_amdgcn_exp2f(sc[kt][e] - mn); sc[kt][e] = pe; ps += pe; }
    G.l = G.l * alpha + ps;
#pragma unroll
    for (int dt = 0; dt < 4; ++dt) G.o[dt] *= alpha;
#pragma unroll
    for (int ks = 0; ks < 2; ++ks) { uint4 w = {pack2(sc[2 * ks][0], sc[2 * ks][1]), pack2(sc[2 * ks][2], sc[2 * ks][3]), pack2(sc[2 * ks + 1][0], sc[2 * ks + 1][1]), pack2(sc[2 * ks + 1][2], sc[2 * ks + 1][3])};
        pf[ks] = __builtin_bit_cast(bf16x8, w); }
}
DI void attn_tile2(const char* sk, const char* sv, const float* tab, QG& A, QG& B, int qposA, int dlt, int lane) {
    const int q = lane & 15, g = lane >> 4;
    f32x4 sa[4], sb[4];
#pragma unroll
    for (int kt = 0; kt < 4; ++kt) {
        const bf16x8 a0 = *(const bf16x8*)(sk + swz(16 * kt + q, g)); const bf16x8 a1 = *(const bf16x8*)(sk + swz(16 * kt + q, 4 + g));
        f32x4 x = {0.f, 0.f, 0.f, 0.f}, y = {0.f, 0.f, 0.f, 0.f};
        x = __builtin_amdgcn_mfma_f32_16x16x32_bf16(a0, A.q0, x, 0, 0, 0); y = __builtin_amdgcn_mfma_f32_16x16x32_bf16(a0, B.q0, y, 0, 0, 0);
        x = __builtin_amdgcn_mfma_f32_16x16x32_bf16(a1, A.q1, x, 0, 0, 0); y = __builtin_amdgcn_mfma_f32_16x16x32_bf16(a1, B.q1, y, 0, 0, 0);
        sa[kt] = x; sb[kt] = y;
    }
    bf16x8 pa[2], pb[2];
    attn_softmax(sa, tab, A, qposA, dlt, g, pa);
    attn_softmax(sb, tab, B, qposA + 16, dlt, g, pb);
#pragma unroll
    for (int dt = 0; dt < 4; ++dt)
#pragma unroll
        for (int ks = 0; ks < 2; ++ks) {
            const int vr = 32 * ks + 4 * g + (q >> 2); const int col = 16 * dt + 4 * (q & 3);
            const s16x4 lo = tr16(sv + swz(vr, col >> 3) + (col & 7) * 2); const s16x4 hi = tr16(sv + swz(vr + 16, col >> 3) + (col & 7) * 2);
            const bf16x8 vf = {lo[0], lo[1], lo[2], lo[3], hi[0], hi[1], hi[2], hi[3]};
            A.o[dt] = __builtin_amdgcn_mfma_f32_16x16x32_bf16(vf, pa[ks], A.o[dt], 0, 0, 0);
            B.o[dt] = __builtin_amdgcn_mfma_f32_16x16x32_bf16(vf, pb[ks], B.o[dt], 0, 0, 0);
        }
}
DI void attn_block2(const Params& p, int bh, int cp, char* lds) {
    int tid = threadIdx.x; asm volatile("" : "+v"(tid));
    const int lane = tid & 63, wave = __builtin_amdgcn_readfirstlane(tid >> 6);
    const u16* proj = (const u16*)(p.ws + W_PROJ);
    const int b = bh >> 3, h = bh & 7, c0 = 2 * cp, cq = c0 + (wave >> 1);
    const int qposA = (wave & 1) * 32 + (lane & 15); const int qrowA = b * 8192 + cq * 64 + qposA;
    float* tab = (float*)(lds + 49152);
    __syncthreads();
    for (int i = tid; i < 257; i += 256) tab[i] = p.relb[h * 257 + i] * LOG2E;
    QG A, B;
    { const u16* qp = proj + (size_t)qrowA * NC + C_Q + h * 64 + 8 * (lane >> 4); A.q0 = *(const bf16x8*)qp; A.q1 = *(const bf16x8*)(qp + 32);
      const u16* qb = qp + (size_t)16 * NC; B.q0 = *(const bf16x8*)qb; B.q1 = *(const bf16x8*)(qb + 32); }
    A.m = -INFINITY; A.l = 0.f; B.m = -INFINITY; B.l = 0.f;
#pragma unroll
    for (int dt = 0; dt < 4; ++dt) { A.o[dt] = (f32x4){0.f, 0.f, 0.f, 0.f}; B.o[dt] = (f32x4){0.f, 0.f, 0.f, 0.f}; }
    unsigned soff[2];
#pragma unroll
    for (int i = 0; i < 2; ++i) { const int row = 8 * (i * 4 + wave) + (lane >> 3); const int ch = (lane & 7) ^ ((row >> 1) & 7); soff[i] = (unsigned)(row * NC + ch * 8); }
    const u16* kbase = proj + (size_t)(b * 8192) * NC + h * 64;
#define ASTAGE2(buf, kc) do { const u16* kr = kbase + (size_t)((kc) * 64) * NC; _Pragma("unroll") for (int i = 0; i < 2; ++i) { \
        __builtin_amdgcn_global_load_lds((const unsigned*)(kr + soff[i] + C_K), (LAS unsigned*)(lds + (buf) * 8192 + (i * 4 + wave) * 1024), 16, 0, 0); \
        __builtin_amdgcn_global_load_lds((const unsigned*)(kr + soff[i] + C_V), (LAS unsigned*)(lds + 24576 + (buf) * 8192 + (i * 4 + wave) * 1024), 16, 0, 0); } } while (0)
    const int lo = c0 >= 8 ? c0 - 8 : 0, hi = c0 + 1;
    __syncthreads();
    ASTAGE2(0, lo); ASTAGE2(1, lo + 1);
    int buf = 0;
    for (int kc = lo; kc <= hi; ++kc) {
        if (kc < hi) asm volatile("s_waitcnt vmcnt(4) lgkmcnt(0)" ::: "memory"); else asm volatile("s_waitcnt vmcnt(0) lgkmcnt(0)" ::: "memory");
        __builtin_amdgcn_s_barrier();
        asm volatile("" ::: "memory");
        const int nb2 = buf >= 1 ? buf - 1 : 2;
        if (kc + 2 <= hi) ASTAGE2(nb2, kc + 2);
        const int dlt = cq - kc;
        if (dlt >= 0 && dlt <= 8) attn_tile2(lds + buf * 8192, lds + 24576 + buf * 8192, tab, A, B, qposA, dlt, lane);
        buf = buf == 2 ? 0 : buf + 1;
    }
#undef ASTAGE2
    attn_finish(p, A.l, A.o, qrowA, h, lane);
    attn_finish(p, B.l, B.o, qrowA + 16, h, lane);
}

DI void attn_block_sample(const Params& p, int s, char* lds) {
    int tid = threadIdx.x; asm volatile("" : "+v"(tid));
    const int lane = tid & 63, wave = __builtin_amdgcn_readfirstlane(tid >> 6);
    char* wl = lds + wave * 18432;
    char* sk = wl; char* sv = wl + 8192; float* tab = (float*)(wl + 16384);
    const u16* proj = (const u16*)(p.ws + W_PROJ);
    const int b = s >> 3, h = s & 7; const int qrow0 = NTP + b * 16;
    for (int i = lane; i < 257; i += 64) tab[i] = p.relb[h * 257 + i] * LOG2E;
    const int q = lane & 15, g = lane >> 4;
    const u16* qp = proj + (size_t)(qrow0 + q) * NC + C_Q + h * 64 + 8 * g;
    const bf16x8 qf0 = *(const bf16x8*)qp, qf1 = *(const bf16x8*)(qp + 32);
    float m = -INFINITY, l = 0.f; f32x4 o[4];
#pragma unroll
    for (int dt = 0; dt < 4; ++dt) o[dt] = (f32x4){0.f, 0.f, 0.f, 0.f};
    const int lrow = lane >> 3, lch = lane & 7;
    float4 rk[16], rv[16];
#define SLOAD(dl) do { const size_t off_ = ((size_t)(b * 8 + h) * 512 + (8 - (dl)) * 64) * 64 + lrow * 64 + lch * 8; \
        _Pragma("unroll") for (int i = 0; i < 8; ++i) { const float* a_ = p.cache_k + off_ + i * 512; const float* c_ = p.cache_v + off_ + i * 512; \
            rk[2 * i] = ntld4(a_); rk[2 * i + 1] = ntld4(a_ + 4); rv[2 * i] = ntld4(c_); rv[2 * i + 1] = ntld4(c_ + 4); } } while (0)
#define SWRITE() do { _Pragma("unroll") for (int i = 0; i < 8; ++i) { const int row = i * 8 + lrow; \
            uint4 kv = {pack2(rk[2 * i].x, rk[2 * i].y), pack2(rk[2 * i].z, rk[2 * i].w), pack2(rk[2 * i + 1].x, rk[2 * i + 1].y), pack2(rk[2 * i + 1].z, rk[2 * i + 1].w)}; \
            uint4 vv = {pack2(rv[2 * i].x, rv[2 * i].y), pack2(rv[2 * i].z, rv[2 * i].w), pack2(rv[2 * i + 1].x, rv[2 * i + 1].y), pack2(rv[2 * i + 1].z, rv[2 * i + 1].w)}; \
            *(uint4*)(sk + swz(row, lch)) = kv; *(uint4*)(sv + swz(row, lch)) = vv; } } while (0)
    const int d0 = 8 - 2 * wave;
    SLOAD(d0);
    asm volatile("s_waitcnt lgkmcnt(0)" ::: "memory");
    SWRITE();
    SLOAD(d0 - 1);
    asm volatile("s_waitcnt lgkmcnt(0)" ::: "memory");
    attn_tile(sk, sv, tab, qf0, qf1, m, l, o, q, d0, 64, lane);
    asm volatile("s_waitcnt lgkmcnt(0)" ::: "memory");
    SWRITE();
    asm volatile("s_waitcnt lgkmcnt(0)" ::: "memory");
    attn_tile(sk, sv, tab, qf0, qf1, m, l, o, q, d0 - 1, 64, lane);
#undef SLOAD
#undef SWRITE
    if (wave == 3) {
        asm volatile("s_waitcnt lgkmcnt(0)" ::: "memory");
#pragma unroll
        for (int i = 0; i < 8; ++i) { const int row = i * 8 + lrow; uint4 kv = {0, 0, 0, 0}, vv = {0, 0, 0, 0};
            if (row < 16) { const u16* sp = proj + (size_t)(qrow0 + row) * NC + h * 64 + lch * 8; kv = *(const uint4*)(sp + C_K); vv = *(const uint4*)(sp + C_V); }
            *(uint4*)(sk + swz(row, lch)) = kv; *(uint4*)(sv + swz(row, lch)) = vv; }
        asm volatile("s_waitcnt lgkmcnt(0)" ::: "memory");
        attn_tile(sk, sv, tab, qf0, qf1, m, l, o, q, 0, 16, lane);
    }
    l = xadd16(l); l = xadd32(l);
    asm volatile("s_waitcnt lgkmcnt(0)" ::: "memory");
    float* cm = (float*)wl; float* cl = cm + 16; float* co = cm + 32;
    if (g == 0) { cm[q] = m; cl[q] = l; }
#pragma unroll
    for (int dt = 0; dt < 4; ++dt) *(f32x4*)(co + q * 64 + 16 * dt + 4 * g) = o[dt];
    __syncthreads();
    {
        float mw[4], M = -INFINITY;
#pragma unroll
        for (int w = 0; w < 4; ++w) { mw[w] = ((const float*)(lds + w * 18432))[q]; M = fmaxf(M, mw[w]); }
        float L = 0.f; f32x4 O = {0.f, 0.f, 0.f, 0.f};
#pragma unroll
        for (int w = 0; w < 4; ++w) { const float* base = (const float*)(lds + w * 18432); const float f = __builtin_amdgcn_exp2f(mw[w] - M);
            L += base[16 + q] * f; const f32x4 ov = *(const f32x4*)(base + 32 + q * 64 + 16 * wave + 4 * g); O += ov * f; }
        const float inv = rcpf_(L); const int qrow = qrow0 + q; const int d = 16 * wave + 4 * g;
        const uint2 gg = *(const uint2*)(proj + (size_t)qrow * NC + C_GA + h * 64 + d);
        uint2 w2; w2.x = pack2(O[0] * inv * silu(bflo(gg.x)), O[1] * inv * silu(bfhi(gg.x))); w2.y = pack2(O[2] * inv * silu(bflo(gg.y)), O[3] * inv * silu(bfhi(gg.y)));
        *(uint2*)((u16*)(p.ws + W_XB) + (size_t)qrow * DM + h * 64 + d) = w2;
    }
    __syncthreads();
}

DI void phase_scan_attn(const Params& p, char* lds) {
    const int tid = threadIdx.x, lane = tid & 63, wave = __builtin_amdgcn_readfirstlane(tid >> 6);
    if (blockIdx.x < 64) {
        if (wave == 0) { const int x_ = blockIdx.x & 7, k_ = blockIdx.x >> 3;
            scan_item(p, (x_ + 8 * (k_ >> 2)) * 4 + (k_ & 3), lane); }
        return;
    }
    unsigned* ctr = (unsigned*)(p.ws + W_BAR) + 3456;
    volatile LAS int* slot = (volatile LAS int*)(lds + 75264);
    const int q0 = (int)((unsigned)__builtin_amdgcn_s_getreg((3 << 11) | 20) & 7u);
    for (int v = 0; v < 8; ++v) {
        const int q = (q0 + v) & 7;
        for (;;) {
            __syncthreads();
            if (tid == 0) *slot = (int)__hip_atomic_fetch_add(ctr + 16 * q, 1u, __ATOMIC_RELAXED, __HIP_MEMORY_SCOPE_AGENT);
            __syncthreads();
            const int item = *slot;
            if (item >= 32 + 128 + 32) break;
            if (item < 32) attn_block_sample(p, 32 * q + item, lds);
            else if (item < 160) { const int j = item - 32; attn_block2(p, 2 * q + (j & 1), 63 - (j >> 1), lds); }
            else scan_item(p, 64 + (32 * q + item - 160) * 4 + wave, lane);
        }
    }
}

DI void phase_rwkv_out(const Params& p, char* lds) {
    const int tid = threadIdx.x, lane = tid & 63, wave = tid >> 6;
    float* pw = (float*)(lds + wave * 1024);
    const int gw = blockIdx.x * 4 + wave, nw = gridDim.x * 4;
    const int i16 = lane & 15, g = lane >> 4;
    const u16* proj = (const u16*)(p.ws + W_PROJ); const u16* QT = (const u16*)(p.ws + W_QT); const u16* SST = (const u16*)(p.ws + W_SST);
    const float* bonus = (const float*)(p.ws + W_BONUS);
    for (int wu = gw; wu < 8192 + 256; wu += nw) {
        int u, tg, b, h, c = 0, row0; bool prm = wu < 8192;
        if (prm) { u = wu >> 2; tg = wu & 3; b = u >> 10; h = (u >> 7) & 7; c = u & 127; row0 = b * 8192 + c * 64; }
        else { const int s = wu - 8192; u = 2048 + s; tg = 0; b = s >> 3; h = s & 7; row0 = NTP + b * 16; }
        const int t = 16 * tg + i16; const int row = row0 + t;
        u16* z = (u16*)(p.ws + W_XB) + (size_t)row * DM + 512 + h * 64;
        const u16* qt = QT + (size_t)u * 4096 + t * 64 + 8 * g; const bf16x8 bq0 = *(const bf16x8*)qt, bq1 = *(const bf16x8*)(qt + 32);
        { const float a_ = p.mix[1024 + h * 64 + lane], b_ = p.gn_g[h * 64 + lane], c_ = p.gn_b[h * 64 + lane];
            asm volatile("s_waitcnt lgkmcnt(0)" ::: "memory"); pw[lane] = a_; pw[64 + lane] = b_; pw[128 + lane] = c_; asm volatile("s_waitcnt lgkmcnt(0)" ::: "memory"); }
        const int wofs = 16 * (g & 1) + 8 * (g >> 1);
        const int mode = t > 0 ? 0 : (prm ? (c > 0 ? 0 : 1) : 2);
        uint2 ylw[4], cvw[4], grw[4], pvw[4];
        { const u16* pr_ = proj + (size_t)row * NC + h * 64 + wofs; const u16* pp_ = proj + (size_t)(mode == 0 ? row - 1 : row) * NC + C_RV + h * 64 + wofs;
#pragma unroll
            for (int mp = 0; mp < 2; ++mp) {
                unwiden16(*(const uint4*)(z + 32 * mp + wofs), ylw[2 * mp], ylw[2 * mp + 1]);
                unwiden16(*(const uint4*)(pr_ + C_RV + 32 * mp), cvw[2 * mp], cvw[2 * mp + 1]);
                unwiden16(*(const uint4*)(pr_ + C_GR + 32 * mp), grw[2 * mp], grw[2 * mp + 1]);
                unwiden16(*(const uint4*)(pp_ + 32 * mp), pvw[2 * mp], pvw[2 * mp + 1]); } }
        f32x4 y[4];
#pragma unroll
        for (int mt = 0; mt < 4; ++mt) {
            const uint2 yl = ylw[mt]; f32x4 a = {bflo(yl.x), bfhi(yl.x), bflo(yl.y), bfhi(yl.y)};
            const u16* sp = SST + (size_t)u * 4096 + (16 * mt + i16) * 64 + 8 * g;
            a = __builtin_amdgcn_mfma_f32_16x16x32_bf16(*(const bf16x8*)sp, bq0, a, 0, 0, 0); a = __builtin_amdgcn_mfma_f32_16x16x32_bf16(*(const bf16x8*)(sp + 32), bq1, a, 0, 0, 0);
            y[mt] = a;
        }
        float s1 = 0.f;
#pragma unroll
        for (int mt = 0; mt < 4; ++mt) s1 += (y[mt][0] + y[mt][1]) + (y[mt][2] + y[mt][3]);
        s1 = xadd16(s1); s1 = xadd32(s1);
        const float mu = s1 * (1.f / 64.f); float s2 = 0.f;
#pragma unroll
        for (int mt = 0; mt < 4; ++mt)
#pragma unroll
            for (int e = 0; e < 4; ++e) { const float d = y[mt][e] - mu; s2 += d * d; }
        s2 = xadd16(s2); s2 = xadd32(s2);
        const float rs = __builtin_amdgcn_rsqf(s2 * (1.f / 64.f) + 64e-5f);
        const float bon = bonus[(size_t)u * 64 + t];
        uint2 wz[4];
#pragma unroll
        for (int mt = 0; mt < 4; ++mt) {
            const int i0 = 16 * mt + 4 * g; const int hj = h * 64 + i0;
            const uint2 cvp = cvw[mt]; const float cv[4] = {bflo(cvp.x), bfhi(cvp.x), bflo(cvp.y), bfhi(cvp.y)};
            float pv[4];
            if (mode == 0) { const uint2 w = pvw[mt]; pv[0] = bflo(w.x); pv[1] = bfhi(w.x); pv[2] = bflo(w.y); pv[3] = bfhi(w.y); }
            else if (mode == 1) { pv[0] = pv[1] = pv[2] = pv[3] = 0.f; }
            else { const float4 w = *(const float4*)(p.st_shift + (size_t)b * 1664 + 1024 + hj); pv[0] = w.x; pv[1] = w.y; pv[2] = w.z; pv[3] = w.w; }
            const float4 mv = *(const float4*)(pw + i0), gg = *(const float4*)(pw + 64 + i0), gb = *(const float4*)(pw + 128 + i0);
            const float mvv[4] = {mv.x, mv.y, mv.z, mv.w}, ggv[4] = {gg.x, gg.y, gg.z, gg.w}, gbv[4] = {gb.x, gb.y, gb.z, gb.w};
            const uint2 grp = grw[mt]; const float gr[4] = {bflo(grp.x), bfhi(grp.x), bflo(grp.y), bfhi(grp.y)};
            float ov[4];
#pragma unroll
            for (int e = 0; e < 4; ++e) { const float xv = cv[e] + (pv[e] - cv[e]) * mvv[e]; const float yn = (y[mt][e] - mu) * rs * ggv[e] + gbv[e] + bon * xv; ov[e] = yn * silu(gr[e]); }
            wz[mt].x = pack2(ov[0], ov[1]); wz[mt].y = pack2(ov[2], ov[3]);
        }
#pragma unroll
        for (int mt = 0; mt < 4; mt += 2) *(uint4*)(z + 16 * (mt + (g & 1)) + 8 * (g >> 1)) = widen16(wz[mt], wz[mt + 1]);
    }
}


#define XB_TMO      128
#define XB_XCNT(j)  (256  + 64 * (j))
#define XB_XSUB(j)  (1280 + 64 * (j))
#define XB_XGEN(j)  (2304 + 64 * (j))
#define XB_TOP      3328
#define XB_TOPGEN   3392
#define XCD_BAR_WORDS 3456
#define XB_SPIN_CAP (1u << 18)
DI unsigned xb_ld(unsigned* p) { return __hip_atomic_load(p, __ATOMIC_RELAXED, __HIP_MEMORY_SCOPE_AGENT); }
DI unsigned xb_add(unsigned* p, unsigned v) { return __hip_atomic_fetch_add(p, v, __ATOMIC_RELAXED, __HIP_MEMORY_SCOPE_AGENT); }
DI unsigned xb_xcc_id() { return (unsigned)__builtin_amdgcn_s_getreg((3 << 11) | 20) & 0xFu; }
#define XB_SPIN(cond, bar) do { unsigned _sp = 0; while (cond) { __builtin_amdgcn_s_sleep(2); \
    if ((++_sp & 255u) == 0u) { if (xb_ld(&(bar)[XB_TMO])) break; if (_sp > XB_SPIN_CAP) { atomicAdd(&(bar)[XB_TMO], 1u); break; } } } } while (0)
struct XcdBarrier { unsigned* bar; unsigned x; volatile LAS unsigned* st; };
DI XcdBarrier xcd_barrier_post(unsigned* bar, volatile LAS unsigned* st) {
    XcdBarrier b; b.bar = bar; b.x = xb_xcc_id(); b.st = st;
    if (threadIdx.x == 0) (void)xb_add(&bar[XB_XCNT(b.x)], 1u);
    return b;
}
DI void xcd_barrier_complete(unsigned* bar, unsigned x, unsigned& nloc, unsigned& nx) {
    const unsigned G = gridDim.x * gridDim.y * gridDim.z;
    unsigned sum, cnt, mine, sp = 0u;
    for (;;) {
        sum = 0u; cnt = 0u; mine = 0u;
#pragma unroll
        for (unsigned j = 0; j < 16; ++j) { const unsigned c = xb_ld(&bar[XB_XCNT(j)]); sum += c; cnt += (c > 0u) ? 1u : 0u; mine = (j == x) ? c : mine; }
        if (sum == G) break;
        __builtin_amdgcn_s_sleep(1);
        if ((++sp & 255u) == 0u) { if (xb_ld(&bar[XB_TMO])) break; if (sp > XB_SPIN_CAP) { atomicAdd(&bar[XB_TMO], 1u); break; } }
    }
    nloc = mine > 0u ? mine : 1u; nx = cnt > 0u ? cnt : 1u;
}
DI void xcd_barrier(const XcdBarrier& b) {
    asm volatile("s_waitcnt vmcnt(0)" ::: "memory");
    __syncthreads();
    if (threadIdx.x == 0) {
        unsigned* bar = b.bar;
        __builtin_amdgcn_s_waitcnt(0);
        unsigned nloc = b.st[0], nx = b.st[1];
        if (nloc == 0u) { xcd_barrier_complete(bar, b.x, nloc, nx); b.st[0] = nloc; b.st[1] = nx; }
        const unsigned old = xb_add(&bar[XB_XSUB(b.x)], 1u);
        const unsigned gen = old / nloc;
        if (old + 1u == (gen + 1u) * nloc) {
            __builtin_amdgcn_fence(__ATOMIC_RELEASE, "agent");
            asm volatile("s_waitcnt vmcnt(0)" ::: "memory");
            const unsigned og = xb_add(&bar[XB_TOP], 1u);
            const unsigned tg = og / nx;
            if (og + 1u == (tg + 1u) * nx) xb_add(&bar[XB_TOPGEN], 1u);
            else XB_SPIN(xb_ld(&bar[XB_TOPGEN]) == tg, bar);
            __builtin_amdgcn_fence(__ATOMIC_ACQUIRE, "agent");
            xb_add(&bar[XB_XGEN(b.x)], 1u);
            asm volatile("s_waitcnt vmcnt(0)" ::: "memory");
        } else {
            XB_SPIN(xb_ld(&bar[XB_XGEN(b.x)]) == gen, bar);
            __builtin_amdgcn_fence(__ATOMIC_ACQUIRE, "agent");
            asm volatile("s_waitcnt vmcnt(0)" ::: "memory");
        }
    }
    __syncthreads();
}

DI void run_phase(const Params& p, char* lds, int ph) {
    if (ph == 0) phase_prep(p, lds);
    else if (ph == 1) { Epi1 e{&p}; gemm_phase((const u16*)(p.ws + W_XB), (const u16*)(p.ws + W_WINT), 132, 33, lds, e); }
    else if (ph == 2) phase_rwkv_prep(p, lds);
    else if (ph == 3) phase_scan_attn(p, lds);
    else if (ph == 4) phase_rwkv_out(p, lds);
    else gemm_out(p, lds);
}

extern "C" __global__ void __launch_bounds__(256, 2) hymba_mega(Params p, int ph_lo, int ph_hi) {
    extern __shared__ __attribute__((aligned(16))) char lds[];
#if ONE_LAUNCH
    volatile LAS unsigned* st = (volatile LAS unsigned*)(lds + 75520);
    if (threadIdx.x == 0) { st[0] = 0u; st[1] = 0u; st[2] = 0u; st[3] = 0u; }
    __syncthreads();
    const XcdBarrier xb = xcd_barrier_post((unsigned*)(p.ws + W_BAR), st);
#ifndef PROBE_REP
#define PROBE_REP -1
#endif
#define RUNP(k) do { run_phase(p, lds, k); if (PROBE_REP == k) { xcd_barrier(xb); run_phase(p, lds, k); } } while (0)
    RUNP(0); xcd_barrier(xb);
    RUNP(1); xcd_barrier(xb);
    RUNP(2); xcd_barrier(xb);
    RUNP(3); xcd_barrier(xb);
    run_phase(p, lds, 4); xcd_barrier(xb);
    RUNP(5);
#else
    run_phase(p, lds, ph_lo);
#endif
}

extern "C" void kernel_launch(void* const* d_in, const int* in_sizes, int n_in, void* d_out, int out_size, void* d_ws, size_t ws_size, hipStream_t stream) {
    Params p{};
    const float** f = (const float**)&p;
    for (int i = 0; i < 22; ++i) f[i] = (const float*)d_in[i];
    p.out = (float*)d_out; p.ws = (char*)d_ws;
    static int grid_blocks = 0;
    if (!grid_blocks) {
        hipFuncSetAttribute((const void*)hymba_mega, hipFuncAttributeMaxDynamicSharedMemorySize, LDS_BYTES);
        int dev = 0, cus = 0, per_cu = 0;
        hipGetDevice(&dev);
        hipDeviceGetAttribute(&cus, hipDeviceAttributeMultiprocessorCount, dev);
        hipOccupancyMaxActiveBlocksPerMultiprocessor(&per_cu, hymba_mega, 256, LDS_BYTES);
        if (per_cu > 2) per_cu = 2;
        if (per_cu < 1) per_cu = 1;
        grid_blocks = cus * per_cu;
    }
#if ONE_LAUNCH
    int lo = 0, hi = 5;
    (void)hipMemsetAsync((char*)d_ws + W_BAR, 0, (XCD_BAR_WORDS + 128) * 4, stream);
    void* args[] = {&p, &lo, &hi};
    hipError_t e = hipLaunchCooperativeKernel((void*)hymba_mega, dim3(grid_blocks), dim3(256), args, LDS_BYTES, stream);
    if (e != hipSuccess) fprintf(stderr, "cooperative launch failed: %s (grid %d)\n", hipGetErrorString(e), grid_blocks);
#else
    for (int ph = 0; ph < 6; ++ph) hipLaunchKernelGGL(hymba_mega, dim3(grid_blocks), dim3(256), LDS_BYTES, stream, p, ph, ph);
#endif
}
```

```cpp
#include <hip/hip_runtime.h>
#include <hip/hip_cooperative_groups.h>
#include <cstdio>
#include <cstdint>
namespace cg = cooperative_groups;

#ifndef ONE_LAUNCH
#define ONE_LAUNCH 1
#endif

#define DI __device__ __forceinline__
#define LAS __attribute__((address_space(3)))
typedef unsigned short u16;
typedef short bf16x8 __attribute__((ext_vector_type(8)));
typedef short s16x4 __attribute__((ext_vector_type(4)));
typedef float f32x4 __attribute__((ext_vector_type(4)));
typedef float f32x16 __attribute__((ext_vector_type(16)));
typedef float f32x2_t __attribute__((ext_vector_type(2)));
typedef __bf16 bf16x2_t __attribute__((ext_vector_type(2)));
typedef __attribute__((address_space(3))) s16x4 lds_s16x4;

constexpr int DM = 1024, NC = 4224, NTP = 16384, NTS = 512, NTOK = 16896;
constexpr int C_Q = 0, C_K = 512, C_V = 1024, C_GA = 1536, C_R = 2048, C_RK = 2560, C_RV = 3072, C_WD = 3584, C_AD = 3648, C_GR = 3712;
constexpr int NUNIT = 2304;
constexpr size_t O_YP = 0, O_YS = 16777216, O_KP = 17301504, O_VP = 17825792, O_KS = 18350080, O_VS = 18612224,
                 O_SP = 18874368, O_SS = 18939904, O_SHP = 19988480, O_SHS = 19991808;
constexpr size_t W_XB = 0, W_WINT = 34603008, W_WOUTT = 43253760, W_WUPT = 45350912, W_AUPT = 45416448, W_RSTD = 45481984,
                 W_BONUS = 264339456  , W_PROJ = 46090240, W_GT = 188827648, W_HH = 207702016, W_QT = 226576384, W_SST = 245450752, W_BAR = 264325120;
constexpr int LDS_BYTES = 75776;
constexpr float LOG2E = 1.4426950408889634f;

struct Params {
    const float *x_p, *x_s, *cache_k, *cache_v, *st_wkv, *st_shift, *norm_g, *w_in, *q_g, *k_g, *relb, *mix, *w0, *w_up, *a0, *a_up,
        *k_k, *k_a, *r_k, *gn_g, *gn_b, *w_out;
    float* out;
    char* ws;
};

DI unsigned pack2(float lo, float hi) { f32x2_t v = {lo, hi}; bf16x2_t b = __builtin_convertvector(v, bf16x2_t); return __builtin_bit_cast(unsigned, b); }
DI u16 f2bf(float f) { return (u16)(pack2(f, 0.f) & 0xffffu); }
DI float bflo(unsigned u) { return __uint_as_float(u << 16); }
DI float bfhi(unsigned u) { return __uint_as_float(u & 0xffff0000u); }
DI float bf2f(u16 h) { return __uint_as_float((unsigned)h << 16); }
DI float4 ntld4(const float* p) { const f32x4 v = __builtin_nontemporal_load((const f32x4*)p); return (float4){v[0], v[1], v[2], v[3]}; }
DI int swz(int row, int ch) { return row * 128 + ((ch ^ ((row >> 1) & 7)) << 4); }
DI float dpp_add(float v, const int ctrl_sel) {
    int x = __float_as_int(v), y;
    if (ctrl_sel == 0) y = __builtin_amdgcn_update_dpp(0, x, 0xB1, 0xf, 0xf, true);
    else if (ctrl_sel == 1) y = __builtin_amdgcn_update_dpp(0, x, 0x4E, 0xf, 0xf, true);
    else if (ctrl_sel == 2) y = __builtin_amdgcn_update_dpp(0, x, 0x141, 0xf, 0xf, true);
    else y = __builtin_amdgcn_update_dpp(0, x, 0x140, 0xf, 0xf, true);
    return v + __int_as_float(y);
}
DI float wave_sum(float v) {
    v = dpp_add(v, 0); v = dpp_add(v, 1); v = dpp_add(v, 2); v = dpp_add(v, 3);
    const int x = __float_as_int(v);
    const float a = __int_as_float(__builtin_amdgcn_readlane(x, 0)), b = __int_as_float(__builtin_amdgcn_readlane(x, 16)),
                c = __int_as_float(__builtin_amdgcn_readlane(x, 32)), d = __int_as_float(__builtin_amdgcn_readlane(x, 48));
    return (a + b) + (c + d);
}
DI float rcpf_(float x) { return __builtin_amdgcn_rcpf(x); }
DI float silu(float x) { return x * rcpf_(1.f + __expf(-x)); }
DI float xadd16(float v) { const unsigned x = __float_as_uint(v); auto r = __builtin_amdgcn_permlane16_swap(x, x, false, false); return __uint_as_float(r[0]) + __uint_as_float(r[1]); }
DI float xadd32(float v) { const unsigned x = __float_as_uint(v); auto r = __builtin_amdgcn_permlane32_swap(x, x, false, false); return __uint_as_float(r[0]) + __uint_as_float(r[1]); }
DI float xmax16(float v) { const unsigned x = __float_as_uint(v); auto r = __builtin_amdgcn_permlane16_swap(x, x, false, false); return fmaxf(__uint_as_float(r[0]), __uint_as_float(r[1])); }
DI uint4 widen16(uint2 w0, uint2 w1) {
    auto rx = __builtin_amdgcn_permlane16_swap(w0.x, w1.x, false, false); auto ry = __builtin_amdgcn_permlane16_swap(w0.y, w1.y, false, false);
    return (uint4){rx[0], ry[0], rx[1], ry[1]};
}
DI void unwiden16(uint4 L, uint2& w0, uint2& w1) {
    auto rx = __builtin_amdgcn_permlane16_swap(L.x, L.z, false, false); auto ry = __builtin_amdgcn_permlane16_swap(L.y, L.w, false, false);
    w0 = (uint2){rx[0], ry[0]}; w1 = (uint2){rx[1], ry[1]};
}
DI float xmax32(float v) { const unsigned x = __float_as_uint(v); auto r = __builtin_amdgcn_permlane32_swap(x, x, false, false); return fmaxf(__uint_as_float(r[0]), __uint_as_float(r[1])); }
DI void unpack8(uint4 u, float* o) {
    o[0] = bflo(u.x); o[1] = bfhi(u.x); o[2] = bflo(u.y); o[3] = bfhi(u.y); o[4] = bflo(u.z); o[5] = bfhi(u.z); o[6] = bflo(u.w); o[7] = bfhi(u.w);
}

DI void transpose_tile(const float* W, int K, int N, const float* gain, u16* dst, float* tile, int t) {
    const int nkt = K / 64; const int kt = t % nkt, nt = t / nkt; const int k0 = kt * 64, n0 = nt * 64;
    const int tid = threadIdx.x, lane = tid & 63, wave = tid >> 6;
    float4 wv[4];
#pragma unroll
    for (int i = 0; i < 4; ++i) { const int idx = tid + 256 * i; wv[i] = ntld4(W + (size_t)(k0 + (idx >> 4)) * N + n0 + 4 * (idx & 15)); }
    const float gl = gain ? gain[k0 + lane] : 1.f;
#pragma unroll
    for (int i = 0; i < 4; ++i) { const int kr = 16 * i + 4 * wave + (lane >> 4);
        const float g = __shfl(gl, kr); float* tp = tile + kr * 65 + 4 * (lane & 15);
        tp[0] = wv[i].x * g; tp[1] = wv[i].y * g; tp[2] = wv[i].z * g; tp[3] = wv[i].w * g; }
    __syncthreads();
#pragma unroll 4
    for (int i = 0; i < 8; ++i) { const int n = i * 8 + (tid >> 5); const int kp = tid & 31;
        const unsigned v = pack2(tile[(2 * kp) * 65 + n], tile[(2 * kp + 1) * 65 + n]); *(unsigned*)(dst + (size_t)(n0 + n) * K + k0 + 2 * kp) = v; }
    __syncthreads();
}
DI void phase_prep(const Params& p, char* lds) {
    const int tid = threadIdx.x, lane = tid & 63, wave = tid >> 6;
    u16* xb = (u16*)(p.ws + W_XB); float* rstd = (float*)(p.ws + W_RSTD);
    for (int rg = blockIdx.x * 4 + wave; rg < NTOK / 4; rg += gridDim.x * 4) {
        float4 v[4][4]; float ss[4];
#pragma unroll
        for (int k = 0; k < 4; ++k) { const int row = rg * 4 + k; const float* src = row < NTP ? p.x_p + (size_t)row * DM : p.x_s + (size_t)(row - NTP) * DM;
#pragma unroll
            for (int i = 0; i < 4; ++i) v[k][i] = ((const float4*)src)[i * 64 + lane]; }
#pragma unroll
        for (int k = 0; k < 4; ++k) { float a = 0.f;
#pragma unroll
            for (int i = 0; i < 4; ++i) a += v[k][i].x * v[k][i].x + v[k][i].y * v[k][i].y + v[k][i].z * v[k][i].z + v[k][i].w * v[k][i].w;
            ss[k] = wave_sum(a); }
#pragma unroll
        for (int k = 0; k < 4; ++k) { const int row = rg * 4 + k;
            if (lane == 0) rstd[row] = rsqrtf(ss[k] * (1.f / 1024.f) + 1e-6f);
#pragma unroll
            for (int i = 0; i < 4; ++i) { uint2 w; w.x = pack2(v[k][i].x, v[k][i].y); w.y = pack2(v[k][i].z, v[k][i].w); *(uint2*)(xb + (size_t)row * DM + (i * 64 + lane) * 4) = w; } }
    }
    float* tile = (float*)lds;
    for (int t = blockIdx.x; t < 1056 + 256 + 16; t += gridDim.x) {
        if (t < 1056) transpose_tile(p.w_in, 1024, NC, p.norm_g, (u16*)(p.ws + W_WINT), tile, t);
        else if (t < 1312) transpose_tile(p.w_out, 1024, 1024, nullptr, (u16*)(p.ws + W_WOUTT), tile, t - 1056);
        else if (t < 1320) transpose_tile(p.w_up, 64, 512, nullptr, (u16*)(p.ws + W_WUPT), tile, t - 1312);
        else transpose_tile(p.a_up, 64, 512, nullptr, (u16*)(p.ws + W_AUPT), tile, t - 1320);
    }
}

template <class Epi>
DI void gemm_phase(const u16* __restrict__ A, const u16* __restrict__ B, int mtiles, int ntiles, char* lds, const Epi& epi) {
    const int ntile = mtiles * ntiles;
    const int vb = (blockIdx.x & 7) * (gridDim.x >> 3) + (blockIdx.x >> 3);
    const int npan = ntiles >> 3;
    int tile = vb; if (tile >= ntile) return;
#define TILE_MN(t, M0, N0) do { int pan_ = (t) / (mtiles * 8); if (pan_ >= npan) pan_ = npan - 1; const int pw_ = (pan_ == npan - 1) ? ntiles - 8 * pan_ : 8; const int loc_ = (t) - pan_ * mtiles * 8; \
        M0 = (loc_ / pw_) * 128; N0 = (8 * pan_ + loc_ % pw_) * 128; } while (0)
#define GSTAGE(buf, kt, GA, GB) do { _Pragma("unroll") for (int i = 0; i < 4; ++i) { \
            __builtin_amdgcn_global_load_lds((const unsigned*)((GA) + soff[i] + (kt) * 64), (LAS unsigned*)(lds + (buf) * 32768 + (i * 4 + wave) * 1024), 16, 0, 0); \
            __builtin_amdgcn_global_load_lds((const unsigned*)((GB) + soff[i] + (kt) * 64), (LAS unsigned*)(lds + (buf) * 32768 + 16384 + (i * 4 + wave) * 1024), 16, 0, 0); } } while (0)
    int m0, n0; TILE_MN(tile, m0, n0);
    {
        const int lane = threadIdx.x & 63, wave = __builtin_amdgcn_readfirstlane(threadIdx.x >> 6);
        unsigned soff[4];
#pragma unroll
        for (int i = 0; i < 4; ++i) { const int row = 8 * (i * 4 + wave) + (lane >> 3); const int ch = (lane & 7) ^ ((row >> 1) & 7); soff[i] = (unsigned)(row * 1024 + ch * 8); }
        GSTAGE(0, 0, A + (size_t)m0 * 1024, B + (size_t)n0 * 1024);
    }
    for (;;) {
        int tid = threadIdx.x; asm volatile("" : "+v"(tid));
        const int lane = tid & 63, wave = __builtin_amdgcn_readfirstlane(tid >> 6); const int wn = wave >> 1, wm = wave & 1; const int r = lane & 31, h = lane >> 5;
        f32x16 acc[2][2];
#pragma unroll
        for (int a = 0; a < 2; ++a)
#pragma unroll
            for (int b = 0; b < 2; ++b)
#pragma unroll
                for (int e = 0; e < 16; ++e) acc[a][b][e] = 0.f;
        unsigned soff[4];
#pragma unroll
        for (int i = 0; i < 4; ++i) { const int row = 8 * (i * 4 + wave) + (lane >> 3); const int ch = (lane & 7) ^ ((row >> 1) & 7); soff[i] = (unsigned)(row * 1024 + ch * 8); }
        const u16* ga = A + (size_t)m0 * 1024; const u16* gb = B + (size_t)n0 * 1024;
        __syncthreads();
        for (int kt = 0; kt < 16; ++kt) {
            if (kt + 1 < 16) GSTAGE((kt + 1) & 1, kt + 1, ga, gb);
            const char* sa = lds + (kt & 1) * 32768; const char* sb = sa + 16384;
#pragma unroll
            for (int ks = 0; ks < 4; ++ks) {
                bf16x8 fw[2], fx[2];
#pragma unroll
                for (int ct = 0; ct < 2; ++ct) fw[ct] = *(const bf16x8*)(sb + swz(wn * 64 + ct * 32 + r, 2 * ks + h));
#pragma unroll
                for (int tt = 0; tt < 2; ++tt) fx[tt] = *(const bf16x8*)(sa + swz(wm * 64 + tt * 32 + r, 2 * ks + h));
#pragma unroll
                for (int ct = 0; ct < 2; ++ct)
#pragma unroll
                    for (int tt = 0; tt < 2; ++tt) acc[ct][tt] = __builtin_amdgcn_mfma_f32_32x32x16_bf16(fw[ct], fx[tt], acc[ct][tt], 0, 0, 0);
            }
            __syncthreads();
        }
        const int nxt = tile + (int)gridDim.x; int m1 = 0, n1 = 0;
        if (nxt < ntile) { TILE_MN(nxt, m1, n1); GSTAGE(0, 0, A + (size_t)m1 * 1024, B + (size_t)n1 * 1024); }
        epi(acc, m0 + wm * 64, n0 + wn * 64, lane);
        if (nxt >= ntile) break;
        tile = nxt; m0 = m1; n0 = n1;
    }
#undef GSTAGE
#undef TILE_MN
}

struct Epi1 {
    const Params* p;
    DI void operator()(f32x16 (&acc)[2][2], int mrow0, int ncol0, int lane) const {
        const int r = lane & 31, h = lane >> 5; const int cb = ncol0 >> 6;
        u16* proj = (u16*)(p->ws + W_PROJ); const float* rstd = (const float*)(p->ws + W_RSTD); float* out = p->out;
#pragma unroll
        for (int tt = 0; tt < 2; ++tt) {
            const int row = mrow0 + tt * 32 + r; const float rs = rstd[row];
            float v[2][16];
#pragma unroll
            for (int ct = 0; ct < 2; ++ct)
#pragma unroll
                for (int e = 0; e < 16; ++e) v[ct][e] = acc[ct][tt][e] * rs;
            if (cb < 16) {
                float ss = 0.f;
#pragma unroll
                for (int ct = 0; ct < 2; ++ct)
#pragma unroll
                    for (int e = 0; e < 16; ++e) ss += v[ct][e] * v[ct][e];
                ss = xadd32(ss);
                const float inv = __builtin_amdgcn_rsqf(ss * (1.f / 64.f) + 1e-6f);
                const float* g = cb < 8 ? p->q_g : p->k_g;
#pragma unroll
                for (int ct = 0; ct < 2; ++ct)
#pragma unroll
                    for (int gq = 0; gq < 4; ++gq) { const float4 gg = *(const float4*)(g + ct * 32 + 8 * gq + 4 * h);
                        v[ct][4 * gq] *= inv * gg.x; v[ct][4 * gq + 1] *= inv * gg.y; v[ct][4 * gq + 2] *= inv * gg.z; v[ct][4 * gq + 3] *= inv * gg.w; }
            }
#pragma unroll
            for (int ct = 0; ct < 2; ++ct)
#pragma unroll
                for (int gq = 0; gq < 4; gq += 2) {
                    unsigned ax = pack2(v[ct][4 * gq], v[ct][4 * gq + 1]), ay = pack2(v[ct][4 * gq + 2], v[ct][4 * gq + 3]);
                    unsigned bx = pack2(v[ct][4 * gq + 4], v[ct][4 * gq + 5]), by = pack2(v[ct][4 * gq + 6], v[ct][4 * gq + 7]);
                    { auto rr = __builtin_amdgcn_permlane32_swap(ax, bx, false, false); ax = rr[0]; bx = rr[1]; }
                    { auto rr = __builtin_amdgcn_permlane32_swap(ay, by, false, false); ay = rr[0]; by = rr[1]; }
                    *(uint4*)(proj + (size_t)row * NC + ncol0 + ct * 32 + 8 * gq + 8 * h) = (uint4){ax, ay, bx, by};
                }
            float* dst = nullptr;
            if (cb >= 8 && cb < 24) {
                const int hh = cb & 7;
                if (row < NTP) { const int b = row >> 13, t = row & 8191; if (t >= 7680) dst = out + (cb < 16 ? O_KP : O_VP) + ((size_t)(b * 8 + hh) * 512 + (t - 7680)) * 64; }
                else { const int s = row - NTP; const int b = s >> 4, t = s & 15; dst = out + (cb < 16 ? O_KS : O_VS) + ((size_t)(b * 8 + hh) * 16 + t) * 64; }
            } else if (cb >= 32 && cb < 58) {
                if (row < NTP) { if ((row & 8191) == 8191) dst = out + O_SHP + (size_t)(row >> 13) * 1664 + (cb - 32) * 64; }
                else { const int s = row - NTP; if ((s & 15) == 15) dst = out + O_SHS + (size_t)(s >> 4) * 1664 + (cb - 32) * 64; }
            }
            if (dst) {
#pragma unroll
                for (int ct = 0; ct < 2; ++ct)
#pragma unroll
                    for (int gq = 0; gq < 4; ++gq) { float4 w = {v[ct][4 * gq], v[ct][4 * gq + 1], v[ct][4 * gq + 2], v[ct][4 * gq + 3]}; *(float4*)(dst + ct * 32 + 8 * gq + 4 * h) = w; }
            }
        }
    }
};
struct Epi2 {
    const Params* p;
    DI void operator()(f32x16 (&acc)[2][2], int mrow0, int ncol0, int lane) const {
        const int r = lane & 31, h = lane >> 5;
#pragma unroll
        for (int tt = 0; tt < 2; ++tt) {
            const int row = mrow0 + tt * 32 + r;
            const float* xr = row < NTP ? p->x_p + (size_t)row * DM : p->x_s + (size_t)(row - NTP) * DM;
            float* o = p->out + (size_t)row * DM;
#pragma unroll
            for (int ct = 0; ct < 2; ++ct)
#pragma unroll
                for (int gq = 0; gq < 4; ++gq) { const int col = ncol0 + ct * 32 + 8 * gq + 4 * h; const float4 xv = *(const float4*)(xr + col);
                    float4 w = {xv.x + acc[ct][tt][4 * gq], xv.y + acc[ct][tt][4 * gq + 1], xv.z + acc[ct][tt][4 * gq + 2], xv.w + acc[ct][tt][4 * gq + 3]}; *(float4*)(o + col) = w; }
        }
    }
};

DI void gemm_out(const Params& p, char* lds) {
    const u16* __restrict__ A = (const u16*)(p.ws + W_XB); const u16* __restrict__ B = (const u16*)(p.ws + W_WOUTT);
    const int ntile = 176 * 8;
    const int vb = (blockIdx.x & 7) * (gridDim.x >> 3) + (blockIdx.x >> 3);
    for (int tile = vb; tile < ntile; tile += gridDim.x) {
        int tid = threadIdx.x; asm volatile("" : "+v"(tid));
        const int lane = tid & 63, wave = __builtin_amdgcn_readfirstlane(tid >> 6); const int wn = wave >> 1, wm = wave & 1; const int q = lane & 15, g = lane >> 4;
        const int mt = tile >> 3, nt = tile & 7; const int m0 = mt * 96, n0 = nt * 128;
        f32x4 acc[4][3];
#pragma unroll
        for (int a = 0; a < 4; ++a)
#pragma unroll
            for (int b = 0; b < 3; ++b) acc[a][b] = (f32x4){0.f, 0.f, 0.f, 0.f};
        unsigned soffb[4], soffa[3];
#pragma unroll
        for (int i = 0; i < 4; ++i) { const int row = 8 * (i * 4 + wave) + (lane >> 3); const int ch = (lane & 7) ^ ((row >> 1) & 7); soffb[i] = (unsigned)(row * 1024 + ch * 8); }
#pragma unroll
        for (int i = 0; i < 3; ++i) { const int row = 8 * (i * 4 + wave) + (lane >> 3); const int ch = (lane & 7) ^ ((row >> 1) & 7); soffa[i] = (unsigned)(row * 1024 + ch * 8); }
        const u16* ga = A + (size_t)m0 * 1024; const u16* gb = B + (size_t)n0 * 1024;
#define OSTAGE(buf, kt) do { _Pragma("unroll") for (int i = 0; i < 4; ++i) \
            __builtin_amdgcn_global_load_lds((const unsigned*)(gb + soffb[i] + (kt) * 64), (LAS unsigned*)(lds + (buf) * 28672 + (i * 4 + wave) * 1024), 16, 0, 0); \
        _Pragma("unroll") for (int i = 0; i < 3; ++i) \
            __builtin_amdgcn_global_load_lds((const unsigned*)(ga + soffa[i] + (kt) * 64), (LAS unsigned*)(lds + (buf) * 28672 + 16384 + (i * 4 + wave) * 1024), 16, 0, 0); } while (0)
        OSTAGE(0, 0);
        float4 xres[3][4];
#pragma unroll
        for (int tt = 0; tt < 3; ++tt) { const int row = m0 + wm * 48 + tt * 16 + q; const float* xr = row < NTP ? p.x_p + (size_t)row * DM : p.x_s + (size_t)(row - NTP) * DM;
#pragma unroll
            for (int ct = 0; ct < 4; ++ct) xres[tt][ct] = ntld4(xr + n0 + wn * 64 + ct * 16 + 4 * g); }
        __syncthreads();
        for (int kt = 0; kt < 16; ++kt) {
            if (kt + 1 < 16) OSTAGE((kt + 1) & 1, kt + 1);
            const char* sb = lds + (kt & 1) * 28672; const char* sa = sb + 16384;
#pragma unroll
            for (int ks = 0; ks < 2; ++ks) {
                bf16x8 fw[4], fx[3];
#pragma unroll
                for (int ct = 0; ct < 4; ++ct) fw[ct] = *(const bf16x8*)(sb + swz(wn * 64 + ct * 16 + q, 4 * ks + g));
#pragma unroll
                for (int tt = 0; tt < 3; ++tt) fx[tt] = *(const bf16x8*)(sa + swz(wm * 48 + tt * 16 + q, 4 * ks + g));
#pragma unroll
                for (int ct = 0; ct < 4; ++ct)
#pragma unroll
                    for (int tt = 0; tt < 3; ++tt) acc[ct][tt] = __builtin_amdgcn_mfma_f32_16x16x32_bf16(fw[ct], fx[tt], acc[ct][tt], 0, 0, 0);
            }
            __syncthreads();
        }
#undef OSTAGE
#pragma unroll
        for (int tt = 0; tt < 3; ++tt) {
            const int row = m0 + wm * 48 + tt * 16 + q;
            const float* xr = row < NTP ? p.x_p + (size_t)row * DM : p.x_s + (size_t)(row - NTP) * DM;
            float* o = p.out + (size_t)row * DM;
#pragma unroll
            for (int ct = 0; ct < 4; ++ct) { const int col = n0 + wn * 64 + ct * 16 + 4 * g; const float4 xv = xres[tt][ct];
                float4 w = {xv.x + acc[ct][tt][0], xv.y + acc[ct][tt][1], xv.z + acc[ct][tt][2], xv.w + acc[ct][tt][3]}; *(float4*)(o + col) = w; }
        }
    }
}

DI f32x16 mmq(const char* X, const char* Y, int qm, int qn, f32x16 acc, int lane) {
    const int r = lane & 31, h = lane >> 5;
#pragma unroll
    for (int ks = 0; ks < 4; ++ks) {
        const bf16x8 a = *(const bf16x8*)(X + swz(32 * qm + r, 2 * ks + h));
        const bf16x8 b = *(const bf16x8*)(Y + swz(32 * qn + r, 2 * ks + h));
        acc = __builtin_amdgcn_mfma_f32_32x32x16_bf16(a, b, acc, 0, 0, 0);
    }
    return acc;
}
DI void st_nat(char* img, const f32x16& a, int qm, int qn, int lane) {
    const int n = 32 * qn + (lane & 31), h = lane >> 5;
#pragma unroll
    for (int g = 0; g < 4; ++g) { const int m = 32 * qm + 8 * g + 4 * h; uint2 w; w.x = pack2(a[4 * g], a[4 * g + 1]); w.y = pack2(a[4 * g + 2], a[4 * g + 3]);
        *(uint2*)(img + swz(n, m >> 3) + (m & 7) * 2) = w; }
}
DI void st_nat_g(u16* gimg, const f32x16& a, int qm, int qn, int lane) {
    const int n = 32 * qn + (lane & 31), h = lane >> 5;
#pragma unroll
    for (int g = 0; g < 4; ++g) { const int m = 32 * qm + 8 * g + 4 * h; uint2 w; w.x = pack2(a[4 * g], a[4 * g + 1]); w.y = pack2(a[4 * g + 2], a[4 * g + 3]);
        *(uint2*)(gimg + n * 64 + m) = w; }
}
DI void st_nat_gp(u16* gimg, const f32x16& a, int qm, int qn, int lane) {
    const int n = 32 * qn + (lane & 31), h = lane >> 5;
#pragma unroll
    for (int g = 0; g < 2; ++g) { const int m = 32 * qm + 8 * g + 4 * h; const int mp = (m & ~0x1c) | ((m & 0xc) << 1) | ((m & 0x10) >> 2);
        uint4 w; w.x = pack2(a[4 * g], a[4 * g + 1]); w.y = pack2(a[4 * g + 2], a[4 * g + 3]); w.z = pack2(a[4 * g + 8], a[4 * g + 9]); w.w = pack2(a[4 * g + 10], a[4 * g + 11]);
        *(uint4*)(gimg + n * 64 + mp) = w; }
}
DI void st_sc(char* img, const f32x16& a, int qm, int qn, int lane) {
    const int n = 32 * qn + (lane & 31), h = lane >> 5;
#pragma unroll
    for (int e = 0; e < 16; ++e) { const int m = 32 * qm + (e & 3) + 8 * (e >> 2) + 4 * h; *(u16*)(img + swz(m, n >> 3) + (n & 7) * 2) = f2bf(a[e]); }
}
DI f32x16 ld_nat(const char* img, int qm, int qn, int lane) {
    const int n = 32 * qn + (lane & 31), h = lane >> 5; f32x16 a;
#pragma unroll
    for (int g = 0; g < 4; ++g) { const int m = 32 * qm + 8 * g + 4 * h; const uint2 w = *(const uint2*)(img + swz(n, m >> 3) + (m & 7) * 2);
        a[4 * g] = bflo(w.x); a[4 * g + 1] = bfhi(w.x); a[4 * g + 2] = bflo(w.y); a[4 * g + 3] = bfhi(w.y); }
    return a;
}
DI void ld_cur_prev8(const Params& p, int row, int col, int mode, int sb, float* cur, float* prev) {
    const u16* proj = (const u16*)(p.ws + W_PROJ);
    unpack8(*(const uint4*)(proj + (size_t)row * NC + col), cur);
    if (mode == 0) unpack8(*(const uint4*)(proj + (size_t)(row - 1) * NC + col), prev);
    else if (mode == 1) { for (int i = 0; i < 8; ++i) prev[i] = 0.f; }
    else { const float* s = p.st_shift + (size_t)sb * 1664 + (col - C_R); const float4 a = *(const float4*)s, b = *(const float4*)(s + 4);
        prev[0] = a.x; prev[1] = a.y; prev[2] = a.z; prev[3] = a.w; prev[4] = b.x; prev[5] = b.y; prev[6] = b.z; prev[7] = b.w; }
}
DI float ld_prev1(const Params& p, int row, int col, int mode, int sb) {
    const u16* proj = (const u16*)(p.ws + W_PROJ);
    if (mode == 0) return bf2f(proj[(size_t)(row - 1) * NC + col]);
    if (mode == 1) return 0.f;
    return p.st_shift[(size_t)sb * 1664 + (col - C_R)];
}

DI void phase_rwkv_prep(const Params& p, char* lds) {
    const u16* proj = (const u16*)(p.ws + W_PROJ);
    char* R0 = lds; char* R1 = lds + 8192; char* R2 = lds + 2 * 8192; char* R3 = lds + 3 * 8192; char* R4 = lds + 4 * 8192; char* R5 = lds + 5 * 8192;
    char* R6 = lds + 6 * 8192; char* R7 = lds + 7 * 8192; char* R8 = lds + 8 * 8192;
    float* tot = (float*)(lds + 9 * 8192); float* gam = tot + 256;
    for (int u = blockIdx.x; u < NUNIT; u += gridDim.x) {
        int tid = threadIdx.x; asm volatile("" : "+v"(tid));
        const int lane = tid & 63, wave = __builtin_amdgcn_readfirstlane(tid >> 6); const int qm = wave >> 1, qn = wave & 1; const int r = lane & 31, h5 = lane >> 5;
        int b, h, c, row0, ntok; bool prm = u < 2048;
        if (prm) { b = u >> 10; h = (u >> 7) & 7; c = u & 127; row0 = b * 8192 + c * 64; ntok = 64; }
        else { const int s = u - 2048; b = s >> 3; h = s & 7; c = 0; row0 = NTP + b * 16; ntok = 16; }
        const int mode0 = prm ? (c > 0 ? 0 : 1) : 2;
        uint4 wr_[2], wk_[2], wv_[2];
#pragma unroll
        for (int i = 0; i < 2; ++i) { wr_[i] = (uint4){0, 0, 0, 0}; wk_[i] = wr_[i]; wv_[i] = wr_[i];
            if (16 * wave < ntok) { const u16* src = proj + (size_t)(row0 + 16 * wave + 8 * i + (lane >> 3)) * NC + h * 64 + 8 * (lane & 7);
                wr_[i] = *(const uint4*)(src + C_R); wk_[i] = *(const uint4*)(src + C_RK); wv_[i] = *(const uint4*)(src + C_RV); } }
        {
            const int t = tid >> 2, q = tid & 3;
#pragma unroll
            for (int half = 0; half < 2; ++half) {
                const int cw = q * 16 + half * 8;
                uint4 ow = {0, 0, 0, 0}, oa = {0, 0, 0, 0};
                if (t < ntok) {
                    const int mode = t > 0 ? 0 : mode0; float cur[8], prv[8], xw[8], xa[8];
                    ld_cur_prev8(p, row0 + t, C_WD + cw, mode, b, cur, prv);
                    { const float4 ma = *(const float4*)(p.mix + 1536 + cw), mb = *(const float4*)(p.mix + 1540 + cw); const float mx_[8] = {ma.x, ma.y, ma.z, ma.w, mb.x, mb.y, mb.z, mb.w};
#pragma unroll
                    for (int i = 0; i < 8; ++i) { const float x = cur[i] + (prv[i] - cur[i]) * mx_[i]; const float e2 = __expf(2.f * x); xw[i] = 1.f - 2.f * rcpf_(e2 + 1.f); } }
                    ld_cur_prev8(p, row0 + t, C_AD + cw, mode, b, cur, prv);
                    { const float4 ma = *(const float4*)(p.mix + 1600 + cw), mb = *(const float4*)(p.mix + 1604 + cw); const float mx_[8] = {ma.x, ma.y, ma.z, ma.w, mb.x, mb.y, mb.z, mb.w};
#pragma unroll
                    for (int i = 0; i < 8; ++i) xa[i] = cur[i] + (prv[i] - cur[i]) * mx_[i]; }
                    ow.x = pack2(xw[0], xw[1]); ow.y = pack2(xw[2], xw[3]); ow.z = pack2(xw[4], xw[5]); ow.w = pack2(xw[6], xw[7]);
                    oa.x = pack2(xa[0], xa[1]); oa.y = pack2(xa[2], xa[3]); oa.z = pack2(xa[4], xa[5]); oa.w = pack2(xa[6], xa[7]);
                }
                *(uint4*)(R0 + swz(t, 2 * q + half)) = ow; *(uint4*)(R1 + swz(t, 2 * q + half)) = oa;
            }
        }
        __syncthreads();
        {
            f32x16 adw, ada;
#pragma unroll
            for (int e = 0; e < 16; ++e) { adw[e] = 0.f; ada[e] = 0.f; }
            const u16* wup = (const u16*)(p.ws + W_WUPT) + (size_t)(h * 64 + 32 * qn + r) * 64; const u16* aup = (const u16*)(p.ws + W_AUPT) + (size_t)(h * 64 + 32 * qn + r) * 64;
#pragma unroll
            for (int ks = 0; ks < 4; ++ks) {
                const bf16x8 xa = *(const bf16x8*)(R0 + swz(32 * qm + r, 2 * ks + h5)); const bf16x8 xb = *(const bf16x8*)(R1 + swz(32 * qm + r, 2 * ks + h5));
                const bf16x8 ya = *(const bf16x8*)(wup + 16 * ks + 8 * h5); const bf16x8 yb = *(const bf16x8*)(aup + 16 * ks + 8 * h5);
                adw = __builtin_amdgcn_mfma_f32_32x32x16_bf16(xa, ya, adw, 0, 0, 0); ada = __builtin_amdgcn_mfma_f32_32x32x16_bf16(xb, yb, ada, 0, 0, 0);
            }
            float* DW = (float*)R4; float* DA = (float*)R6; const int n = 32 * qn + r;
#pragma unroll
            for (int e = 0; e < 16; ++e) { const int m = 32 * qm + (e & 3) + 8 * (e >> 2) + 4 * h5; DW[m * 64 + n] = adw[e]; DA[m * 64 + n] = ada[e]; }
        }
        __syncthreads();
        {
            const int tg = wave, j = lane, hj = h * 64 + j;
            float* DW = (float*)R4; const float* DA = (const float*)R6;
            { const float w0j = p.w0[hj];
                float run = 0.f;
#pragma unroll 4
                for (int i = 0; i < 16; ++i) { const int t = 16 * tg + i; const float x = w0j + DW[t * 64 + j];
                    const float z = -x; const float sp = fmaxf(z, 0.f) + __logf(1.f + __expf(-fabsf(z))); float l = -__expf(-sp - 0.5f); if (t >= ntok) l = 0.f; DW[t * 64 + j] = l; run += l; }
                tot[tg * 64 + j] = run;
            }
            __syncthreads();
            float prefix = 0.f, ctot = 0.f;
#pragma unroll
            for (int g = 0; g < 4; ++g) { const float v = tot[g * 64 + j]; if (g < tg) prefix += v; ctot += v; }
            if (tg == 0) gam[j] = __expf(ctot);
            const float a0j = p.a0[hj], kkj = p.k_k[hj], kaj = p.k_a[hj], rkj = p.r_k[hj];
            const float mr = p.mix[hj], mk = p.mix[512 + hj], mv = p.mix[1024 + hj];
            float* bonus = (float*)(p.ws + W_BONUS);
            float mybon = 0.f;
            u16 gcr[16], gck[16], gcv[16];
            { char* tb = R8 + wave * 2048; char* wp = tb + (lane >> 3) * 128 + (lane & 7) * 16; const char* rp = tb + lane * 2;
#define XPOSE16(W, OUT) do { asm volatile("s_waitcnt lgkmcnt(0)" ::: "memory"); *(uint4*)wp = W[0]; *(uint4*)(wp + 1024) = W[1]; asm volatile("s_waitcnt lgkmcnt(0)" ::: "memory"); \
                    _Pragma("unroll") for (int tt = 0; tt < 16; ++tt) OUT[tt] = *(const u16*)(rp + tt * 128); } while (0)
                XPOSE16(wr_, gcr); XPOSE16(wk_, gck); XPOSE16(wv_, gcv);
#undef XPOSE16
            }
            float pr = 0.f, pk = 0.f, pv = 0.f;
            { const int t0 = 16 * tg; if (t0 < ntok) { const int mode = t0 > 0 ? 0 : mode0; pr = ld_prev1(p, row0 + t0, C_R + hj, mode, b); pk = ld_prev1(p, row0 + t0, C_RK + hj, mode, b); pv = ld_prev1(p, row0 + t0, C_RV + hj, mode, b); } }
            float ecl = __expf(prefix); const float etot = __expf(ctot);
            unsigned pAt[8], pV[8], pKb[8], pBb[8]; float hAt = 0.f, hV = 0.f, hKb = 0.f, hBb = 0.f;
#pragma unroll
            for (int i = 0; i < 16; ++i) {
                const int t = 16 * tg + i; const bool valid = t < ntok;
                float xr = 0.f, xk = 0.f, xv = 0.f;
                if (valid) { const float cr = bf2f(gcr[i]), ck = bf2f(gck[i]), cv = bf2f(gcv[i]);
                    xr = cr + (pr - cr) * mr; xk = ck + (pk - ck) * mk; xv = cv + (pv - cv) * mv; pr = cr; pk = ck; pv = cv; }
                const float a = rcpf_(1.f + __expf(-(a0j + DA[t * 64 + j])));
                const float kx = xk * kkj; const float ss = wave_sum(kx * kx); const float kk = kx * __builtin_amdgcn_rsqf(fmaxf(ss, 1e-24f));
                const float kmod = xk * (1.f + (a - 1.f) * kaj);
                const float bon = wave_sum(xr * kmod * rkj);
                if (lane == i) mybon = bon;
                const float e_ce = ecl; ecl *= __expf(DW[t * 64 + j]);
                const float e_cl = ecl, e_n = rcpf_(ecl), e_t = etot * e_n;
                const float vAt = -kk * e_ce, vRt = xr * e_cl, vBt = kk * a * e_n, vKt = kmod * e_n, vBb = kk * a * e_t, vKb = kmod * e_t;
                const int so = swz(t, j >> 3) + (j & 7) * 2;
                *(u16*)(R0 + so) = f2bf(vAt); *(u16*)(R1 + so) = f2bf(vRt); *(u16*)(R2 + so) = f2bf(vBt); *(u16*)(R3 + so) = f2bf(vKt);
                if (i & 1) { pAt[i >> 1] = pack2(hAt, vAt); pV[i >> 1] = pack2(hV, xv); pKb[i >> 1] = pack2(hKb, vKb); pBb[i >> 1] = pack2(hBb, vBb); }
                else { hAt = vAt; hV = xv; hKb = vKb; hBb = vBb; }
            }
            if (lane < 16) bonus[(size_t)u * 64 + 16 * tg + lane] = mybon;
            __syncthreads();
#pragma unroll
            for (int half = 0; half < 2; ++half) { const int o = swz(j, 2 * tg + half);
                *(uint4*)(R4 + o) = (uint4){pAt[4 * half], pAt[4 * half + 1], pAt[4 * half + 2], pAt[4 * half + 3]};
                *(uint4*)(R5 + o) = (uint4){pV[4 * half], pV[4 * half + 1], pV[4 * half + 2], pV[4 * half + 3]};
                *(uint4*)(R6 + o) = (uint4){pKb[4 * half], pKb[4 * half + 1], pKb[4 * half + 2], pKb[4 * half + 3]};
                *(uint4*)(R7 + o) = (uint4){pBb[4 * half], pBb[4 * half + 1], pBb[4 * half + 2], pBb[4 * half + 3]}; }
        }
        __syncthreads();
        f32x16 z16;
#pragma unroll
        for (int e = 0; e < 16; ++e) z16[e] = 0.f;
        f32x16 aN = mmq(R2, R0, qm, qn, z16, lane);
        f32x16 aKa = mmq(R3, R0, qm, qn, z16, lane);
        f32x16 aW1 = mmq(R2, R1, qm, qn, z16, lane);
        f32x16 aKr = mmq(R3, R1, qm, qn, z16, lane);
        {
            const int n = 32 * qn + r;
#pragma unroll
            for (int e = 0; e < 16; ++e) { const int m = 32 * qm + (e & 3) + 8 * (e >> 2) + 4 * h5;
                if (!(m < n)) { aN[e] = 0.f; aKa[e] = 0.f; } if (!(m <= n)) { aW1[e] = 0.f; aKr[e] = 0.f; } }
        }
        f32x16 aW2 = ld_nat(R7, qm, qn, lane);
        __syncthreads();
        st_sc(R0, aN, qm, qn, lane);
        st_nat(R2, aN, qm, qn, lane);
        st_sc(R3, aKa, qm, qn, lane);
        st_nat(R8, aW1, qm, qn, lane);
        __syncthreads();
        for (int it = 0; it < 6; ++it) {
            aW1 = mmq(R0, R8, qm, qn, aW1, lane);
            aW2 = mmq(R0, R7, qm, qn, aW2, lane);
            if (it < 5) aN = mmq(R0, R2, qm, qn, z16, lane);
            __syncthreads();
            st_nat(R8, aW1, qm, qn, lane); st_nat(R7, aW2, qm, qn, lane);
            if (it < 5) { st_sc(R0, aN, qm, qn, lane); st_nat(R2, aN, qm, qn, lane); }
            __syncthreads();
        }
        {
            f32x16 aG = mmq(R4, R7, qm, qn, z16, lane);
            { const int n = 32 * qn + r; const float gn = gam[n];
#pragma unroll
                for (int e = 0; e < 16; ++e) { const int m = 32 * qm + (e & 3) + 8 * (e >> 2) + 4 * h5; if (m == n) aG[e] += gn; } }
            st_nat_gp((u16*)(p.ws + W_GT) + (size_t)u * 4096, aG, qm, qn, lane);
            f32x16 aQ = ld_nat(R1, qm, qn, lane);
            aQ = mmq(R4, R8, qm, qn, aQ, lane);
            st_nat_gp((u16*)(p.ws + W_QT) + (size_t)u * 4096, aQ, qm, qn, lane);
            f32x16 aP1 = ld_nat(R6, qm, qn, lane);
            aP1 = mmq(R3, R7, qm, qn, aP1, lane);
            aKr = mmq(R3, R8, qm, qn, aKr, lane);
            st_nat(R0, aP1, qm, qn, lane);
            st_nat(R2, aKr, qm, qn, lane);
        }
        __syncthreads();
        {
            f32x16 aH = mmq(R0, R5, qm, qn, z16, lane);
            st_nat_gp((u16*)(p.ws + W_HH) + (size_t)u * 4096, aH, qm, qn, lane);
            f32x16 aY = mmq(R5, R2, qm, qn, z16, lane);
            const int n = 32 * qn + r;

#pragma unroll
            for (int g = 0; g < 4; g += 2) {
                unsigned ax = pack2(aY[4 * g], aY[4 * g + 1]), ay = pack2(aY[4 * g + 2], aY[4 * g + 3]), bx = pack2(aY[4 * g + 4], aY[4 * g + 5]), by = pack2(aY[4 * g + 6], aY[4 * g + 7]);
                { auto rr = __builtin_amdgcn_permlane32_swap(ax, bx, false, false); ax = rr[0]; bx = rr[1]; }
                { auto rr = __builtin_amdgcn_permlane32_swap(ay, by, false, false); ay = rr[0]; by = rr[1]; }
                if (n < ntok) *(uint4*)((u16*)(p.ws + W_XB) + (size_t)(row0 + n) * DM + 512 + h * 64 + 32 * qm + 8 * g + 8 * h5) = (uint4){ax, ay, bx, by};
            }
        }
        __syncthreads();
    }
}

struct ScanSlot { uint4 ga[4][2]; uint4 gh[2]; };
DI void scan_load(ScanSlot& s, const u16* GT, const u16* HH, int u, int irow, int i16, int g) {
    const u16* gt = GT + (size_t)u * 4096; const u16* hh = HH + (size_t)u * 4096 + irow * 64;
#pragma unroll
    for (int mt = 0; mt < 4; ++mt) {
#pragma unroll
        for (int ks = 0; ks < 2; ++ks) s.ga[mt][ks] = *(const uint4*)(gt + (16 * mt + i16) * 64 + 32 * ks + 8 * g);
    }
#pragma unroll
    for (int ks = 0; ks < 2; ++ks) s.gh[ks] = *(const uint4*)(hh + 32 * ks + 8 * g);
}
DI void scan_step(const ScanSlot& s, f32x4 (&acc)[4], u16* sst, int irow, int g) {
    unsigned pk[4][2];
#pragma unroll
    for (int mt = 0; mt < 4; ++mt) { pk[mt][0] = pack2(acc[mt][0], acc[mt][1]); pk[mt][1] = pack2(acc[mt][2], acc[mt][3]); }
    bf16x8 bfr[2];
#pragma unroll
    for (int ks = 0; ks < 2; ++ks) { uint4 w = {pk[2 * ks][0], pk[2 * ks][1], pk[2 * ks + 1][0], pk[2 * ks + 1][1]}; bfr[ks] = __builtin_bit_cast(bf16x8, w);
        *(uint4*)(sst + irow * 64 + 32 * ks + 8 * g) = w; }
#pragma unroll
    for (int mt = 0; mt < 4; ++mt) {
        const unsigned hx = (mt & 1) ? s.gh[mt >> 1].z : s.gh[mt >> 1].x, hy = (mt & 1) ? s.gh[mt >> 1].w : s.gh[mt >> 1].y;
        f32x4 c = {bflo(hx), bfhi(hx), bflo(hy), bfhi(hy)};
#pragma unroll
        for (int ks = 0; ks < 2; ++ks) c = __builtin_amdgcn_mfma_f32_16x16x32_bf16(__builtin_bit_cast(bf16x8, s.ga[mt][ks]), bfr[ks], c, 0, 0, 0);
        acc[mt] = c;
    }
}
DI void scan_item(const Params& p, int item, int lane) {
    const int i16 = lane & 15, g = lane >> 4;
    const u16* GT = (const u16*)(p.ws + W_GT); const u16* HH = (const u16*)(p.ws + W_HH); u16* SST = (u16*)(p.ws + W_SST);
    f32x4 acc[4];
    if (item < 64) {
        const int bh = item >> 2, iq = item & 3, u0 = bh * 128, irow = 16 * iq + i16;
#pragma unroll
        for (int mt = 0; mt < 4; ++mt) acc[mt] = (f32x4){0.f, 0.f, 0.f, 0.f};
        ScanSlot s0, s1, s2, s3, s4;
        scan_load(s0, GT, HH, u0, irow, i16, g); scan_load(s1, GT, HH, u0 + 1, irow, i16, g); scan_load(s2, GT, HH, u0 + 2, irow, i16, g); scan_load(s3, GT, HH, u0 + 3, irow, i16, g);
        scan_load(s4, GT, HH, u0 + 4, irow, i16, g);
        const int ul = u0 + 127;
#define PINM do { asm volatile("" ::: "memory"); __builtin_amdgcn_sched_barrier(0); } while (0)
        for (int st = 0; st < 125; st += 5) {
            const int u = u0 + st;
            scan_step(s0, acc, SST + (size_t)u * 4096, irow, g);       PINM; scan_load(s0, GT, HH, min(u + 5, ul), irow, i16, g); PINM;
            scan_step(s1, acc, SST + (size_t)(u + 1) * 4096, irow, g); PINM; scan_load(s1, GT, HH, min(u + 6, ul), irow, i16, g); PINM;
            scan_step(s2, acc, SST + (size_t)(u + 2) * 4096, irow, g); PINM; scan_load(s2, GT, HH, min(u + 7, ul), irow, i16, g); PINM;
            scan_step(s3, acc, SST + (size_t)(u + 3) * 4096, irow, g); PINM; scan_load(s3, GT, HH, min(u + 8, ul), irow, i16, g); PINM;
            scan_step(s4, acc, SST + (size_t)(u + 4) * 4096, irow, g); PINM; scan_load(s4, GT, HH, min(u + 9, ul), irow, i16, g); PINM;
        }
        scan_step(s0, acc, SST + (size_t)(u0 + 125) * 4096, irow, g); PINM;
        scan_step(s1, acc, SST + (size_t)(u0 + 126) * 4096, irow, g); PINM;
        scan_step(s2, acc, SST + (size_t)(u0 + 127) * 4096, irow, g);
#undef PINM
        float* fout = p.out + O_SP + (size_t)bh * 4096;
#pragma unroll
        for (int mt = 0; mt < 4; ++mt) *(f32x4*)(fout + irow * 64 + 16 * mt + 4 * g) = acc[mt];
    } else {
        const int s = (item - 64) >> 2, iq = item & 3, u = 2048 + s, irow = 16 * iq + i16;
        const float* st0 = p.st_wkv + (size_t)s * 4096 + irow * 64;
#pragma unroll
        for (int mt = 0; mt < 4; ++mt) acc[mt] = *(const f32x4*)(st0 + 16 * mt + 4 * g);
        ScanSlot s0; scan_load(s0, GT, HH, u, irow, i16, g);
        scan_step(s0, acc, SST + (size_t)u * 4096, irow, g);
        float* fout = p.out + O_SS + (size_t)s * 4096;
#pragma unroll
        for (int mt = 0; mt < 4; ++mt) *(f32x4*)(fout + irow * 64 + 16 * mt + 4 * g) = acc[mt];
    }
}

DI s16x4 tr16(const char* p) { return __builtin_bit_cast(s16x4, __builtin_amdgcn_ds_read_tr16_b64_v4i16((__attribute__((address_space(3))) s16x4*)p)); }

DI void attn_tile(const char* sk, const char* sv, const float* tab, const bf16x8& qf0, const bf16x8& qf1, float& m, float& l, f32x4 (&o)[4], int qpos, int dlt, int nvalid, int lane) {
    const int q = lane & 15, g = lane >> 4;
    const float C2 = 0.125f * LOG2E;
    f32x4 sc[4];
#pragma unroll
    for (int kt = 0; kt < 4; ++kt) {
        const bf16x8 a0 = *(const bf16x8*)(sk + swz(16 * kt + q, g)); const bf16x8 a1 = *(const bf16x8*)(sk + swz(16 * kt + q, 4 + g));
        f32x4 s = {0.f, 0.f, 0.f, 0.f};
        s = __builtin_amdgcn_mfma_f32_16x16x32_bf16(a0, qf0, s, 0, 0, 0); s = __builtin_amdgcn_mfma_f32_16x16x32_bf16(a1, qf1, s, 0, 0, 0);
        sc[kt] = s;
    }
    float mx = -INFINITY;
    if (dlt >= 3) {
        const float bc = tab[256];
#pragma unroll
        for (int kt = 0; kt < 4; ++kt)
#pragma unroll
            for (int e = 0; e < 4; ++e) { const float s = sc[kt][e] * C2 + bc; sc[kt][e] = s; mx = fmaxf(mx, s); }
    } else {
#pragma unroll
        for (int kt = 0; kt < 4; ++kt)
#pragma unroll
            for (int e = 0; e < 4; ++e) { const int key = 16 * kt + 4 * g + e; int rel = qpos - key + dlt * 64; rel = rel < -128 ? -128 : (rel > 128 ? 128 : rel);
                float s = sc[kt][e] * C2 + tab[rel + 128]; if (key >= nvalid) s = -INFINITY; sc[kt][e] = s; mx = fmaxf(mx, s); }
    }
    mx = xmax16(mx); mx = xmax32(mx);
    const float mn = fmaxf(m, mx); const float alpha = __builtin_amdgcn_exp2f(m - mn); m = mn;
    float ps = 0.f;
#pragma unroll
    for (int kt = 0; kt < 4; ++kt)
#pragma unroll
        for (int e = 0; e < 4; ++e) { const float pe = __builtin_amdgcn_exp2f(sc[kt][e] - mn); sc[kt][e] = pe; ps += pe; }
    l = l * alpha + ps;
#pragma unroll
    for (int dt = 0; dt < 4; ++dt) o[dt] *= alpha;
    bf16x8 pf[2];
#pragma unroll
    for (int ks = 0; ks < 2; ++ks) { uint4 w = {pack2(sc[2 * ks][0], sc[2 * ks][1]), pack2(sc[2 * ks][2], sc[2 * ks][3]), pack2(sc[2 * ks + 1][0], sc[2 * ks + 1][1]), pack2(sc[2 * ks + 1][2], sc[2 * ks + 1][3])};
        pf[ks] = __builtin_bit_cast(bf16x8, w); }
#pragma unroll
    for (int dt = 0; dt < 4; ++dt)
#pragma unroll
        for (int ks = 0; ks < 2; ++ks) {
            const int vr = 32 * ks + 4 * g + (q >> 2); const int col = 16 * dt + 4 * (q & 3);
            const s16x4 lo = tr16(sv + swz(vr, col >> 3) + (col & 7) * 2); const s16x4 hi = tr16(sv + swz(vr + 16, col >> 3) + (col & 7) * 2);
            const bf16x8 vf = {lo[0], lo[1], lo[2], lo[3], hi[0], hi[1], hi[2], hi[3]};
            o[dt] = __builtin_amdgcn_mfma_f32_16x16x32_bf16(vf, pf[ks], o[dt], 0, 0, 0);
        }
}
DI void attn_finish(const Params& p, float l, const f32x4 (&o)[4], int qrow, int h, int lane) {
    const int g = lane >> 4; const u16* proj = (const u16*)(p.ws + W_PROJ);
    l = xadd16(l); l = xadd32(l);
    const float inv = rcpf_(l);
    u16* z = (u16*)(p.ws + W_XB) + (size_t)qrow * DM + h * 64; const u16* ga = proj + (size_t)qrow * NC + C_GA + h * 64;
    uint2 w[4];
#pragma unroll
    for (int dt = 0; dt < 4; ++dt) { const int d = 16 * dt + 4 * g; const uint2 gg = *(const uint2*)(ga + d);
        w[dt].x = pack2(o[dt][0] * inv * silu(bflo(gg.x)), o[dt][1] * inv * silu(bfhi(gg.x))); w[dt].y = pack2(o[dt][2] * inv * silu(bflo(gg.y)), o[dt][3] * inv * silu(bfhi(gg.y))); }
#pragma unroll
    for (int dt = 0; dt < 4; dt += 2) *(uint4*)(z + 16 * (dt + (g & 1)) + 8 * (g >> 1)) = widen16(w[dt], w[dt + 1]);
}
DI void attn_block(const Params& p, int u, char* lds) {
    int tid = threadIdx.x; asm volatile("" : "+v"(tid));
    const int lane = tid & 63, wave = __builtin_amdgcn_readfirstlane(tid >> 6);
    const u16* proj = (const u16*)(p.ws + W_PROJ);
    const int b = u >> 10, h = (u >> 7) & 7, c = u & 127; const int qrow = b * 8192 + c * 64 + wave * 16 + (lane & 15); const int ndl = c < 8 ? c : 8;
    float* tab = (float*)(lds + 49152);
    __syncthreads();
    for (int i = tid; i < 257; i += 256) tab[i] = p.relb[h * 257 + i] * LOG2E;
    const u16* qp = proj + (size_t)qrow * NC + C_Q + h * 64 + 8 * (lane >> 4);
    const bf16x8 qf0 = *(const bf16x8*)qp, qf1 = *(const bf16x8*)(qp + 32);
    float m = -INFINITY, l = 0.f; f32x4 o[4];
#pragma unroll
    for (int dt = 0; dt < 4; ++dt) o[dt] = (f32x4){0.f, 0.f, 0.f, 0.f};
    unsigned soff[2];
#pragma unroll
    for (int i = 0; i < 2; ++i) { const int row = 8 * (i * 4 + wave) + (lane >> 3); const int ch = (lane & 7) ^ ((row >> 1) & 7); soff[i] = (unsigned)(row * NC + ch * 8); }
    const u16* kbase = proj + (size_t)(b * 8192) * NC + h * 64;
#define ASTAGE(buf, dl) do { const u16* kr = kbase + (size_t)((c - (dl)) * 64) * NC; _Pragma("unroll") for (int i = 0; i < 2; ++i) { \
        __builtin_amdgcn_global_load_lds((const unsigned*)(kr + soff[i] + C_K), (LAS unsigned*)(lds + (buf) * 8192 + (i * 4 + wave) * 1024), 16, 0, 0); \
        __builtin_amdgcn_global_load_lds((const unsigned*)(kr + soff[i] + C_V), (LAS unsigned*)(lds + 24576 + (buf) * 8192 + (i * 4 + wave) * 1024), 16, 0, 0); } } while (0)
    __syncthreads();
    ASTAGE(0, ndl); if (ndl >= 1) ASTAGE(1, ndl - 1);
    int buf = 0;
    for (int dlt = ndl; dlt >= 0; --dlt) {
        if (dlt >= 1) asm volatile("s_waitcnt vmcnt(4) lgkmcnt(0)" ::: "memory"); else asm volatile("s_waitcnt vmcnt(0) lgkmcnt(0)" ::: "memory");
        __builtin_amdgcn_s_barrier();
        asm volatile("" ::: "memory");
        const int nb2 = buf >= 1 ? buf - 1 : 2;
        if (dlt >= 2) ASTAGE(nb2, dlt - 2);
        attn_tile(lds + buf * 8192, lds + 24576 + buf * 8192, tab, qf0, qf1, m, l, o, wave * 16 + (lane & 15), dlt, 64, lane);
        buf = buf == 2 ? 0 : buf + 1;
    }
#undef ASTAGE
    attn_finish(p, l, o, qrow, h, lane);
}
struct QG { bf16x8 q0, q1; float m, l; f32x4 o[4]; };
DI void attn_softmax(f32x4 (&sc)[4], const float* tab, QG& G, int qpos, int dlt, int g, bf16x8 (&pf)[2]) {
    const float C2 = 0.125f * LOG2E;
    float mx = -INFINITY;
    if (dlt >= 3) {
        const float bc = tab[256];
#pragma unroll
        for (int kt = 0; kt < 4; ++kt)
#pragma unroll
            for (int e = 0; e < 4; ++e) { const float s = sc[kt][e] * C2 + bc; sc[kt][e] = s; mx = fmaxf(mx, s); }
    } else {
#pragma unroll
        for (int kt = 0; kt < 4; ++kt)
#pragma unroll
            for (int e = 0; e < 4; ++e) { const int key = 16 * kt + 4 * g + e; int rel = qpos - key + dlt * 64; rel = rel < -128 ? -128 : (rel > 128 ? 128 : rel);
                const float s = sc[kt][e] * C2 + tab[rel + 128]; sc[kt][e] = s; mx = fmaxf(mx, s); }
    }
    mx = xmax16(mx); mx = xmax32(mx);
    const float mn = fmaxf(G.m, mx); const float alpha = __builtin_amdgcn_exp2f(G.m - mn); G.m = mn;
    float ps = 0.f;
#pragma unroll
    for (int kt = 0; kt < 4; ++kt)
#pragma unroll
        for (int e = 0; e < 4; ++e) { const float pe = __builtin_amdgcn_exp2f(sc[kt][e] - mn); sc[kt][e] = pe; ps += pe; }
    G.l = G.l * alpha + ps;
#pragma unroll
    for (int dt = 0; dt < 4; ++dt) G.o[dt] *= alpha;
#pragma unroll
    for (int ks = 0; ks < 2; ++ks) { uint4 w = {pack2(sc[2 * ks][0], sc[2 * ks][1]), pack2(sc[2 * ks][2], sc[2 * ks][3]), pack2(sc[2 * ks + 1][0], sc[2 * ks + 1][1]), pack2(sc[2 * ks + 1][2], sc[2 * ks + 1][3])};
        pf[ks] = __builtin_bit_cast(bf16x8, w); }
}
DI void attn_tile2(const char* sk, const char* sv, const float* tab, QG& A, QG& B, int qposA, int dlt, int lane) {
    const int q = lane & 15, g = lane >> 4;
    f32x4 sa[4], sb[4];
#pragma unroll
    for (int kt = 0; kt < 4; ++kt) {
        const bf16x8 a0 = *(const bf16x8*)(sk + swz(16 * kt + q, g)); const bf16x8 a1 = *(const bf16x8*)(sk + swz(16 * kt + q, 4 + g));
        f32x4 x = {0.f, 0.f, 0.f, 0.f}, y = {0.f, 0.f, 0.f, 0.f};
        x = __builtin_amdgcn_mfma_f32_16x16x32_bf16(a0, A.q0, x, 0, 0, 0); y = __builtin_amdgcn_mfma_f32_16x16x32_bf16(a0, B.q0, y, 0, 0, 0);
        x = __builtin_amdgcn_mfma_f32_16x16x32_bf16(a1, A.q1, x, 0, 0, 0); y = __builtin_amdgcn_mfma_f32_16x16x32_bf16(a1, B.q1, y, 0, 0, 0);
        sa[kt] = x; sb[kt] = y;
    }
    bf16x8 pa[2], pb[2];
    attn_softmax(sa, tab, A, qposA, dlt, g, pa);
    attn_softmax(sb, tab, B, qposA + 16, dlt, g, pb);
#pragma unroll
    for (int dt = 0; dt < 4; ++dt)
#pragma unroll
        for (int ks = 0; ks < 2; ++ks) {
            const int vr = 32 * ks + 4 * g + (q >> 2); const int col = 16 * dt + 4 * (q & 3);
            const s16x4 lo = tr16(sv + swz(vr, col >> 3) + (col & 7) * 2); const s16x4 hi = tr16(sv + swz(vr + 16, col >> 3) + (col & 7) * 2);
            const bf16x8 vf = {lo[0], lo[1], lo[2], lo[3], hi[0], hi[1], hi[2], hi[3]};
            A.o[dt] = __builtin_amdgcn_mfma_f32_16x16x32_bf16(vf, pa[ks], A.o[dt], 0, 0, 0);
            B.o[dt] = __builtin_amdgcn_mfma_f32_16x16x32_bf16(vf, pb[ks], B.o[dt], 0, 0, 0);
        }
}
DI void attn_block2(const Params& p, int bh, int cp, char* lds) {
    int tid = threadIdx.x; asm volatile("" : "+v"(tid));
    const int lane = tid & 63, wave = __builtin_amdgcn_readfirstlane(tid >> 6);
    const u16* proj = (const u16*)(p.ws + W_PROJ);
    const int b = bh >> 3, h = bh & 7, c0 = 2 * cp, cq = c0 + (wave >> 1);
    const int qposA = (wave & 1) * 32 + (lane & 15); const int qrowA = b * 8192 + cq * 64 + qposA;
    float* tab = (float*)(lds + 49152);
    __syncthreads();
    for (int i = tid; i < 257; i += 256) tab[i] = p.relb[h * 257 + i] * LOG2E;
    QG A, B;
    { const u16* qp = proj + (size_t)qrowA * NC + C_Q + h * 64 + 8 * (lane >> 4); A.q0 = *(const bf16x8*)qp; A.q1 = *(const bf16x8*)(qp + 32);
      const u16* qb = qp + (size_t)16 * NC; B.q0 = *(const bf16x8*)qb; B.q1 = *(const bf16x8*)(qb + 32); }
    A.m = -INFINITY; A.l = 0.f; B.m = -INFINITY; B.l = 0.f;
#pragma unroll
    for (int dt = 0; dt < 4; ++dt) { A.o[dt] = (f32x4){0.f, 0.f, 0.f, 0.f}; B.o[dt] = (f32x4){0.f, 0.f, 0.f, 0.f}; }
    unsigned soff[2];
#pragma unroll
    for (int i = 0; i < 2; ++i) { const int row = 8 * (i * 4 + wave) + (lane >> 3); const int ch = (lane & 7) ^ ((row >> 1) & 7); soff[i] = (unsigned)(row * NC + ch * 8); }
    const u16* kbase = proj + (size_t)(b * 8192) * NC + h * 64;
#define ASTAGE2(buf, kc) do { const u16* kr = kbase + (size_t)((kc) * 64) * NC; _Pragma("unroll") for (int i = 0; i < 2; ++i) { \
        __builtin_amdgcn_global_load_lds((const unsigned*)(kr + soff[i] + C_K), (LAS unsigned*)(lds + (buf) * 8192 + (i * 4 + wave) * 1024), 16, 0, 0); \
        __builtin_amdgcn_global_load_lds((const unsigned*)(kr + soff[i] + C_V), (LAS unsigned*)(lds + 24576 + (buf) * 8192 + (i * 4 + wave) * 1024), 16, 0, 0); } } while (0)
    const int lo = c0 >= 8 ? c0 - 8 : 0, hi = c0 + 1;
    __syncthreads();
    ASTAGE2(0, lo); ASTAGE2(1, lo + 1);
    int buf = 0;
    for (int kc = lo; kc <= hi; ++kc) {
        if (kc < hi) asm volatile("s_waitcnt vmcnt(4) lgkmcnt(0)" ::: "memory"); else asm volatile("s_waitcnt vmcnt(0) lgkmcnt(0)" ::: "memory");
        __builtin_amdgcn_s_barrier();
        asm volatile("" ::: "memory");
        const int nb2 = buf >= 1 ? buf - 1 : 2;
        if (kc + 2 <= hi) ASTAGE2(nb2, kc + 2);
        const int dlt = cq - kc;
        if (dlt >= 0 && dlt <= 8) attn_tile2(lds + buf * 8192, lds + 24576 + buf * 8192, tab, A, B, qposA, dlt, lane);
        buf = buf == 2 ? 0 : buf + 1;
    }
#undef ASTAGE2
    attn_finish(p, A.l, A.o, qrowA, h, lane);
    attn_finish(p, B.l, B.o, qrowA + 16, h, lane);
}

DI void attn_block_sample(const Params& p, int s, char* lds) {
    int tid = threadIdx.x; asm volatile("" : "+v"(tid));
    const int lane = tid & 63, wave = __builtin_amdgcn_readfirstlane(tid >> 6);
    char* wl = lds + wave * 18432;
    char* sk = wl; char* sv = wl + 8192; float* tab = (float*)(wl + 16384);
    const u16* proj = (const u16*)(p.ws + W_PROJ);
    const int b = s >> 3, h = s & 7; const int qrow0 = NTP + b * 16;
    for (int i = lane; i < 257; i += 64) tab[i] = p.relb[h * 257 + i] * LOG2E;
    const int q = lane & 15, g = lane >> 4;
    const u16* qp = proj + (size_t)(qrow0 + q) * NC + C_Q + h * 64 + 8 * g;
    const bf16x8 qf0 = *(const bf16x8*)qp, qf1 = *(const bf16x8*)(qp + 32);
    float m = -INFINITY, l = 0.f; f32x4 o[4];
#pragma unroll
    for (int dt = 0; dt < 4; ++dt) o[dt] = (f32x4){0.f, 0.f, 0.f, 0.f};
    const int lrow = lane >> 3, lch = lane & 7;
    float4 rk[16], rv[16];
#define SLOAD(dl) do { const size_t off_ = ((size_t)(b * 8 + h) * 512 + (8 - (dl)) * 64) * 64 + lrow * 64 + lch * 8; \
        _Pragma("unroll") for (int i = 0; i < 8; ++i) { const float* a_ = p.cache_k + off_ + i * 512; const float* c_ = p.cache_v + off_ + i * 512; \
            rk[2 * i] = ntld4(a_); rk[2 * i + 1] = ntld4(a_ + 4); rv[2 * i] = ntld4(c_); rv[2 * i + 1] = ntld4(c_ + 4); } } while (0)
#define SWRITE() do { _Pragma("unroll") for (int i = 0; i < 8; ++i) { const int row = i * 8 + lrow; \
            uint4 kv = {pack2(rk[2 * i].x, rk[2 * i].y), pack2(rk[2 * i].z, rk[2 * i].w), pack2(rk[2 * i + 1].x, rk[2 * i + 1].y), pack2(rk[2 * i + 1].z, rk[2 * i + 1].w)}; \
            uint4 vv = {pack2(rv[2 * i].x, rv[2 * i].y), pack2(rv[2 * i].z, rv[2 * i].w), pack2(rv[2 * i + 1].x, rv[2 * i + 1].y), pack2(rv[2 * i + 1].z, rv[2 * i + 1].w)}; \
            *(uint4*)(sk + swz(row, lch)) = kv; *(uint4*)(sv + swz(row, lch)) = vv; } } while (0)
    const int d0 = 8 - 2 * wave;
    SLOAD(d0);
    asm volatile("s_waitcnt lgkmcnt(0)" ::: "memory");
    SWRITE();
    SLOAD(d0 - 1);
    asm volatile("s_waitcnt lgkmcnt(0)" ::: "memory");
    attn_tile(sk, sv, tab, qf0, qf1, m, l, o, q, d0, 64, lane);
    asm volatile("s_waitcnt lgkmcnt(0)" ::: "memory");
    SWRITE();
    asm volatile("s_waitcnt lgkmcnt(0)" ::: "memory");
    attn_tile(sk, sv, tab, qf0, qf1, m, l, o, q, d0 - 1, 64, lane);
#undef SLOAD
#undef SWRITE
    if (wave == 3) {
        asm volatile("s_waitcnt lgkmcnt(0)" ::: "memory");
#pragma unroll
        for (int i = 0; i < 8; ++i) { const int row = i * 8 + lrow; uint4 kv = {0, 0, 0, 0}, vv = {0, 0, 0, 0};
            if (row < 16) { const u16* sp = proj + (size_t)(qrow0 + row) * NC + h * 64 + lch * 8; kv = *(const uint4*)(sp + C_K); vv = *(const uint4*)(sp + C_V); }
            *(uint4*)(sk + swz(row, lch)) = kv; *(uint4*)(sv + swz(row, lch)) = vv; }
        asm volatile("s_waitcnt lgkmcnt(0)" ::: "memory");
        attn_tile(sk, sv, tab, qf0, qf1, m, l, o, q, 0, 16, lane);
    }
    l = xadd16(l); l = xadd32(l);
    asm volatile("s_waitcnt lgkmcnt(0)" ::: "memory");
    float* cm = (float*)wl; float* cl = cm + 16; float* co = cm + 32;
    if (g == 0) { cm[q] = m; cl[q] = l; }
#pragma unroll
    for (int dt = 0; dt < 4; ++dt) *(f32x4*)(co + q * 64 + 16 * dt + 4 * g) = o[dt];
    __syncthreads();
    {
        float mw[4], M = -INFINITY;
#pragma unroll
        for (int w = 0; w < 4; ++w) { mw[w] = ((const float*)(lds + w * 18432))[q]; M = fmaxf(M, mw[w]); }
        float L = 0.f; f32x4 O = {0.f, 0.f, 0.f, 0.f};
#pragma unroll
        for (int w = 0; w < 4; ++w) { const float* base = (const float*)(lds + w * 18432); const float f = __builtin_amdgcn_exp2f(mw[w] - M);
            L += base[16 + q] * f; const f32x4 ov = *(const f32x4*)(base + 32 + q * 64 + 16 * wave + 4 * g); O += ov * f; }
        const float inv = rcpf_(L); const int qrow = qrow0 + q; const int d = 16 * wave + 4 * g;
        const uint2 gg = *(const uint2*)(proj + (size_t)qrow * NC + C_GA + h * 64 + d);
        uint2 w2; w2.x = pack2(O[0] * inv * silu(bflo(gg.x)), O[1] * inv * silu(bfhi(gg.x))); w2.y = pack2(O[2] * inv * silu(bflo(gg.y)), O[3] * inv * silu(bfhi(gg.y)));
        *(uint2*)((u16*)(p.ws + W_XB) + (size_t)qrow * DM + h * 64 + d) = w2;
    }
    __syncthreads();
}

DI void phase_scan_attn(const Params& p, char* lds) {
    const int tid = threadIdx.x, lane = tid & 63, wave = __builtin_amdgcn_readfirstlane(tid >> 6);
    if (blockIdx.x < 64) {
        if (wave == 0) { const int x_ = blockIdx.x & 7, k_ = blockIdx.x >> 3;
            scan_item(p, (x_ + 8 * (k_ >> 2)) * 4 + (k_ & 3), lane); }
        return;
    }
    unsigned* ctr = (unsigned*)(p.ws + W_BAR) + 3456;
    volatile LAS int* slot = (volatile LAS int*)(lds + 75264);
    const int q0 = (int)((unsigned)__builtin_amdgcn_s_getreg((3 << 11) | 20) & 7u);
    for (int v = 0; v < 8; ++v) {
        const int q = (q0 + v) & 7;
        for (;;) {
            __syncthreads();
            if (tid == 0) *slot = (int)__hip_atomic_fetch_add(ctr + 16 * q, 1u, __ATOMIC_RELAXED, __HIP_MEMORY_SCOPE_AGENT);
            __syncthreads();
            const int item = *slot;
            if (item >= 32 + 128 + 32) break;
            if (item < 32) attn_block_sample(p, 32 * q + item, lds);
            else if (item < 160) { const int j = item - 32; attn_block2(p, 2 * q + (j & 1), 63 - (j >> 1), lds); }
            else scan_item(p, 64 + (32 * q + item - 160) * 4 + wave, lane);
        }
    }
}

DI void phase_rwkv_out(const Params& p, char* lds) {
    const int tid = threadIdx.x, lane = tid & 63, wave = tid >> 6;
    float* pw = (float*)(lds + wave * 1024);
    const int gw = blockIdx.x * 4 + wave, nw = gridDim.x * 4;
    const int i16 = lane & 15, g = lane >> 4;
    const u16* proj = (const u16*)(p.ws + W_PROJ); const u16* QT = (const u16*)(p.ws + W_QT); const u16* SST = (const u16*)(p.ws + W_SST);
    const float* bonus = (const float*)(p.ws + W_BONUS);
    for (int wu = gw; wu < 8192 + 256; wu += nw) {
        int u, tg, b, h, c = 0, row0; bool prm = wu < 8192;
        if (prm) { u = wu >> 2; tg = wu & 3; b = u >> 10; h = (u >> 7) & 7; c = u & 127; row0 = b * 8192 + c * 64; }
        else { const int s = wu - 8192; u = 2048 + s; tg = 0; b = s >> 3; h = s & 7; row0 = NTP + b * 16; }
        const int t = 16 * tg + i16; const int row = row0 + t;
        u16* z = (u16*)(p.ws + W_XB) + (size_t)row * DM + 512 + h * 64;
        const u16* qt = QT + (size_t)u * 4096 + t * 64 + 8 * g; const bf16x8 bq0 = *(const bf16x8*)qt, bq1 = *(const bf16x8*)(qt + 32);
        { const float a_ = p.mix[1024 + h * 64 + lane], b_ = p.gn_g[h * 64 + lane], c_ = p.gn_b[h * 64 + lane];
            asm volatile("s_waitcnt lgkmcnt(0)" ::: "memory"); pw[lane] = a_; pw[64 + lane] = b_; pw[128 + lane] = c_; asm volatile("s_waitcnt lgkmcnt(0)" ::: "memory"); }
        const int wofs = 16 * (g & 1) + 8 * (g >> 1);
        const int mode = t > 0 ? 0 : (prm ? (c > 0 ? 0 : 1) : 2);
        uint2 ylw[4], cvw[4], grw[4], pvw[4];
        { const u16* pr_ = proj + (size_t)row * NC + h * 64 + wofs; const u16* pp_ = proj + (size_t)(mode == 0 ? row - 1 : row) * NC + C_RV + h * 64 + wofs;
#pragma unroll
            for (int mp = 0; mp < 2; ++mp) {
                unwiden16(*(const uint4*)(z + 32 * mp + wofs), ylw[2 * mp], ylw[2 * mp + 1]);
                unwiden16(*(const uint4*)(pr_ + C_RV + 32 * mp), cvw[2 * mp], cvw[2 * mp + 1]);
                unwiden16(*(const uint4*)(pr_ + C_GR + 32 * mp), grw[2 * mp], grw[2 * mp + 1]);
                unwiden16(*(const uint4*)(pp_ + 32 * mp), pvw[2 * mp], pvw[2 * mp + 1]); } }
        f32x4 y[4];
#pragma unroll
        for (int mt = 0; mt < 4; ++mt) {
            const uint2 yl = ylw[mt]; f32x4 a = {bflo(yl.x), bfhi(yl.x), bflo(yl.y), bfhi(yl.y)};
            const u16* sp = SST + (size_t)u * 4096 + (16 * mt + i16) * 64 + 8 * g;
            a = __builtin_amdgcn_mfma_f32_16x16x32_bf16(*(const bf16x8*)sp, bq0, a, 0, 0, 0); a = __builtin_amdgcn_mfma_f32_16x16x32_bf16(*(const bf16x8*)(sp + 32), bq1, a, 0, 0, 0);
            y[mt] = a;
        }
        float s1 = 0.f;
#pragma unroll
        for (int mt = 0; mt < 4; ++mt) s1 += (y[mt][0] + y[mt][1]) + (y[mt][2] + y[mt][3]);
        s1 = xadd16(s1); s1 = xadd32(s1);
        const float mu = s1 * (1.f / 64.f); float s2 = 0.f;
#pragma unroll
        for (int mt = 0; mt < 4; ++mt)
#pragma unroll
            for (int e = 0; e < 4; ++e) { const float d = y[mt][e] - mu; s2 += d * d; }
        s2 = xadd16(s2); s2 = xadd32(s2);
        const float rs = __builtin_amdgcn_rsqf(s2 * (1.f / 64.f) + 64e-5f);
        const float bon = bonus[(size_t)u * 64 + t];
        uint2 wz[4];
#pragma unroll
        for (int mt = 0; mt < 4; ++mt) {
            const int i0 = 16 * mt + 4 * g; const int hj = h * 64 + i0;
            const uint2 cvp = cvw[mt]; const float cv[4] = {bflo(cvp.x), bfhi(cvp.x), bflo(cvp.y), bfhi(cvp.y)};
            float pv[4];
            if (mode == 0) { const uint2 w = pvw[mt]; pv[0] = bflo(w.x); pv[1] = bfhi(w.x); pv[2] = bflo(w.y); pv[3] = bfhi(w.y); }
            else if (mode == 1) { pv[0] = pv[1] = pv[2] = pv[3] = 0.f; }
            else { const float4 w = *(const float4*)(p.st_shift + (size_t)b * 1664 + 1024 + hj); pv[0] = w.x; pv[1] = w.y; pv[2] = w.z; pv[3] = w.w; }
            const float4 mv = *(const float4*)(pw + i0), gg = *(const float4*)(pw + 64 + i0), gb = *(const float4*)(pw + 128 + i0);
            const float mvv[4] = {mv.x, mv.y, mv.z, mv.w}, ggv[4] = {gg.x, gg.y, gg.z, gg.w}, gbv[4] = {gb.x, gb.y, gb.z, gb.w};
            const uint2 grp = grw[mt]; const float gr[4] = {bflo(grp.x), bfhi(grp.x), bflo(grp.y), bfhi(grp.y)};
            float ov[4];
#pragma unroll
            for (int e = 0; e < 4; ++e) { const float xv = cv[e] + (pv[e] - cv[e]) * mvv[e]; const float yn = (y[mt][e] - mu) * rs * ggv[e] + gbv[e] + bon * xv; ov[e] = yn * silu(gr[e]); }
            wz[mt].x = pack2(ov[0], ov[1]); wz[mt].y = pack2(ov[2], ov[3]);
        }
#pragma unroll
        for (int mt = 0; mt < 4; mt += 2) *(uint4*)(z + 16 * (mt + (g & 1)) + 8 * (g >> 1)) = widen16(wz[mt], wz[mt + 1]);
    }
}


#define XB_TMO      128
#define XB_XCNT(j)  (256  + 64 * (j))
#define XB_XSUB(j)  (1280 + 64 * (j))
#define XB_XGEN(j)  (2304 + 64 * (j))
#define XB_TOP      3328
#define XB_TOPGEN   3392
#define XCD_BAR_WORDS 3456
#define XB_SPIN_CAP (1u << 18)
DI unsigned xb_ld(unsigned* p) { return __hip_atomic_load(p, __ATOMIC_RELAXED, __HIP_MEMORY_SCOPE_AGENT); }
DI unsigned xb_add(unsigned* p, unsigned v) { return __hip_atomic_fetch_add(p, v, __ATOMIC_RELAXED, __HIP_MEMORY_SCOPE_AGENT); }
DI unsigned xb_xcc_id() { return (unsigned)__builtin_amdgcn_s_getreg((3 << 11) | 20) & 0xFu; }
#define XB_SPIN(cond, bar) do { unsigned _sp = 0; while (cond) { __builtin_amdgcn_s_sleep(2); \
    if ((++_sp & 255u) == 0u) { if (xb_ld(&(bar)[XB_TMO])) break; if (_sp > XB_SPIN_CAP) { atomicAdd(&(bar)[XB_TMO], 1u); break; } } } } while (0)
struct XcdBarrier { unsigned* bar; unsigned x; volatile LAS unsigned* st; };
DI XcdBarrier xcd_barrier_post(unsigned* bar, volatile LAS unsigned* st) {
    XcdBarrier b; b.bar = bar; b.x = xb_xcc_id(); b.st = st;
    if (threadIdx.x == 0) (void)xb_add(&bar[XB_XCNT(b.x)], 1u);
    return b;
}
DI void xcd_barrier_complete(unsigned* bar, unsigned x, unsigned& nloc, unsigned& nx) {
    const unsigned G = gridDim.x * gridDim.y * gridDim.z;
    unsigned sum, cnt, mine, sp = 0u;
    for (;;) {
        sum = 0u; cnt = 0u; mine = 0u;
#pragma unroll
        for (unsigned j = 0; j < 16; ++j) { const unsigned c = xb_ld(&bar[XB_XCNT(j)]); sum += c; cnt += (c > 0u) ? 1u : 0u; mine = (j == x) ? c : mine; }
        if (sum == G) break;
        __builtin_amdgcn_s_sleep(1);
        if ((++sp & 255u) == 0u) { if (xb_ld(&bar[XB_TMO])) break; if (sp > XB_SPIN_CAP) { atomicAdd(&bar[XB_TMO], 1u); break; } }
    }
    nloc = mine > 0u ? mine : 1u; nx = cnt > 0u ? cnt : 1u;
}
DI void xcd_barrier(const XcdBarrier& b) {
    asm volatile("s_waitcnt vmcnt(0)" ::: "memory");
    __syncthreads();
    if (threadIdx.x == 0) {
        unsigned* bar = b.bar;
        __builtin_amdgcn_s_waitcnt(0);
        unsigned nloc = b.st[0], nx = b.st[1];
        if (nloc == 0u) { xcd_barrier_complete(bar, b.x, nloc, nx); b.st[0] = nloc; b.st[1] = nx; }
        const unsigned old = xb_add(&bar[XB_XSUB(b.x)], 1u);
        const unsigned gen = old / nloc;
        if (old + 1u == (gen + 1u) * nloc) {
            __builtin_amdgcn_fence(__ATOMIC_RELEASE, "agent");
            asm volatile("s_waitcnt vmcnt(0)" ::: "memory");
            const unsigned og = xb_add(&bar[XB_TOP], 1u);
            const unsigned tg = og / nx;
            if (og + 1u == (tg + 1u) * nx) xb_add(&bar[XB_TOPGEN], 1u);
            else XB_SPIN(xb_ld(&bar[XB_TOPGEN]) == tg, bar);
            __builtin_amdgcn_fence(__ATOMIC_ACQUIRE, "agent");
            xb_add(&bar[XB_XGEN(b.x)], 1u);
            asm volatile("s_waitcnt vmcnt(0)" ::: "memory");
        } else {
            XB_SPIN(xb_ld(&bar[XB_XGEN(b.x)]) == gen, bar);
            __builtin_amdgcn_fence(__ATOMIC_ACQUIRE, "agent");
            asm volatile("s_waitcnt vmcnt(0)" ::: "memory");
        }
    }
    __syncthreads();
}

DI void run_phase(const Params& p, char* lds, int ph) {
    if (ph == 0) phase_prep(p, lds);
    else if (ph == 1) { Epi1 e{&p}; gemm_phase((const u16*)(p.ws + W_XB), (const u16*)(p.ws + W_WINT), 132, 33, lds, e); }
    else if (ph == 2) phase_rwkv_prep(p, lds);
    else if (ph == 3) phase_scan_attn(p, lds);
    else if (ph == 4) phase_rwkv_out(p, lds);
    else gemm_out(p, lds);
}

extern "C" __global__ void __launch_bounds__(256, 2) hymba_mega(Params p, int ph_lo, int ph_hi) {
    extern __shared__ __attribute__((aligned(16))) char lds[];
#if ONE_LAUNCH
    volatile LAS unsigned* st = (volatile LAS unsigned*)(lds + 75520);
    if (threadIdx.x == 0) { st[0] = 0u; st[1] = 0u; st[2] = 0u; st[3] = 0u; }
    __syncthreads();
    const XcdBarrier xb = xcd_barrier_post((unsigned*)(p.ws + W_BAR), st);
#ifndef PROBE_REP
#define PROBE_REP -1
#endif
#define RUNP(k) do { run_phase(p, lds, k); if (PROBE_REP == k) { xcd_barrier(xb); run_phase(p, lds, k); } } while (0)
    RUNP(0); xcd_barrier(xb);
    RUNP(1); xcd_barrier(xb);
    RUNP(2); xcd_barrier(xb);
    RUNP(3); xcd_barrier(xb);
    run_phase(p, lds, 4); xcd_barrier(xb);
    RUNP(5);
#else
    run_phase(p, lds, ph_lo);
#endif
}

extern "C" void kernel_launch(void* const* d_in, const int* in_sizes, int n_in, void* d_out, int out_size, void* d_ws, size_t ws_size, hipStream_t stream) {
    Params p{};
    const float** f = (const float**)&p;
    for (int i = 0; i < 22; ++i) f[i] = (const float*)d_in[i];
    p.out = (float*)d_out; p.ws = (char*)d_ws;
    static int grid_blocks = 0;
    if (!grid_blocks) {
        hipFuncSetAttribute((const void*)hymba_mega, hipFuncAttributeMaxDynamicSharedMemorySize, LDS_BYTES);
        int dev = 0, cus = 0, per_cu = 0;
        hipGetDevice(&dev);
        hipDeviceGetAttribute(&cus, hipDeviceAttributeMultiprocessorCount, dev);
        hipOccupancyMaxActiveBlocksPerMultiprocessor(&per_cu, hymba_mega, 256, LDS_BYTES);
        if (per_cu > 2) per_cu = 2;
        if (per_cu < 1) per_cu = 1;
        grid_blocks = cus * per_cu;
    }
#if ONE_LAUNCH
    int lo = 0, hi = 5;
    (void)hipMemsetAsync((char*)d_ws + W_BAR, 0, (XCD_BAR_WORDS + 128) * 4, stream);
    void* args[] = {&p, &lo, &hi};
    hipError_t e = hipLaunchCooperativeKernel((void*)hymba_mega, dim3(grid_blocks), dim3(256), args, LDS_BYTES, stream);
    if (e != hipSuccess) fprintf(stderr, "cooperative launch failed: %s (grid %d)\n", hipGetErrorString(e), grid_blocks);
#else
    for (int ph = 0; ph < 6; ++ph) hipLaunchKernelGGL(hymba_mega, dim3(grid_blocks), dim3(256), LDS_BYTES, stream, p, ph, ph);
#endif
}
```

```cpp
#include <hip/hip_runtime.h>
#include <hip/hip_cooperative_groups.h>
#include <cstdio>
#include <cstdint>
namespace cg = cooperative_groups;

#ifndef ONE_LAUNCH
#define ONE_LAUNCH 1
#endif

#define DI __device__ __forceinline__
#define LAS __attribute__((address_space(3)))
typedef unsigned short u16;
typedef short bf16x8 __attribute__((ext_vector_type(8)));
typedef short s16x4 __attribute__((ext_vector_type(4)));
typedef float f32x4 __attribute__((ext_vector_type(4)));
typedef float f32x16 __attribute__((ext_vector_type(16)));
typedef float f32x2_t __attribute__((ext_vector_type(2)));
typedef __bf16 bf16x2_t __attribute__((ext_vector_type(2)));
typedef __attribute__((address_space(3))) s16x4 lds_s16x4;

constexpr int DM = 1024, NC = 4224, NTP = 16384, NTS = 512, NTOK = 16896;
constexpr int C_Q = 0, C_K = 512, C_V = 1024, C_GA = 1536, C_R = 2048, C_RK = 2560, C_RV = 3072, C_WD = 3584, C_AD = 3648, C_GR = 3712;
constexpr int NUNIT = 2304;
constexpr size_t O_YP = 0, O_YS = 16777216, O_KP = 17301504, O_VP = 17825792, O_KS = 18350080, O_VS = 18612224,
                 O_SP = 18874368, O_SS = 18939904, O_SHP = 19988480, O_SHS = 19991808;
constexpr size_t W_XB = 0, W_WINT = 34603008, W_WOUTT = 43253760, W_WUPT = 45350912, W_AUPT = 45416448, W_RSTD = 45481984,
                 W_BONUS = 264339456  , W_PROJ = 46090240, W_GT = 188827648, W_HH = 207702016, W_QT = 226576384, W_SST = 245450752, W_BAR = 264325120;
constexpr int LDS_BYTES = 75776;
constexpr float LOG2E = 1.4426950408889634f;

struct Params {
    const float *x_p, *x_s, *cache_k, *cache_v, *st_wkv, *st_shift, *norm_g, *w_in, *q_g, *k_g, *relb, *mix, *w0, *w_up, *a0, *a_up,
        *k_k, *k_a, *r_k, *gn_g, *gn_b, *w_out;
    float* out;
    char* ws;
};

DI unsigned pack2(float lo, float hi) { f32x2_t v = {lo, hi}; bf16x2_t b = __builtin_convertvector(v, bf16x2_t); return __builtin_bit_cast(unsigned, b); }
DI u16 f2bf(float f) { return (u16)(pack2(f, 0.f) & 0xffffu); }
DI float bflo(unsigned u) { return __uint_as_float(u << 16); }
DI float bfhi(unsigned u) { return __uint_as_float(u & 0xffff0000u); }
DI float bf2f(u16 h) { return __uint_as_float((unsigned)h << 16); }
DI float4 ntld4(const float* p) { const f32x4 v = __builtin_nontemporal_load((const f32x4*)p); return (float4){v[0], v[1], v[2], v[3]}; }
DI int swz(int row, int ch) { return row * 128 + ((ch ^ ((row >> 1) & 7)) << 4); }
DI float dpp_add(float v, const int ctrl_sel) {
    int x = __float_as_int(v), y;
    if (ctrl_sel == 0) y = __builtin_amdgcn_update_dpp(0, x, 0xB1, 0xf, 0xf, true);
    else if (ctrl_sel == 1) y = __builtin_amdgcn_update_dpp(0, x, 0x4E, 0xf, 0xf, true);
    else if (ctrl_sel == 2) y = __builtin_amdgcn_update_dpp(0, x, 0x141, 0xf, 0xf, true);
    else y = __builtin_amdgcn_update_dpp(0, x, 0x140, 0xf, 0xf, true);
    return v + __int_as_float(y);
}
DI float wave_sum(float v) {
    v = dpp_add(v, 0); v = dpp_add(v, 1); v = dpp_add(v, 2); v = dpp_add(v, 3);
    const int x = __float_as_int(v);
    const float a = __int_as_float(__builtin_amdgcn_readlane(x, 0)), b = __int_as_float(__builtin_amdgcn_readlane(x, 16)),
                c = __int_as_float(__builtin_amdgcn_readlane(x, 32)), d = __int_as_float(__builtin_amdgcn_readlane(x, 48));
    return (a + b) + (c + d);
}
DI float rcpf_(float x) { return __builtin_amdgcn_rcpf(x); }
DI float silu(float x) { return x * rcpf_(1.f + __expf(-x)); }
DI float xadd16(float v) { const unsigned x = __float_as_uint(v); auto r = __builtin_amdgcn_permlane16_swap(x, x, false, false); return __uint_as_float(r[0]) + __uint_as_float(r[1]); }
DI float xadd32(float v) { const unsigned x = __float_as_uint(v); auto r = __builtin_amdgcn_permlane32_swap(x, x, false, false); return __uint_as_float(r[0]) + __uint_as_float(r[1]); }
DI float xmax16(float v) { const unsigned x = __float_as_uint(v); auto r = __builtin_amdgcn_permlane16_swap(x, x, false, false); return fmaxf(__uint_as_float(r[0]), __uint_as_float(r[1])); }
DI uint4 widen16(uint2 w0, uint2 w1) {
    auto rx = __builtin_amdgcn_permlane16_swap(w0.x, w1.x, false, false); auto ry = __builtin_amdgcn_permlane16_swap(w0.y, w1.y, false, false);
    return (uint4){rx[0], ry[0], rx[1], ry[1]};
}
DI void unwiden16(uint4 L, uint2& w0, uint2& w1) {
    auto rx = __builtin_amdgcn_permlane16_swap(L.x, L.z, false, false); auto ry = __builtin_amdgcn_permlane16_swap(L.y, L.w, false, false);
    w0 = (uint2){rx[0], ry[0]}; w1 = (uint2){rx[1], ry[1]};
}
DI float xmax32(float v) { const unsigned x = __float_as_uint(v); auto r = __builtin_amdgcn_permlane32_swap(x, x, false, false); return fmaxf(__uint_as_float(r[0]), __uint_as_float(r[1])); }
DI void unpack8(uint4 u, float* o) {
    o[0] = bflo(u.x); o[1] = bfhi(u.x); o[2] = bflo(u.y); o[3] = bfhi(u.y); o[4] = bflo(u.z); o[5] = bfhi(u.z); o[6] = bflo(u.w); o[7] = bfhi(u.w);
}

DI void transpose_tile(const float* W, int K, int N, const float* gain, u16* dst, float* tile, int t) {
    const int nkt = K / 64; const int kt = t % nkt, nt = t / nkt; const int k0 = kt * 64, n0 = nt * 64;
    const int tid = threadIdx.x, lane = tid & 63, wave = tid >> 6;
    float4 wv[4];
#pragma unroll
    for (int i = 0; i < 4; ++i) { const int idx = tid + 256 * i; wv[i] = ntld4(W + (size_t)(k0 + (idx >> 4)) * N + n0 + 4 * (idx & 15)); }
    const float gl = gain ? gain[k0 + lane] : 1.f;
#pragma unroll
    for (int i = 0; i < 4; ++i) { const int kr = 16 * i + 4 * wave + (lane >> 4);
        const float g = __shfl(gl, kr); float* tp = tile + kr * 65 + 4 * (lane & 15);
        tp[0] = wv[i].x * g; tp[1] = wv[i].y * g; tp[2] = wv[i].z * g; tp[3] = wv[i].w * g; }
    __syncthreads();
#pragma unroll 4
    for (int i = 0; i < 8; ++i) { const int n = i * 8 + (tid >> 5); const int kp = tid & 31;
        const unsigned v = pack2(tile[(2 * kp) * 65 + n], tile[(2 * kp + 1) * 65 + n]); *(unsigned*)(dst + (size_t)(n0 + n) * K + k0 + 2 * kp) = v; }
    __syncthreads();
}
DI void phase_prep(const Params& p, char* lds) {
    const int tid = threadIdx.x, lane = tid & 63, wave = tid >> 6;
    u16* xb = (u16*)(p.ws + W_XB); float* rstd = (float*)(p.ws + W_RSTD);
    for (int rg = blockIdx.x * 4 + wave; rg < NTOK / 4; rg += gridDim.x * 4) {
        float4 v[4][4]; float ss[4];
#pragma unroll
        for (int k = 0; k < 4; ++k) { const int row = rg * 4 + k; const float* src = row < NTP ? p.x_p + (size_t)row * DM : p.x_s + (size_t)(row - NTP) * DM;
#pragma unroll
            for (int i = 0; i < 4; ++i) v[k][i] = ((const float4*)src)[i * 64 + lane]; }
#pragma unroll
        for (int k = 0; k < 4; ++k) { float a = 0.f;
#pragma unroll
            for (int i = 0; i < 4; ++i) a += v[k][i].x * v[k][i].x + v[k][i].y * v[k][i].y + v[k][i].z * v[k][i].z + v[k][i].w * v[k][i].w;
            ss[k] = wave_sum(a); }
#pragma unroll
        for (int k = 0; k < 4; ++k) { const int row = rg * 4 + k;
            if (lane == 0) rstd[row] = rsqrtf(ss[k] * (1.f / 1024.f) + 1e-6f);
#pragma unroll
            for (int i = 0; i < 4; ++i) { uint2 w; w.x = pack2(v[k][i].x, v[k][i].y); w.y = pack2(v[k][i].z, v[k][i].w); *(uint2*)(xb + (size_t)row * DM + (i * 64 + lane) * 4) = w; } }
    }
    float* tile = (float*)lds;
    for (int t = blockIdx.x; t < 1056 + 256 + 16; t += gridDim.x) {
        if (t < 1056) transpose_tile(p.w_in, 1024, NC, p.norm_g, (u16*)(p.ws + W_WINT), tile, t);
        else if (t < 1312) transpose_tile(p.w_out, 1024, 1024, nullptr, (u16*)(p.ws + W_WOUTT), tile, t - 1056);
        else if (t < 1320) transpose_tile(p.w_up, 64, 512, nullptr, (u16*)(p.ws + W_WUPT), tile, t - 1312);
        else transpose_tile(p.a_up, 64, 512, nullptr, (u16*)(p.ws + W_AUPT), tile, t - 1320);
    }
}

template <class Epi>
DI void gemm_phase(const u16* __restrict__ A, const u16* __restrict__ B, int mtiles, int ntiles, char* lds, const Epi& epi) {
    const int ntile = mtiles * ntiles;
    const int vb = (blockIdx.x & 7) * (gridDim.x >> 3) + (blockIdx.x >> 3);
    const int npan = ntiles >> 3;
    int tile = vb; if (tile >= ntile) return;
#define TILE_MN(t, M0, N0) do { int pan_ = (t) / (mtiles * 8); if (pan_ >= npan) pan_ = npan - 1; const int pw_ = (pan_ == npan - 1) ? ntiles - 8 * pan_ : 8; const int loc_ = (t) - pan_ * mtiles * 8; \
        M0 = (loc_ / pw_) * 128; N0 = (8 * pan_ + loc_ % pw_) * 128; } while (0)
#define GSTAGE(buf, kt, GA, GB) do { _Pragma("unroll") for (int i = 0; i < 4; ++i) { \
            __builtin_amdgcn_global_load_lds((const unsigned*)((GA) + soff[i] + (kt) * 64), (LAS unsigned*)(lds + (buf) * 32768 + (i * 4 + wave) * 1024), 16, 0, 0); \
            __builtin_amdgcn_global_load_lds((const unsigned*)((GB) + soff[i] + (kt) * 64), (LAS unsigned*)(lds + (buf) * 32768 + 16384 + (i * 4 + wave) * 1024), 16, 0, 0); } } while (0)
    int m0, n0; TILE_MN(tile, m0, n0);
    {
        const int lane = threadIdx.x & 63, wave = __builtin_amdgcn_readfirstlane(threadIdx.x >> 6);
        unsigned soff[4];
#pragma unroll
        for (int i = 0; i < 4; ++i) { const int row = 8 * (i * 4 + wave) + (lane >> 3); const int ch = (lane & 7) ^ ((row >> 1) & 7); soff[i] = (unsigned)(row * 1024 + ch * 8); }
        GSTAGE(0, 0, A + (size_t)m0 * 1024, B + (size_t)n0 * 1024);
    }
    for (;;) {
        int tid = threadIdx.x; asm volatile("" : "+v"(tid));
        const int lane = tid & 63, wave = __builtin_amdgcn_readfirstlane(tid >> 6); const int wn = wave >> 1, wm = wave & 1; const int r = lane & 31, h = lane >> 5;
        f32x16 acc[2][2];
#pragma unroll
        for (int a = 0; a < 2; ++a)
#pragma unroll
            for (int b = 0; b < 2; ++b)
#pragma unroll
                for (int e = 0; e < 16; ++e) acc[a][b][e] = 0.f;
        unsigned soff[4];
#pragma unroll
        for (int i = 0; i < 4; ++i) { const int row = 8 * (i * 4 + wave) + (lane >> 3); const int ch = (lane & 7) ^ ((row >> 1) & 7); soff[i] = (unsigned)(row * 1024 + ch * 8); }
        const u16* ga = A + (size_t)m0 * 1024; const u16* gb = B + (size_t)n0 * 1024;
        __syncthreads();
        for (int kt = 0; kt < 16; ++kt) {
            if (kt + 1 < 16) GSTAGE((kt + 1) & 1, kt + 1, ga, gb);
            const char* sa = lds + (kt & 1) * 32768; const char* sb = sa + 16384;
#pragma unroll
            for (int ks = 0; ks < 4; ++ks) {
                bf16x8 fw[2], fx[2];
#pragma unroll
                for (int ct = 0; ct < 2; ++ct) fw[ct] = *(const bf16x8*)(sb + swz(wn * 64 + ct * 32 + r, 2 * ks + h));
#pragma unroll
                for (int tt = 0; tt < 2; ++tt) fx[tt] = *(const bf16x8*)(sa + swz(wm * 64 + tt * 32 + r, 2 * ks + h));
#pragma unroll
                for (int ct = 0; ct < 2; ++ct)
#pragma unroll
                    for (int tt = 0; tt < 2; ++tt) acc[ct][tt] = __builtin_amdgcn_mfma_f32_32x32x16_bf16(fw[ct], fx[tt], acc[ct][tt], 0, 0, 0);
            }
            __syncthreads();
        }
        const int nxt = tile + (int)gridDim.x; int m1 = 0, n1 = 0;
        if (nxt < ntile) { TILE_MN(nxt, m1, n1); GSTAGE(0, 0, A + (size_t)m1 * 1024, B + (size_t)n1 * 1024); }
        epi(acc, m0 + wm * 64, n0 + wn * 64, lane);
        if (nxt >= ntile) break;
        tile = nxt; m0 = m1; n0 = n1;
    }
#undef GSTAGE
#undef TILE_MN
}

struct Epi1 {
    const Params* p;
    DI void operator()(f32x16 (&acc)[2][2], int mrow0, int ncol0, int lane) const {
        const int r = lane & 31, h = lane >> 5; const int cb = ncol0 >> 6;
        u16* proj = (u16*)(p->ws + W_PROJ); const float* rstd = (const float*)(p->ws + W_RSTD); float* out = p->out;
#pragma unroll
        for (int tt = 0; tt < 2; ++tt) {
            const int row = mrow0 + tt * 32 + r; const float rs = rstd[row];
            float v[2][16];
#pragma unroll
            for (int ct = 0; ct < 2; ++ct)
#pragma unroll
                for (int e = 0; e < 16; ++e) v[ct][e] = acc[ct][tt][e] * rs;
            if (cb < 16) {
                float ss = 0.f;
#pragma unroll
                for (int ct = 0; ct < 2; ++ct)
#pragma unroll
                    for (int e = 0; e < 16; ++e) ss += v[ct][e] * v[ct][e];
                ss = xadd32(ss);
                const float inv = __builtin_amdgcn_rsqf(ss * (1.f / 64.f) + 1e-6f);
                const float* g = cb < 8 ? p->q_g : p->k_g;
#pragma unroll
                for (int ct = 0; ct < 2; ++ct)
#pragma unroll
                    for (int gq = 0; gq < 4; ++gq) { const float4 gg = *(const float4*)(g + ct * 32 + 8 * gq + 4 * h);
                        v[ct][4 * gq] *= inv * gg.x; v[ct][4 * gq + 1] *= inv * gg.y; v[ct][4 * gq + 2] *= inv * gg.z; v[ct][4 * gq + 3] *= inv * gg.w; }
            }
#pragma unroll
            for (int ct = 0; ct < 2; ++ct)
#pragma unroll
                for (int gq = 0; gq < 4; gq += 2) {
                    unsigned ax = pack2(v[ct][4 * gq], v[ct][4 * gq + 1]), ay = pack2(v[ct][4 * gq + 2], v[ct][4 * gq + 3]);
                    unsigned bx = pack2(v[ct][4 * gq + 4], v[ct][4 * gq + 5]), by = pack2(v[ct][4 * gq + 6], v[ct][4 * gq + 7]);
                    { auto rr = __builtin_amdgcn_permlane32_swap(ax, bx, false, false); ax = rr[0]; bx = rr[1]; }
                    { auto rr = __builtin_amdgcn_permlane32_swap(ay, by, false, false); ay = rr[0]; by = rr[1]; }
                    *(uint4*)(proj + (size_t)row * NC + ncol0 + ct * 32 + 8 * gq + 8 * h) = (uint4){ax, ay, bx, by};
                }
            float* dst = nullptr;
            if (cb >= 8 && cb < 24) {
                const int hh = cb & 7;
                if (row < NTP) { const int b = row >> 13, t = row & 8191; if (t >= 7680) dst = out + (cb < 16 ? O_KP : O_VP) + ((size_t)(b * 8 + hh) * 512 + (t - 7680)) * 64; }
                else { const int s = row - NTP; const int b = s >> 4, t = s & 15; dst = out + (cb < 16 ? O_KS : O_VS) + ((size_t)(b * 8 + hh) * 16 + t) * 64; }
            } else if (cb >= 32 && cb < 58) {
                if (row < NTP) { if ((row & 8191) == 8191) dst = out + O_SHP + (size_t)(row >> 13) * 1664 + (cb - 32) * 64; }
                else { const int s = row - NTP; if ((s & 15) == 15) dst = out + O_SHS + (size_t)(s >> 4) * 1664 + (cb - 32) * 64; }
            }
            if (dst) {
#pragma unroll
                for (int ct = 0; ct < 2; ++ct)
#pragma unroll
                    for (int gq = 0; gq < 4; ++gq) { float4 w = {v[ct][4 * gq], v[ct][4 * gq + 1], v[ct][4 * gq + 2], v[ct][4 * gq + 3]}; *(float4*)(dst + ct * 32 + 8 * gq + 4 * h) = w; }
            }
        }
    }
};
struct Epi2 {
    const Params* p;
    DI void operator()(f32x16 (&acc)[2][2], int mrow0, int ncol0, int lane) const {
        const int r = lane & 31, h = lane >> 5;
#pragma unroll
        for (int tt = 0; tt < 2; ++tt) {
            const int row = mrow0 + tt * 32 + r;
            const float* xr = row < NTP ? p->x_p + (size_t)row * DM : p->x_s + (size_t)(row - NTP) * DM;
            float* o = p->out + (size_t)row * DM;
#pragma unroll
            for (int ct = 0; ct < 2; ++ct)
#pragma unroll
                for (int gq = 0; gq < 4; ++gq) { const int col = ncol0 + ct * 32 + 8 * gq + 4 * h; const float4 xv = *(const float4*)(xr + col);
                    float4 w = {xv.x + acc[ct][tt][4 * gq], xv.y + acc[ct][tt][4 * gq + 1], xv.z + acc[ct][tt][4 * gq + 2], xv.w + acc[ct][tt][4 * gq + 3]}; *(float4*)(o + col) = w; }
        }
    }
};

DI void gemm_out(const Params& p, char* lds) {
    const u16* __restrict__ A = (const u16*)(p.ws + W_XB); const u16* __restrict__ B = (const u16*)(p.ws + W_WOUTT);
    const int ntile = 176 * 8;
    const int vb = (blockIdx.x & 7) * (gridDim.x >> 3) + (blockIdx.x >> 3);
    for (int tile = vb; tile < ntile; tile += gridDim.x) {
        int tid = threadIdx.x; asm volatile("" : "+v"(tid));
        const int lane = tid & 63, wave = __builtin_amdgcn_readfirstlane(tid >> 6); const int wn = wave >> 1, wm = wave & 1; const int q = lane & 15, g = lane >> 4;
        const int mt = tile >> 3, nt = tile & 7; const int m0 = mt * 96, n0 = nt * 128;
        f32x4 acc[4][3];
#pragma unroll
        for (int a = 0; a < 4; ++a)
#pragma unroll
            for (int b = 0; b < 3; ++b) acc[a][b] = (f32x4){0.f, 0.f, 0.f, 0.f};
        unsigned soffb[4], soffa[3];
#pragma unroll
        for (int i = 0; i < 4; ++i) { const int row = 8 * (i * 4 + wave) + (lane >> 3); const int ch = (lane & 7) ^ ((row >> 1) & 7); soffb[i] = (unsigned)(row * 1024 + ch * 8); }
#pragma unroll
        for (int i = 0; i < 3; ++i) { const int row = 8 * (i * 4 + wave) + (lane >> 3); const int ch = (lane & 7) ^ ((row >> 1) & 7); soffa[i] = (unsigned)(row * 1024 + ch * 8); }
        const u16* ga = A + (size_t)m0 * 1024; const u16* gb = B + (size_t)n0 * 1024;
#define OSTAGE(buf, kt) do { _Pragma("unroll") for (int i = 0; i < 4; ++i) \
            __builtin_amdgcn_global_load_lds((const unsigned*)(gb + soffb[i] + (kt) * 64), (LAS unsigned*)(lds + (buf) * 28672 + (i * 4 + wave) * 1024), 16, 0, 0); \
        _Pragma("unroll") for (int i = 0; i < 3; ++i) \
            __builtin_amdgcn_global_load_lds((const unsigned*)(ga + soffa[i] + (kt) * 64), (LAS unsigned*)(lds + (buf) * 28672 + 16384 + (i * 4 + wave) * 1024), 16, 0, 0); } while (0)
        OSTAGE(0, 0);
        float4 xres[3][4];
#pragma unroll
        for (int tt = 0; tt < 3; ++tt) { const int row = m0 + wm * 48 + tt * 16 + q; const float* xr = row < NTP ? p.x_p + (size_t)row * DM : p.x_s + (size_t)(row - NTP) * DM;
#pragma unroll
            for (int ct = 0; ct < 4; ++ct) xres[tt][ct] = ntld4(xr + n0 + wn * 64 + ct * 16 + 4 * g); }
        __syncthreads();
        for (int kt = 0; kt < 16; ++kt) {
            if (kt + 1 < 16) OSTAGE((kt + 1) & 1, kt + 1);
            const char* sb = lds + (kt & 1) * 28672; const char* sa = sb + 16384;
#pragma unroll
            for (int ks = 0; ks < 2; ++ks) {
                bf16x8 fw[4], fx[3];
#pragma unroll
                for (int ct = 0; ct < 4; ++ct) fw[ct] = *(const bf16x8*)(sb + swz(wn * 64 + ct * 16 + q, 4 * ks + g));
#pragma unroll
                for (int tt = 0; tt < 3; ++tt) fx[tt] = *(const bf16x8*)(sa + swz(wm * 48 + tt * 16 + q, 4 * ks + g));
#pragma unroll
                for (int ct = 0; ct < 4; ++ct)
#pragma unroll
                    for (int tt = 0; tt < 3; ++tt) acc[ct][tt] = __builtin_amdgcn_mfma_f32_16x16x32_bf16(fw[ct], fx[tt], acc[ct][tt], 0, 0, 0);
            }
            __syncthreads();
        }
#undef OSTAGE
#pragma unroll
        for (int tt = 0; tt < 3; ++tt) {
            const int row = m0 + wm * 48 + tt * 16 + q;
            const float* xr = row < NTP ? p.x_p + (size_t)row * DM : p.x_s + (size_t)(row - NTP) * DM;
            float* o = p.out + (size_t)row * DM;
#pragma unroll
            for (int ct = 0; ct < 4; ++ct) { const int col = n0 + wn * 64 + ct * 16 + 4 * g; const float4 xv = xres[tt][ct];
                const f32x4 w = {xv.x + acc[ct][tt][0], xv.y + acc[ct][tt][1], xv.z + acc[ct][tt][2], xv.w + acc[ct][tt][3]}; __builtin_nontemporal_store(w, (f32x4*)(o + col)); }
        }
    }
}

DI f32x16 mmq(const char* X, const char* Y, int qm, int qn, f32x16 acc, int lane) {
    const int r = lane & 31, h = lane >> 5;
#pragma unroll
    for (int ks = 0; ks < 4; ++ks) {
        const bf16x8 a = *(const bf16x8*)(X + swz(32 * qm + r, 2 * ks + h));
        const bf16x8 b = *(const bf16x8*)(Y + swz(32 * qn + r, 2 * ks + h));
        acc = __builtin_amdgcn_mfma_f32_32x32x16_bf16(a, b, acc, 0, 0, 0);
    }
    return acc;
}
DI void st_nat(char* img, const f32x16& a, int qm, int qn, int lane) {
    const int n = 32 * qn + (lane & 31), h = lane >> 5;
#pragma unroll
    for (int g = 0; g < 4; ++g) { const int m = 32 * qm + 8 * g + 4 * h; uint2 w; w.x = pack2(a[4 * g], a[4 * g + 1]); w.y = pack2(a[4 * g + 2], a[4 * g + 3]);
        *(uint2*)(img + swz(n, m >> 3) + (m & 7) * 2) = w; }
}
DI void st_nat_g(u16* gimg, const f32x16& a, int qm, int qn, int lane) {
    const int n = 32 * qn + (lane & 31), h = lane >> 5;
#pragma unroll
    for (int g = 0; g < 4; ++g) { const int m = 32 * qm + 8 * g + 4 * h; uint2 w; w.x = pack2(a[4 * g], a[4 * g + 1]); w.y = pack2(a[4 * g + 2], a[4 * g + 3]);
        *(uint2*)(gimg + n * 64 + m) = w; }
}
DI void st_nat_gp(u16* gimg, const f32x16& a, int qm, int qn, int lane) {
    const int n = 32 * qn + (lane & 31), h = lane >> 5;
#pragma unroll
    for (int g = 0; g < 2; ++g) { const int m = 32 * qm + 8 * g + 4 * h; const int mp = (m & ~0x1c) | ((m & 0xc) << 1) | ((m & 0x10) >> 2);
        uint4 w; w.x = pack2(a[4 * g], a[4 * g + 1]); w.y = pack2(a[4 * g + 2], a[4 * g + 3]); w.z = pack2(a[4 * g + 8], a[4 * g + 9]); w.w = pack2(a[4 * g + 10], a[4 * g + 11]);
        *(uint4*)(gimg + n * 64 + mp) = w; }
}
DI void st_sc(char* img, const f32x16& a, int qm, int qn, int lane) {
    const int n = 32 * qn + (lane & 31), h = lane >> 5;
#pragma unroll
    for (int e = 0; e < 16; ++e) { const int m = 32 * qm + (e & 3) + 8 * (e >> 2) + 4 * h; *(u16*)(img + swz(m, n >> 3) + (n & 7) * 2) = f2bf(a[e]); }
}
DI f32x16 ld_nat(const char* img, int qm, int qn, int lane) {
    const int n = 32 * qn + (lane & 31), h = lane >> 5; f32x16 a;
#pragma unroll
    for (int g = 0; g < 4; ++g) { const int m = 32 * qm + 8 * g + 4 * h; const uint2 w = *(const uint2*)(img + swz(n, m >> 3) + (m & 7) * 2);
        a[4 * g] = bflo(w.x); a[4 * g + 1] = bfhi(w.x); a[4 * g + 2] = bflo(w.y); a[4 * g + 3] = bfhi(w.y); }
    return a;
}
DI void ld_cur_prev8(const Params& p, int row, int col, int mode, int sb, float* cur, float* prev) {
    const u16* proj = (const u16*)(p.ws + W_PROJ);
    unpack8(*(const uint4*)(proj + (size_t)row * NC + col), cur);
    if (mode == 0) unpack8(*(const uint4*)(proj + (size_t)(row - 1) * NC + col), prev);
    else if (mode == 1) { for (int i = 0; i < 8; ++i) prev[i] = 0.f; }
    else { const float* s = p.st_shift + (size_t)sb * 1664 + (col - C_R); const float4 a = *(const float4*)s, b = *(const float4*)(s + 4);
        prev[0] = a.x; prev[1] = a.y; prev[2] = a.z; prev[3] = a.w; prev[4] = b.x; prev[5] = b.y; prev[6] = b.z; prev[7] = b.w; }
}
DI float ld_prev1(const Params& p, int row, int col, int mode, int sb) {
    const u16* proj = (const u16*)(p.ws + W_PROJ);
    if (mode == 0) return bf2f(proj[(size_t)(row - 1) * NC + col]);
    if (mode == 1) return 0.f;
    return p.st_shift[(size_t)sb * 1664 + (col - C_R)];
}

DI void phase_rwkv_prep(const Params& p, char* lds) {
    const u16* proj = (const u16*)(p.ws + W_PROJ);
    char* R0 = lds; char* R1 = lds + 8192; char* R2 = lds + 2 * 8192; char* R3 = lds + 3 * 8192; char* R4 = lds + 4 * 8192; char* R5 = lds + 5 * 8192;
    char* R6 = lds + 6 * 8192; char* R7 = lds + 7 * 8192; char* R8 = lds + 8 * 8192;
    float* tot = (float*)(lds + 9 * 8192); float* gam = tot + 256;
    for (int u = blockIdx.x; u < NUNIT; u += gridDim.x) {
        int tid = threadIdx.x; asm volatile("" : "+v"(tid));
        const int lane = tid & 63, wave = __builtin_amdgcn_readfirstlane(tid >> 6); const int qm = wave >> 1, qn = wave & 1; const int r = lane & 31, h5 = lane >> 5;
        int b, h, c, row0, ntok; bool prm = u < 2048;
        if (prm) { b = u >> 10; h = (u >> 7) & 7; c = u & 127; row0 = b * 8192 + c * 64; ntok = 64; }
        else { const int s = u - 2048; b = s >> 3; h = s & 7; c = 0; row0 = NTP + b * 16; ntok = 16; }
        const int mode0 = prm ? (c > 0 ? 0 : 1) : 2;
        uint4 wr_[2], wk_[2], wv_[2];
#pragma unroll
        for (int i = 0; i < 2; ++i) { wr_[i] = (uint4){0, 0, 0, 0}; wk_[i] = wr_[i]; wv_[i] = wr_[i];
            if (16 * wave < ntok) { const u16* src = proj + (size_t)(row0 + 16 * wave + 8 * i + (lane >> 3)) * NC + h * 64 + 8 * (lane & 7);
                wr_[i] = *(const uint4*)(src + C_R); wk_[i] = *(const uint4*)(src + C_RK); wv_[i] = *(const uint4*)(src + C_RV); } }
        {
            const int t = tid >> 2, q = tid & 3;
#pragma unroll
            for (int half = 0; half < 2; ++half) {
                const int cw = q * 16 + half * 8;
                uint4 ow = {0, 0, 0, 0}, oa = {0, 0, 0, 0};
                if (t < ntok) {
                    const int mode = t > 0 ? 0 : mode0; float cur[8], prv[8], xw[8], xa[8];
                    ld_cur_prev8(p, row0 + t, C_WD + cw, mode, b, cur, prv);
                    { const float4 ma = *(const float4*)(p.mix + 1536 + cw), mb = *(const float4*)(p.mix + 1540 + cw); const float mx_[8] = {ma.x, ma.y, ma.z, ma.w, mb.x, mb.y, mb.z, mb.w};
#pragma unroll
                    for (int i = 0; i < 8; ++i) { const float x = cur[i] + (prv[i] - cur[i]) * mx_[i]; const float e2 = __expf(2.f * x); xw[i] = 1.f - 2.f * rcpf_(e2 + 1.f); } }
                    ld_cur_prev8(p, row0 + t, C_AD + cw, mode, b, cur, prv);
                    { const float4 ma = *(const float4*)(p.mix + 1600 + cw), mb = *(const float4*)(p.mix + 1604 + cw); const float mx_[8] = {ma.x, ma.y, ma.z, ma.w, mb.x, mb.y, mb.z, mb.w};
#pragma unroll
                    for (int i = 0; i < 8; ++i) xa[i] = cur[i] + (prv[i] - cur[i]) * mx_[i]; }
                    ow.x = pack2(xw[0], xw[1]); ow.y = pack2(xw[2], xw[3]); ow.z = pack2(xw[4], xw[5]); ow.w = pack2(xw[6], xw[7]);
                    oa.x = pack2(xa[0], xa[1]); oa.y = pack2(xa[2], xa[3]); oa.z = pack2(xa[4], xa[5]); oa.w = pack2(xa[6], xa[7]);
                }
                *(uint4*)(R0 + swz(t, 2 * q + half)) = ow; *(uint4*)(R1 + swz(t, 2 * q + half)) = oa;
            }
        }
        __syncthreads();
        {
            f32x16 adw, ada;
#pragma unroll
            for (int e = 0; e < 16; ++e) { adw[e] = 0.f; ada[e] = 0.f; }
            const u16* wup = (const u16*)(p.ws + W_WUPT) + (size_t)(h * 64 + 32 * qn + r) * 64; const u16* aup = (const u16*)(p.ws + W_AUPT) + (size_t)(h * 64 + 32 * qn + r) * 64;
#pragma unroll
            for (int ks = 0; ks < 4; ++ks) {
                const bf16x8 xa = *(const bf16x8*)(R0 + swz(32 * qm + r, 2 * ks + h5)); const bf16x8 xb = *(const bf16x8*)(R1 + swz(32 * qm + r, 2 * ks + h5));
                const bf16x8 ya = *(const bf16x8*)(wup + 16 * ks + 8 * h5); const bf16x8 yb = *(const bf16x8*)(aup + 16 * ks + 8 * h5);
                adw = __builtin_amdgcn_mfma_f32_32x32x16_bf16(xa, ya, adw, 0, 0, 0); ada = __builtin_amdgcn_mfma_f32_32x32x16_bf16(xb, yb, ada, 0, 0, 0);
            }
            float* DW = (float*)R4; float* DA = (float*)R6; const int n = 32 * qn + r;
#pragma unroll
            for (int e = 0; e < 16; ++e) { const int m = 32 * qm + (e & 3) + 8 * (e >> 2) + 4 * h5; DW[m * 64 + n] = adw[e]; DA[m * 64 + n] = ada[e]; }
        }
        __syncthreads();
        {
            const int tg = wave, j = lane, hj = h * 64 + j;
            float* DW = (float*)R4; const float* DA = (const float*)R6;
            { const float w0j = p.w0[hj];
                float run = 0.f;
#pragma unroll 4
                for (int i = 0; i < 16; ++i) { const int t = 16 * tg + i; const float x = w0j + DW[t * 64 + j];
                    const float z = -x; const float sp = fmaxf(z, 0.f) + __logf(1.f + __expf(-fabsf(z))); float l = -__expf(-sp - 0.5f); if (t >= ntok) l = 0.f; DW[t * 64 + j] = l; run += l; }
                tot[tg * 64 + j] = run;
            }
            __syncthreads();
            float prefix = 0.f, ctot = 0.f;
#pragma unroll
            for (int g = 0; g < 4; ++g) { const float v = tot[g * 64 + j]; if (g < tg) prefix += v; ctot += v; }
            if (tg == 0) gam[j] = __expf(ctot);
            const float a0j = p.a0[hj], kkj = p.k_k[hj], kaj = p.k_a[hj], rkj = p.r_k[hj];
            const float mr = p.mix[hj], mk = p.mix[512 + hj], mv = p.mix[1024 + hj];
            float* bonus = (float*)(p.ws + W_BONUS);
            float mybon = 0.f;
            u16 gcr[16], gck[16], gcv[16];
            { char* tb = R8 + wave * 2048; char* wp = tb + (lane >> 3) * 128 + (lane & 7) * 16; const char* rp = tb + lane * 2;
#define XPOSE16(W, OUT) do { asm volatile("s_waitcnt lgkmcnt(0)" ::: "memory"); *(uint4*)wp = W[0]; *(uint4*)(wp + 1024) = W[1]; asm volatile("s_waitcnt lgkmcnt(0)" ::: "memory"); \
                    _Pragma("unroll") for (int tt = 0; tt < 16; ++tt) OUT[tt] = *(const u16*)(rp + tt * 128); } while (0)
                XPOSE16(wr_, gcr); XPOSE16(wk_, gck); XPOSE16(wv_, gcv);
#undef XPOSE16
            }
            float pr = 0.f, pk = 0.f, pv = 0.f;
            { const int t0 = 16 * tg; if (t0 < ntok) { const int mode = t0 > 0 ? 0 : mode0; pr = ld_prev1(p, row0 + t0, C_R + hj, mode, b); pk = ld_prev1(p, row0 + t0, C_RK + hj, mode, b); pv = ld_prev1(p, row0 + t0, C_RV + hj, mode, b); } }
            float ecl = __expf(prefix); const float etot = __expf(ctot);
            unsigned pAt[8], pV[8], pKb[8], pBb[8]; float hAt = 0.f, hV = 0.f, hKb = 0.f, hBb = 0.f;
#pragma unroll
            for (int i = 0; i < 16; ++i) {
                const int t = 16 * tg + i; const bool valid = t < ntok;
                float xr = 0.f, xk = 0.f, xv = 0.f;
                if (valid) { const float cr = bf2f(gcr[i]), ck = bf2f(gck[i]), cv = bf2f(gcv[i]);
                    xr = cr + (pr - cr) * mr; xk = ck + (pk - ck) * mk; xv = cv + (pv - cv) * mv; pr = cr; pk = ck; pv = cv; }
                const float a = rcpf_(1.f + __expf(-(a0j + DA[t * 64 + j])));
                const float kx = xk * kkj; const float ss = wave_sum(kx * kx); const float kk = kx * __builtin_amdgcn_rsqf(fmaxf(ss, 1e-24f));
                const float kmod = xk * (1.f + (a - 1.f) * kaj);
                const float bon = wave_sum(xr * kmod * rkj);
                if (lane == i) mybon = bon;
                const float e_ce = ecl; ecl *= __expf(DW[t * 64 + j]);
                const float e_cl = ecl, e_n = rcpf_(ecl), e_t = etot * e_n;
                const float vAt = -kk * e_ce, vRt = xr * e_cl, vBt = kk * a * e_n, vKt = kmod * e_n, vBb = kk * a * e_t, vKb = kmod * e_t;
                const int so = swz(t, j >> 3) + (j & 7) * 2;
                *(u16*)(R0 + so) = f2bf(vAt); *(u16*)(R1 + so) = f2bf(vRt); *(u16*)(R2 + so) = f2bf(vBt); *(u16*)(R3 + so) = f2bf(vKt);
                if (i & 1) { pAt[i >> 1] = pack2(hAt, vAt); pV[i >> 1] = pack2(hV, xv); pKb[i >> 1] = pack2(hKb, vKb); pBb[i >> 1] = pack2(hBb, vBb); }
                else { hAt = vAt; hV = xv; hKb = vKb; hBb = vBb; }
            }
            if (lane < 16) bonus[(size_t)u * 64 + 16 * tg + lane] = mybon;
            __syncthreads();
#pragma unroll
            for (int half = 0; half < 2; ++half) { const int o = swz(j, 2 * tg + half);
                *(uint4*)(R4 + o) = (uint4){pAt[4 * half], pAt[4 * half + 1], pAt[4 * half + 2], pAt[4 * half + 3]};
                *(uint4*)(R5 + o) = (uint4){pV[4 * half], pV[4 * half + 1], pV[4 * half + 2], pV[4 * half + 3]};
                *(uint4*)(R6 + o) = (uint4){pKb[4 * half], pKb[4 * half + 1], pKb[4 * half + 2], pKb[4 * half + 3]};
                *(uint4*)(R7 + o) = (uint4){pBb[4 * half], pBb[4 * half + 1], pBb[4 * half + 2], pBb[4 * half + 3]}; }
        }
        __syncthreads();
        f32x16 z16;
#pragma unroll
        for (int e = 0; e < 16; ++e) z16[e] = 0.f;
        f32x16 aN = mmq(R2, R0, qm, qn, z16, lane);
        f32x16 aKa = mmq(R3, R0, qm, qn, z16, lane);
        f32x16 aW1 = mmq(R2, R1, qm, qn, z16, lane);
        f32x16 aKr = mmq(R3, R1, qm, qn, z16, lane);
        {
            const int n = 32 * qn + r;
#pragma unroll
            for (int e = 0; e < 16; ++e) { const int m = 32 * qm + (e & 3) + 8 * (e >> 2) + 4 * h5;
                if (!(m < n)) { aN[e] = 0.f; aKa[e] = 0.f; } if (!(m <= n)) { aW1[e] = 0.f; aKr[e] = 0.f; } }
        }
        f32x16 aW2 = ld_nat(R7, qm, qn, lane);
        __syncthreads();
        st_sc(R0, aN, qm, qn, lane);
        st_nat(R2, aN, qm, qn, lane);
        st_sc(R3, aKa, qm, qn, lane);
        st_nat(R8, aW1, qm, qn, lane);
        __syncthreads();
        for (int it = 0; it < 6; ++it) {
            aW1 = mmq(R0, R8, qm, qn, aW1, lane);
            aW2 = mmq(R0, R7, qm, qn, aW2, lane);
            if (it < 5) aN = mmq(R0, R2, qm, qn, z16, lane);
            __syncthreads();
            st_nat(R8, aW1, qm, qn, lane); st_nat(R7, aW2, qm, qn, lane);
            if (it < 5) { st_sc(R0, aN, qm, qn, lane); st_nat(R2, aN, qm, qn, lane); }
            __syncthreads();
        }
        {
            f32x16 aG = mmq(R4, R7, qm, qn, z16, lane);
            { const int n = 32 * qn + r; const float gn = gam[n];
#pragma unroll
                for (int e = 0; e < 16; ++e) { const int m = 32 * qm + (e & 3) + 8 * (e >> 2) + 4 * h5; if (m == n) aG[e] += gn; } }
            st_nat_gp((u16*)(p.ws + W_GT) + (size_t)u * 4096, aG, qm, qn, lane);
            f32x16 aQ = ld_nat(R1, qm, qn, lane);
            aQ = mmq(R4, R8, qm, qn, aQ, lane);
            st_nat_gp((u16*)(p.ws + W_QT) + (size_t)u * 4096, aQ, qm, qn, lane);
            f32x16 aP1 = ld_nat(R6, qm, qn, lane);
            aP1 = mmq(R3, R7, qm, qn, aP1, lane);
            aKr = mmq(R3, R8, qm, qn, aKr, lane);
            st_nat(R0, aP1, qm, qn, lane);
            st_nat(R2, aKr, qm, qn, lane);
        }
        __syncthreads();
        {
            f32x16 aH = mmq(R0, R5, qm, qn, z16, lane);
            st_nat_gp((u16*)(p.ws + W_HH) + (size_t)u * 4096, aH, qm, qn, lane);
            f32x16 aY = mmq(R5, R2, qm, qn, z16, lane);
            const int n = 32 * qn + r;

#pragma unroll
            for (int g = 0; g < 4; g += 2) {
                unsigned ax = pack2(aY[4 * g], aY[4 * g + 1]), ay = pack2(aY[4 * g + 2], aY[4 * g + 3]), bx = pack2(aY[4 * g + 4], aY[4 * g + 5]), by = pack2(aY[4 * g + 6], aY[4 * g + 7]);
                { auto rr = __builtin_amdgcn_permlane32_swap(ax, bx, false, false); ax = rr[0]; bx = rr[1]; }
                { auto rr = __builtin_amdgcn_permlane32_swap(ay, by, false, false); ay = rr[0]; by = rr[1]; }
                if (n < ntok) *(uint4*)((u16*)(p.ws + W_XB) + (size_t)(row0 + n) * DM + 512 + h * 64 + 32 * qm + 8 * g + 8 * h5) = (uint4){ax, ay, bx, by};
            }
        }
        __syncthreads();
    }
}

struct ScanSlot { uint4 ga[4][2]; uint4 gh[2]; };
DI void scan_load(ScanSlot& s, const u16* GT, const u16* HH, int u, int irow, int i16, int g) {
    const u16* gt = GT + (size_t)u * 4096; const u16* hh = HH + (size_t)u * 4096 + irow * 64;
#pragma unroll
    for (int mt = 0; mt < 4; ++mt) {
#pragma unroll
        for (int ks = 0; ks < 2; ++ks) s.ga[mt][ks] = *(const uint4*)(gt + (16 * mt + i16) * 64 + 32 * ks + 8 * g);
    }
#pragma unroll
    for (int ks = 0; ks < 2; ++ks) s.gh[ks] = *(const uint4*)(hh + 32 * ks + 8 * g);
}
DI void scan_step(const ScanSlot& s, f32x4 (&acc)[4], u16* sst, int irow, int g) {
    unsigned pk[4][2];
#pragma unroll
    for (int mt = 0; mt < 4; ++mt) { pk[mt][0] = pack2(acc[mt][0], acc[mt][1]); pk[mt][1] = pack2(acc[mt][2], acc[mt][3]); }
    bf16x8 bfr[2];
#pragma unroll
    for (int ks = 0; ks < 2; ++ks) { uint4 w = {pk[2 * ks][0], pk[2 * ks][1], pk[2 * ks + 1][0], pk[2 * ks + 1][1]}; bfr[ks] = __builtin_bit_cast(bf16x8, w);
        *(uint4*)(sst + irow * 64 + 32 * ks + 8 * g) = w; }
#pragma unroll
    for (int mt = 0; mt < 4; ++mt) {
        const unsigned hx = (mt & 1) ? s.gh[mt >> 1].z : s.gh[mt >> 1].x, hy = (mt & 1) ? s.gh[mt >> 1].w : s.gh[mt >> 1].y;
        f32x4 c = {bflo(hx), bfhi(hx), bflo(hy), bfhi(hy)};
#pragma unroll
        for (int ks = 0; ks < 2; ++ks) c = __builtin_amdgcn_mfma_f32_16x16x32_bf16(__builtin_bit_cast(bf16x8, s.ga[mt][ks]), bfr[ks], c, 0, 0, 0);
        acc[mt] = c;
    }
}
DI void scan_item(const Params& p, int item, int lane) {
    const int i16 = lane & 15, g = lane >> 4;
    const u16* GT = (const u16*)(p.ws + W_GT); const u16* HH = (const u16*)(p.ws + W_HH); u16* SST = (u16*)(p.ws + W_SST);
    f32x4 acc[4];
    if (item < 64) {
        const int bh = item >> 2, iq = item & 3, u0 = bh * 128, irow = 16 * iq + i16;
#pragma unroll
        for (int mt = 0; mt < 4; ++mt) acc[mt] = (f32x4){0.f, 0.f, 0.f, 0.f};
        ScanSlot s0, s1, s2, s3, s4;
        scan_load(s0, GT, HH, u0, irow, i16, g); scan_load(s1, GT, HH, u0 + 1, irow, i16, g); scan_load(s2, GT, HH, u0 + 2, irow, i16, g); scan_load(s3, GT, HH, u0 + 3, irow, i16, g);
        scan_load(s4, GT, HH, u0 + 4, irow, i16, g);
        const int ul = u0 + 127;
#define PINM do { asm volatile("" ::: "memory"); __builtin_amdgcn_sched_barrier(0); } while (0)
        for (int st = 0; st < 125; st += 5) {
            const int u = u0 + st;
            scan_step(s0, acc, SST + (size_t)u * 4096, irow, g);       PINM; scan_load(s0, GT, HH, min(u + 5, ul), irow, i16, g); PINM;
            scan_step(s1, acc, SST + (size_t)(u + 1) * 4096, irow, g); PINM; scan_load(s1, GT, HH, min(u + 6, ul), irow, i16, g); PINM;
            scan_step(s2, acc, SST + (size_t)(u + 2) * 4096, irow, g); PINM; scan_load(s2, GT, HH, min(u + 7, ul), irow, i16, g); PINM;
            scan_step(s3, acc, SST + (size_t)(u + 3) * 4096, irow, g); PINM; scan_load(s3, GT, HH, min(u + 8, ul), irow, i16, g); PINM;
            scan_step(s4, acc, SST + (size_t)(u + 4) * 4096, irow, g); PINM; scan_load(s4, GT, HH, min(u + 9, ul), irow, i16, g); PINM;
        }
        scan_step(s0, acc, SST + (size_t)(u0 + 125) * 4096, irow, g); PINM;
        scan_step(s1, acc, SST + (size_t)(u0 + 126) * 4096, irow, g); PINM;
        scan_step(s2, acc, SST + (size_t)(u0 + 127) * 4096, irow, g);
#undef PINM
        float* fout = p.out + O_SP + (size_t)bh * 4096;
#pragma unroll
        for (int mt = 0; mt < 4; ++mt) *(f32x4*)(fout + irow * 64 + 16 * mt + 4 * g) = acc[mt];
    } else {
        const int s = (item - 64) >> 2, iq = item & 3, u = 2048 + s, irow = 16 * iq + i16;
        const float* st0 = p.st_wkv + (size_t)s * 4096 + irow * 64;
#pragma unroll
        for (int mt = 0; mt < 4; ++mt) acc[mt] = *(const f32x4*)(st0 + 16 * mt + 4 * g);
        ScanSlot s0; scan_load(s0, GT, HH, u, irow, i16, g);
        scan_step(s0, acc, SST + (size_t)u * 4096, irow, g);
        float* fout = p.out + O_SS + (size_t)s * 4096;
#pragma unroll
        for (int mt = 0; mt < 4; ++mt) *(f32x4*)(fout + irow * 64 + 16 * mt + 4 * g) = acc[mt];
    }
}

DI s16x4 tr16(const char* p) { return __builtin_bit_cast(s16x4, __builtin_amdgcn_ds_read_tr16_b64_v4i16((__attribute__((address_space(3))) s16x4*)p)); }

DI void attn_tile(const char* sk, const char* sv, const float* tab, const bf16x8& qf0, const bf16x8& qf1, float& m, float& l, f32x4 (&o)[4], int qpos, int dlt, int nvalid, int lane) {
    const int q = lane & 15, g = lane >> 4;
    const float C2 = 0.125f * LOG2E;
    f32x4 sc[4];
#pragma unroll
    for (int kt = 0; kt < 4; ++kt) {
        const bf16x8 a0 = *(const bf16x8*)(sk + swz(16 * kt + q, g)); const bf16x8 a1 = *(const bf16x8*)(sk + swz(16 * kt + q, 4 + g));
        f32x4 s = {0.f, 0.f, 0.f, 0.f};
        s = __builtin_amdgcn_mfma_f32_16x16x32_bf16(a0, qf0, s, 0, 0, 0); s = __builtin_amdgcn_mfma_f32_16x16x32_bf16(a1, qf1, s, 0, 0, 0);
        sc[kt] = s;
    }
    float mx = -INFINITY;
    if (dlt >= 3) {
        const float bc = tab[256];
#pragma unroll
        for (int kt = 0; kt < 4; ++kt)
#pragma unroll
            for (int e = 0; e < 4; ++e) { const float s = sc[kt][e] * C2 + bc; sc[kt][e] = s; mx = fmaxf(mx, s); }
    } else {
#pragma unroll
        for (int kt = 0; kt < 4; ++kt)
#pragma unroll
            for (int e = 0; e < 4; ++e) { const int key = 16 * kt + 4 * g + e; int rel = qpos - key + dlt * 64; rel = rel < -128 ? -128 : (rel > 128 ? 128 : rel);
                float s = sc[kt][e] * C2 + tab[rel + 128]; if (key >= nvalid) s = -INFINITY; sc[kt][e] = s; mx = fmaxf(mx, s); }
    }
    mx = xmax16(mx); mx = xmax32(mx);
    const float mn = fmaxf(m, mx); const float alpha = __builtin_amdgcn_exp2f(m - mn); m = mn;
    float ps = 0.f;
#pragma unroll
    for (int kt = 0; kt < 4; ++kt)
#pragma unroll
        for (int e = 0; e < 4; ++e) { const float pe = __builtin_amdgcn_exp2f(sc[kt][e] - mn); sc[kt][e] = pe; ps += pe; }
    l = l * alpha + ps;
#pragma unroll
    for (int dt = 0; dt < 4; ++dt) o[dt] *= alpha;
    bf16x8 pf[2];
#pragma unroll
    for (int ks = 0; ks < 2; ++ks) { uint4 w = {pack2(sc[2 * ks][0], sc[2 * ks][1]), pack2(sc[2 * ks][2], sc[2 * ks][3]), pack2(sc[2 * ks + 1][0], sc[2 * ks + 1][1]), pack2(sc[2 * ks + 1][2], sc[2 * ks + 1][3])};
        pf[ks] = __builtin_bit_cast(bf16x8, w); }
#pragma unroll
    for (int dt = 0; dt < 4; ++dt)
#pragma unroll
        for (int ks = 0; ks < 2; ++ks) {
            const int vr = 32 * ks + 4 * g + (q >> 2); const int col = 16 * dt + 4 * (q & 3);
            const s16x4 lo = tr16(sv + swz(vr, col >> 3) + (col & 7) * 2); const s16x4 hi = tr16(sv + swz(vr + 16, col >> 3) + (col & 7) * 2);
            const bf16x8 vf = {lo[0], lo[1], lo[2], lo[3], hi[0], hi[1], hi[2], hi[3]};
            o[dt] = __builtin_amdgcn_mfma_f32_16x16x32_bf16(vf, pf[ks], o[dt], 0, 0, 0);
        }
}
DI void attn_finish(const Params& p, float l, const f32x4 (&o)[4], int qrow, int h, int lane) {
    const int g = lane >> 4; const u16* proj = (const u16*)(p.ws + W_PROJ);
    l = xadd16(l); l = xadd32(l);
    const float inv = rcpf_(l);
    u16* z = (u16*)(p.ws + W_XB) + (size_t)qrow * DM + h * 64; const u16* ga = proj + (size_t)qrow * NC + C_GA + h * 64;
    uint2 w[4];
#pragma unroll
    for (int dt = 0; dt < 4; ++dt) { const int d = 16 * dt + 4 * g; const uint2 gg = *(const uint2*)(ga + d);
        w[dt].x = pack2(o[dt][0] * inv * silu(bflo(gg.x)), o[dt][1] * inv * silu(bfhi(gg.x))); w[dt].y = pack2(o[dt][2] * inv * silu(bflo(gg.y)), o[dt][3] * inv * silu(bfhi(gg.y))); }
#pragma unroll
    for (int dt = 0; dt < 4; dt += 2) *(uint4*)(z + 16 * (dt + (g & 1)) + 8 * (g >> 1)) = widen16(w[dt], w[dt + 1]);
}
DI void attn_block(const Params& p, int u, char* lds) {
    int tid = threadIdx.x; asm volatile("" : "+v"(tid));
    const int lane = tid & 63, wave = __builtin_amdgcn_readfirstlane(tid >> 6);
    const u16* proj = (const u16*)(p.ws + W_PROJ);
    const int b = u >> 10, h = (u >> 7) & 7, c = u & 127; const int qrow = b * 8192 + c * 64 + wave * 16 + (lane & 15); const int ndl = c < 8 ? c : 8;
    float* tab = (float*)(lds + 49152);
    __syncthreads();
    for (int i = tid; i < 257; i += 256) tab[i] = p.relb[h * 257 + i] * LOG2E;
    const u16* qp = proj + (size_t)qrow * NC + C_Q + h * 64 + 8 * (lane >> 4);
    const bf16x8 qf0 = *(const bf16x8*)qp, qf1 = *(const bf16x8*)(qp + 32);
    float m = -INFINITY, l = 0.f; f32x4 o[4];
#pragma unroll
    for (int dt = 0; dt < 4; ++dt) o[dt] = (f32x4){0.f, 0.f, 0.f, 0.f};
    unsigned soff[2];
#pragma unroll
    for (int i = 0; i < 2; ++i) { const int row = 8 * (i * 4 + wave) + (lane >> 3); const int ch = (lane & 7) ^ ((row >> 1) & 7); soff[i] = (unsigned)(row * NC + ch * 8); }
    const u16* kbase = proj + (size_t)(b * 8192) * NC + h * 64;
#define ASTAGE(buf, dl) do { const u16* kr = kbase + (size_t)((c - (dl)) * 64) * NC; _Pragma("unroll") for (int i = 0; i < 2; ++i) { \
        __builtin_amdgcn_global_load_lds((const unsigned*)(kr + soff[i] + C_K), (LAS unsigned*)(lds + (buf) * 8192 + (i * 4 + wave) * 1024), 16, 0, 0); \
        __builtin_amdgcn_global_load_lds((const unsigned*)(kr + soff[i] + C_V), (LAS unsigned*)(lds + 24576 + (buf) * 8192 + (i * 4 + wave) * 1024), 16, 0, 0); } } while (0)
    __syncthreads();
    ASTAGE(0, ndl); if (ndl >= 1) ASTAGE(1, ndl - 1);
    int buf = 0;
    for (int dlt = ndl; dlt >= 0; --dlt) {
        if (dlt >= 1) asm volatile("s_waitcnt vmcnt(4) lgkmcnt(0)" ::: "memory"); else asm volatile("s_waitcnt vmcnt(0) lgkmcnt(0)" ::: "memory");
        __builtin_amdgcn_s_barrier();
        asm volatile("" ::: "memory");
        const int nb2 = buf >= 1 ? buf - 1 : 2;
        if (dlt >= 2) ASTAGE(nb2, dlt - 2);
        attn_tile(lds + buf * 8192, lds + 24576 + buf * 8192, tab, qf0, qf1, m, l, o, wave * 16 + (lane & 15), dlt, 64, lane);
        buf = buf == 2 ? 0 : buf + 1;
    }
#undef ASTAGE
    attn_finish(p, l, o, qrow, h, lane);
}
struct QG { bf16x8 q0, q1; float m, l; f32x4 o[4]; };
DI void attn_softmax(f32x4 (&sc)[4], const float* tab, QG& G, int qpos, int dlt, int g, bf16x8 (&pf)[2]) {
    const float C2 = 0.125f * LOG2E;
    float mx = -INFINITY;
    if (dlt >= 3) {
        const float bc = tab[256];
#pragma unroll
        for (int kt = 0; kt < 4; ++kt)
#pragma unroll
            for (int e = 0; e < 4; ++e) { const float s = sc[kt][e] * C2 + bc; sc[kt][e] = s; mx = fmaxf(mx, s); }
    } else {
#pragma unroll
        for (int kt = 0; kt < 4; ++kt)
#pragma unroll
            for (int e = 0; e < 4; ++e) { const int key = 16 * kt + 4 * g + e; int rel = qpos - key + dlt * 64; rel = rel < -128 ? -128 : (rel > 128 ? 128 : rel);
                const float s = sc[kt][e] * C2 + tab[rel + 128]; sc[kt][e] = s; mx = fmaxf(mx, s); }
    }
    mx = xmax16(mx); mx = xmax32(mx);
    const float mn = fmaxf(G.m, mx); const float alpha = __builtin_amdgcn_exp2f(G.m - mn); G.m = mn;
    float ps = 0.f;
#pragma unroll
    for (int kt = 0; kt < 4; ++kt)
#pragma unroll
        for (int e = 0; e < 4; ++e) { const float pe = __builtin_amdgcn_exp2f(sc[kt][e] - mn); sc[kt][e] = pe; ps += pe; }
    G.l = G.l * alpha + ps;
#pragma unroll
    for (int dt = 0; dt < 4; ++dt) G.o[dt] *= alpha;
#pragma unroll
    for (int ks = 0; ks < 2; ++ks) { uint4 w = {pack2(sc[2 * ks][0], sc[2 * ks][1]), pack2(sc[2 * ks][2], sc[2 * ks][3]), pack2(sc[2 * ks + 1][0], sc[2 * ks + 1][1]), pack2(sc[2 * ks + 1][2], sc[2 * ks + 1][3])};
        pf[ks] = __builtin_bit_cast(bf16x8, w); }
}
DI void attn_tile2(const char* sk, const char* sv, const float* tab, QG& A, QG& B, int qposA, int dlt, int lane) {
    const int q = lane & 15, g = lane >> 4;
    f32x4 sa[4], sb[4];
#pragma unroll
    for (int kt = 0; kt < 4; ++kt) {
        const bf16x8 a0 = *(const bf16x8*)(sk + swz(16 * kt + q, g)); const bf16x8 a1 = *(const bf16x8*)(sk + swz(16 * kt + q, 4 + g));
        f32x4 x = {0.f, 0.f, 0.f, 0.f}, y = {0.f, 0.f, 0.f, 0.f};
        x = __builtin_amdgcn_mfma_f32_16x16x32_bf16(a0, A.q0, x, 0, 0, 0); y = __builtin_amdgcn_mfma_f32_16x16x32_bf16(a0, B.q0, y, 0, 0, 0);
        x = __builtin_amdgcn_mfma_f32_16x16x32_bf16(a1, A.q1, x, 0, 0, 0); y = __builtin_amdgcn_mfma_f32_16x16x32_bf16(a1, B.q1, y, 0, 0, 0);
        sa[kt] = x; sb[kt] = y;
    }
    bf16x8 pa[2], pb[2];
    attn_softmax(sa, tab, A, qposA, dlt, g, pa);
    attn_softmax(sb, tab, B, qposA + 16, dlt, g, pb);
#pragma unroll
    for (int dt = 0; dt < 4; ++dt)
#pragma unroll
        for (int ks = 0; ks < 2; ++ks) {
            const int vr = 32 * ks + 4 * g + (q >> 2); const int col = 16 * dt + 4 * (q & 3);
            const s16x4 lo = tr16(sv + swz(vr, col >> 3) + (col & 7) * 2); const s16x4 hi = tr16(sv + swz(vr + 16, col >> 3) + (col & 7) * 2);
            const bf16x8 vf = {lo[0], lo[1], lo[2], lo[3], hi[0], hi[1], hi[2], hi[3]};
            A.o[dt] = __builtin_amdgcn_mfma_f32_16x16x32_bf16(vf, pa[ks], A.o[dt], 0, 0, 0);
            B.o[dt] = __builtin_amdgcn_mfma_f32_16x16x32_bf16(vf, pb[ks], B.o[dt], 0, 0, 0);
        }
}
DI void attn_block2(const Params& p, int bh, int cp, char* lds) {
    int tid = threadIdx.x; asm volatile("" : "+v"(tid));
    const int lane = tid & 63, wave = __builtin_amdgcn_readfirstlane(tid >> 6);
    const u16* proj = (const u16*)(p.ws + W_PROJ);
    const int b = bh >> 3, h = bh & 7, c0 = 2 * cp, cq = c0 + (wave >> 1);
    const int qposA = (wave & 1) * 32 + (lane & 15); const int qrowA = b * 8192 + cq * 64 + qposA;
    float* tab = (float*)(lds + 49152);
    __syncthreads();
    for (int i = tid; i < 257; i += 256) tab[i] = p.relb[h * 257 + i] * LOG2E;
    QG A, B;
    { const u16* qp = proj + (size_t)qrowA * NC + C_Q + h * 64 + 8 * (lane >> 4); A.q0 = *(const bf16x8*)qp; A.q1 = *(const bf16x8*)(qp + 32);
      const u16* qb = qp + (size_t)16 * NC; B.q0 = *(const bf16x8*)qb; B.q1 = *(const bf16x8*)(qb + 32); }
    A.m = -INFINITY; A.l = 0.f; B.m = -INFINITY; B.l = 0.f;
#pragma unroll
    for (int dt = 0; dt < 4; ++dt) { A.o[dt] = (f32x4){0.f, 0.f, 0.f, 0.f}; B.o[dt] = (f32x4){0.f, 0.f, 0.f, 0.f}; }
    unsigned soff[2];
#pragma unroll
    for (int i = 0; i < 2; ++i) { const int row = 8 * (i * 4 + wave) + (lane >> 3); const int ch = (lane & 7) ^ ((row >> 1) & 7); soff[i] = (unsigned)(row * NC + ch * 8); }
    const u16* kbase = proj + (size_t)(b * 8192) * NC + h * 64;
#define ASTAGE2(buf, kc) do { const u16* kr = kbase + (size_t)((kc) * 64) * NC; _Pragma("unroll") for (int i = 0; i < 2; ++i) { \
        __builtin_amdgcn_global_load_lds((const unsigned*)(kr + soff[i] + C_K), (LAS unsigned*)(lds + (buf) * 8192 + (i * 4 + wave) * 1024), 16, 0, 0); \
        __builtin_amdgcn_global_load_lds((const unsigned*)(kr + soff[i] + C_V), (LAS unsigned*)(lds + 24576 + (buf) * 8192 + (i * 4 + wave) * 1024), 16, 0, 0); } } while (0)
    const int lo = c0 >= 8 ? c0 - 8 : 0, hi = c0 + 1;
    __syncthreads();
    ASTAGE2(0, lo); ASTAGE2(1, lo + 1);
    int buf = 0;
    for (int kc = lo; kc <= hi; ++kc) {
        if (kc < hi) asm volatile("s_waitcnt vmcnt(4) lgkmcnt(0)" ::: "memory"); else asm volatile("s_waitcnt vmcnt(0) lgkmcnt(0)" ::: "memory");
        __builtin_amdgcn_s_barrier();
        asm volatile("" ::: "memory");
        const int nb2 = buf >= 1 ? buf - 1 : 2;
        if (kc + 2 <= hi) ASTAGE2(nb2, kc + 2);
        const int dlt = cq - kc;
        if (dlt >= 0 && dlt <= 8) attn_tile2(lds + buf * 8192, lds + 24576 + buf * 8192, tab, A, B, qposA, dlt, lane);
        buf = buf == 2 ? 0 : buf + 1;
    }
#undef ASTAGE2
    attn_finish(p, A.l, A.o, qrowA, h, lane);
    attn_finish(p, B.l, B.o, qrowA + 16, h, lane);
}

DI void attn_block_sample(const Params& p, int s, char* lds) {
    int tid = threadIdx.x; asm volatile("" : "+v"(tid));
    const int lane = tid & 63, wave = __builtin_amdgcn_readfirstlane(tid >> 6);
    char* wl = lds + wave * 18432;
    char* sk = wl; char* sv = wl + 8192; float* tab = (float*)(wl + 16384);
    const u16* proj = (const u16*)(p.ws + W_PROJ);
    const int b = s >> 3, h = s & 7; const int qrow0 = NTP + b * 16;
    for (int i = lane; i < 257; i += 64) tab[i] = p.relb[h * 257 + i] * LOG2E;
    const int q = lane & 15, g = lane >> 4;
    const u16* qp = proj + (size_t)(qrow0 + q) * NC + C_Q + h * 64 + 8 * g;
    const bf16x8 qf0 = *(const bf16x8*)qp, qf1 = *(const bf16x8*)(qp + 32);
    float m = -INFINITY, l = 0.f; f32x4 o[4];
#pragma unroll
    for (int dt = 0; dt < 4; ++dt) o[dt] = (f32x4){0.f, 0.f, 0.f, 0.f};
    const int lrow = lane >> 3, lch = lane & 7;
    float4 rk[16], rv[16];
#define SLOAD(dl) do { const size_t off_ = ((size_t)(b * 8 + h) * 512 + (8 - (dl)) * 64) * 64 + lrow * 64 + lch * 8; \
        _Pragma("unroll") for (int i = 0; i < 8; ++i) { const float* a_ = p.cache_k + off_ + i * 512; const float* c_ = p.cache_v + off_ + i * 512; \
            rk[2 * i] = ntld4(a_); rk[2 * i + 1] = ntld4(a_ + 4); rv[2 * i] = ntld4(c_); rv[2 * i + 1] = ntld4(c_ + 4); } } while (0)
#define SWRITE() do { _Pragma("unroll") for (int i = 0; i < 8; ++i) { const int row = i * 8 + lrow; \
            uint4 kv = {pack2(rk[2 * i].x, rk[2 * i].y), pack2(rk[2 * i].z, rk[2 * i].w), pack2(rk[2 * i + 1].x, rk[2 * i + 1].y), pack2(rk[2 * i + 1].z, rk[2 * i + 1].w)}; \
            uint4 vv = {pack2(rv[2 * i].x, rv[2 * i].y), pack2(rv[2 * i].z, rv[2 * i].w), pack2(rv[2 * i + 1].x, rv[2 * i + 1].y), pack2(rv[2 * i + 1].z, rv[2 * i + 1].w)}; \
            *(uint4*)(sk + swz(row, lch)) = kv; *(uint4*)(sv + swz(row, lch)) = vv; } } while (0)
    const int d0 = 8 - 2 * wave;
    SLOAD(d0);
    asm volatile("s_waitcnt lgkmcnt(0)" ::: "memory");
    SWRITE();
    SLOAD(d0 - 1);
    asm volatile("s_waitcnt lgkmcnt(0)" ::: "memory");
    attn_tile(sk, sv, tab, qf0, qf1, m, l, o, q, d0, 64, lane);
    asm volatile("s_waitcnt lgkmcnt(0)" ::: "memory");
    SWRITE();
    asm volatile("s_waitcnt lgkmcnt(0)" ::: "memory");
    attn_tile(sk, sv, tab, qf0, qf1, m, l, o, q, d0 - 1, 64, lane);
#undef SLOAD
#undef SWRITE
    if (wave == 3) {
        asm volatile("s_waitcnt lgkmcnt(0)" ::: "memory");
#pragma unroll
        for (int i = 0; i < 8; ++i) { const int row = i * 8 + lrow; uint4 kv = {0, 0, 0, 0}, vv = {0, 0, 0, 0};
            if (row < 16) { const u16* sp = proj + (size_t)(qrow0 + row) * NC + h * 64 + lch * 8; kv = *(const uint4*)(sp + C_K); vv = *(const uint4*)(sp + C_V); }
            *(uint4*)(sk + swz(row, lch)) = kv; *(uint4*)(sv + swz(row, lch)) = vv; }
        asm volatile("s_waitcnt lgkmcnt(0)" ::: "memory");
        attn_tile(sk, sv, tab, qf0, qf1, m, l, o, q, 0, 16, lane);
    }
    l = xadd16(l); l = xadd32(l);
    asm volatile("s_waitcnt lgkmcnt(0)" ::: "memory");
    float* cm = (float*)wl; float* cl = cm + 16; float* co = cm + 32;
    if (g == 0) { cm[q] = m; cl[q] = l; }
#pragma unroll
    for (int dt = 0; dt < 4; ++dt) *(f32x4*)(co + q * 64 + 16 * dt + 4 * g) = o[dt];
    __syncthreads();
    {
        float mw[4], M = -INFINITY;
#pragma unroll
        for (int w = 0; w < 4; ++w) { mw[w] = ((const float*)(lds + w * 18432))[q]; M = fmaxf(M, mw[w]); }
        float L = 0.f; f32x4 O = {0.f, 0.f, 0.f, 0.f};
#pragma unroll
        for (int w = 0; w < 4; ++w) { const float* base = (const float*)(lds + w * 18432); const float f = __builtin_amdgcn_exp2f(mw[w] - M);
            L += base[16 + q] * f; const f32x4 ov = *(const f32x4*)(base + 32 + q * 64 + 16 * wave + 4 * g); O += ov * f; }
        const float inv = rcpf_(L); const int qrow = qrow0 + q; const int d = 16 * wave + 4 * g;
        const uint2 gg = *(const uint2*)(proj + (size_t)qrow * NC + C_GA + h * 64 + d);
        uint2 w2; w2.x = pack2(O[0] * inv * silu(bflo(gg.x)), O[1] * inv * silu(bfhi(gg.x))); w2.y = pack2(O[2] * inv * silu(bflo(gg.y)), O[3] * inv * silu(bfhi(gg.y)));
        *(uint2*)((u16*)(p.ws + W_XB) + (size_t)qrow * DM + h * 64 + d) = w2;
    }
    __syncthreads();
}

DI void phase_scan_attn(const Params& p, char* lds) {
    const int tid = threadIdx.x, lane = tid & 63, wave = __builtin_amdgcn_readfirstlane(tid >> 6);
    if (blockIdx.x < 64) {
        if (wave == 0) { const int x_ = blockIdx.x & 7, k_ = blockIdx.x >> 3;
            scan_item(p, (x_ + 8 * (k_ >> 2)) * 4 + (k_ & 3), lane); }
        return;
    }
    unsigned* ctr = (unsigned*)(p.ws + W_BAR) + 3456;
    volatile LAS int* slot = (volatile LAS int*)(lds + 75264);
    const int q0 = (int)((unsigned)__builtin_amdgcn_s_getreg((3 << 11) | 20) & 7u);
    for (int v = 0; v < 8; ++v) {
        const int q = (q0 + v) & 7;
        for (;;) {
            __syncthreads();
            if (tid == 0) *slot = (int)__hip_atomic_fetch_add(ctr + 16 * q, 1u, __ATOMIC_RELAXED, __HIP_MEMORY_SCOPE_AGENT);
            __syncthreads();
            const int item = *slot;
            if (item >= 32 + 128 + 32) break;
            if (item < 32) attn_block_sample(p, 32 * q + item, lds);
            else if (item < 160) { const int j = item - 32; attn_block2(p, 2 * q + (j & 1), 63 - (j >> 1), lds); }
            else scan_item(p, 64 + (32 * q + item - 160) * 4 + wave, lane);
        }
    }
}

DI void phase_rwkv_out(const Params& p, char* lds) {
    const int tid = threadIdx.x, lane = tid & 63, wave = tid >> 6;
    float* pw = (float*)(lds + wave * 1024);
    const int gw = blockIdx.x * 4 + wave, nw = gridDim.x * 4;
    const int i16 = lane & 15, g = lane >> 4;
    const u16* proj = (const u16*)(p.ws + W_PROJ); const u16* QT = (const u16*)(p.ws + W_QT); const u16* SST = (const u16*)(p.ws + W_SST);
    const float* bonus = (const float*)(p.ws + W_BONUS);
    for (int wu = gw; wu < 8192 + 256; wu += nw) {
        int u, tg, b, h, c = 0, row0; bool prm = wu < 8192;
        if (prm) { u = wu >> 2; tg = wu & 3; b = u >> 10; h = (u >> 7) & 7; c = u & 127; row0 = b * 8192 + c * 64; }
        else { const int s = wu - 8192; u = 2048 + s; tg = 0; b = s >> 3; h = s & 7; row0 = NTP + b * 16; }
        const int t = 16 * tg + i16; const int row = row0 + t;
        u16* z = (u16*)(p.ws + W_XB) + (size_t)row * DM + 512 + h * 64;
        const u16* qt = QT + (size_t)u * 4096 + t * 64 + 8 * g; const bf16x8 bq0 = *(const bf16x8*)qt, bq1 = *(const bf16x8*)(qt + 32);
        { const float a_ = p.mix[1024 + h * 64 + lane], b_ = p.gn_g[h * 64 + lane], c_ = p.gn_b[h * 64 + lane];
            asm volatile("s_waitcnt lgkmcnt(0)" ::: "memory"); pw[lane] = a_; pw[64 + lane] = b_; pw[128 + lane] = c_; asm volatile("s_waitcnt lgkmcnt(0)" ::: "memory"); }
        const int wofs = 16 * (g & 1) + 8 * (g >> 1);
        const int mode = t > 0 ? 0 : (prm ? (c > 0 ? 0 : 1) : 2);
        uint2 ylw[4], cvw[4], grw[4], pvw[4];
        { const u16* pr_ = proj + (size_t)row * NC + h * 64 + wofs; const u16* pp_ = proj + (size_t)(mode == 0 ? row - 1 : row) * NC + C_RV + h * 64 + wofs;
#pragma unroll
            for (int mp = 0; mp < 2; ++mp) {
                unwiden16(*(const uint4*)(z + 32 * mp + wofs), ylw[2 * mp], ylw[2 * mp + 1]);
                unwiden16(*(const uint4*)(pr_ + C_RV + 32 * mp), cvw[2 * mp], cvw[2 * mp + 1]);
                unwiden16(*(const uint4*)(pr_ + C_GR + 32 * mp), grw[2 * mp], grw[2 * mp + 1]);
                unwiden16(*(const uint4*)(pp_ + 32 * mp), pvw[2 * mp], pvw[2 * mp + 1]); } }
        f32x4 y[4];
#pragma unroll
        for (int mt = 0; mt < 4; ++mt) {
            const uint2 yl = ylw[mt]; f32x4 a = {bflo(yl.x), bfhi(yl.x), bflo(yl.y), bfhi(yl.y)};
            const u16* sp = SST + (size_t)u * 4096 + (16 * mt + i16) * 64 + 8 * g;
            a = __builtin_amdgcn_mfma_f32_16x16x32_bf16(*(const bf16x8*)sp, bq0, a, 0, 0, 0); a = __builtin_amdgcn_mfma_f32_16x16x32_bf16(*(const bf16x8*)(sp + 32), bq1, a, 0, 0, 0);
            y[mt] = a;
        }
        float s1 = 0.f;
#pragma unroll
        for (int mt = 0; mt < 4; ++mt) s1 += (y[mt][0] + y[mt][1]) + (y[mt][2] + y[mt][3]);
        s1 = xadd16(s1); s1 = xadd32(s1);
        const float mu = s1 * (1.f / 64.f); float s2 = 0.f;
#pragma unroll
        for (int mt = 0; mt < 4; ++mt)
#pragma unroll
            for (int e = 0; e < 4; ++e) { const float d = y[mt][e] - mu; s2 += d * d; }
        s2 = xadd16(s2); s2 = xadd32(s2);
        const float rs = __builtin_amdgcn_rsqf(s2 * (1.f / 64.f) + 64e-5f);
        const float bon = bonus[(size_t)u * 64 + t];
        uint2 wz[4];
#pragma unroll
        for (int mt = 0; mt < 4; ++mt) {
            const int i0 = 16 * mt + 4 * g; const int hj = h * 64 + i0;
            const uint2 cvp = cvw[mt]; const float cv[4] = {bflo(cvp.x), bfhi(cvp.x), bflo(cvp.y), bfhi(cvp.y)};
            float pv[4];
            if (mode == 0) { const uint2 w = pvw[mt]; pv[0] = bflo(w.x); pv[1] = bfhi(w.x); pv[2] = bflo(w.y); pv[3] = bfhi(w.y); }
            else if (mode == 1) { pv[0] = pv[1] = pv[2] = pv[3] = 0.f; }
            else { const float4 w = *(const float4*)(p.st_shift + (size_t)b * 1664 + 1024 + hj); pv[0] = w.x; pv[1] = w.y; pv[2] = w.z; pv[3] = w.w; }
            const float4 mv = *(const float4*)(pw + i0), gg = *(const float4*)(pw + 64 + i0), gb = *(const float4*)(pw + 128 + i0);
            const float mvv[4] = {mv.x, mv.y, mv.z, mv.w}, ggv[4] = {gg.x, gg.y, gg.z, gg.w}, gbv[4] = {gb.x, gb.y, gb.z, gb.w};
            const uint2 grp = grw[mt]; const float gr[4] = {bflo(grp.x), bfhi(grp.x), bflo(grp.y), bfhi(grp.y)};
            float ov[4];
#pragma unroll
            for (int e = 0; e < 4; ++e) { const float xv = cv[e] + (pv[e] - cv[e]) * mvv[e]; const float yn = (y[mt][e] - mu) * rs * ggv[e] + gbv[e] + bon * xv; ov[e] = yn * silu(gr[e]); }
            wz[mt].x = pack2(ov[0], ov[1]); wz[mt].y = pack2(ov[2], ov[3]);
        }
#pragma unroll
        for (int mt = 0; mt < 4; mt += 2) *(uint4*)(z + 16 * (mt + (g & 1)) + 8 * (g >> 1)) = widen16(wz[mt], wz[mt + 1]);
    }
}


#define XB_TMO      128
#define XB_XCNT(j)  (256  + 64 * (j))
#define XB_XSUB(j)  (1280 + 64 * (j))
#define XB_XGEN(j)  (2304 + 64 * (j))
#define XB_TOP      3328
#define XB_TOPGEN   3392
#define XCD_BAR_WORDS 3456
#define XB_SPIN_CAP (1u << 18)
DI unsigned xb_ld(unsigned* p) { return __hip_atomic_load(p, __ATOMIC_RELAXED, __HIP_MEMORY_SCOPE_AGENT); }
DI unsigned xb_add(unsigned* p, unsigned v) { return __hip_atomic_fetch_add(p, v, __ATOMIC_RELAXED, __HIP_MEMORY_SCOPE_AGENT); }
DI unsigned xb_xcc_id() { return (unsigned)__builtin_amdgcn_s_getreg((3 << 11) | 20) & 0xFu; }
#define XB_SPIN(cond, bar) do { unsigned _sp = 0; while (cond) { __builtin_amdgcn_s_sleep(2); \
    if ((++_sp & 255u) == 0u) { if (xb_ld(&(bar)[XB_TMO])) break; if (_sp > XB_SPIN_CAP) { atomicAdd(&(bar)[XB_TMO], 1u); break; } } } } while (0)
struct XcdBarrier { unsigned* bar; unsigned x; volatile LAS unsigned* st; };
DI XcdBarrier xcd_barrier_post(unsigned* bar, volatile LAS unsigned* st) {
    XcdBarrier b; b.bar = bar; b.x = xb_xcc_id(); b.st = st;
    if (threadIdx.x == 0) (void)xb_add(&bar[XB_XCNT(b.x)], 1u);
    return b;
}
DI void xcd_barrier_complete(unsigned* bar, unsigned x, unsigned& nloc, unsigned& nx) {
    const unsigned G = gridDim.x * gridDim.y * gridDim.z;
    unsigned sum, cnt, mine, sp = 0u;
    for (;;) {
        sum = 0u; cnt = 0u; mine = 0u;
#pragma unroll
        for (unsigned j = 0; j < 16; ++j) { const unsigned c = xb_ld(&bar[XB_XCNT(j)]); sum += c; cnt += (c > 0u) ? 1u : 0u; mine = (j == x) ? c : mine; }
        if (sum == G) break;
        __builtin_amdgcn_s_sleep(1);
        if ((++sp & 255u) == 0u) { if (xb_ld(&bar[XB_TMO])) break; if (sp > XB_SPIN_CAP) { atomicAdd(&bar[XB_TMO], 1u); break; } }
    }
    nloc = mine > 0u ? mine : 1u; nx = cnt > 0u ? cnt : 1u;
}
DI void xcd_barrier(const XcdBarrier& b) {
    asm volatile("s_waitcnt vmcnt(0)" ::: "memory");
    __syncthreads();
    if (threadIdx.x == 0) {
        unsigned* bar = b.bar;
        __builtin_amdgcn_s_waitcnt(0);
        unsigned nloc = b.st[0], nx = b.st[1];
        if (nloc == 0u) { xcd_barrier_complete(bar, b.x, nloc, nx); b.st[0] = nloc; b.st[1] = nx; }
        const unsigned old = xb_add(&bar[XB_XSUB(b.x)], 1u);
        const unsigned gen = old / nloc;
        if (old + 1u == (gen + 1u) * nloc) {
            __builtin_amdgcn_fence(__ATOMIC_RELEASE, "agent");
            asm volatile("s_waitcnt vmcnt(0)" ::: "memory");
            const unsigned og = xb_add(&bar[XB_TOP], 1u);
            const unsigned tg = og / nx;
            if (og + 1u == (tg + 1u) * nx) xb_add(&bar[XB_TOPGEN], 1u);
            else XB_SPIN(xb_ld(&bar[XB_TOPGEN]) == tg, bar);
            __builtin_amdgcn_fence(__ATOMIC_ACQUIRE, "agent");
            xb_add(&bar[XB_XGEN(b.x)], 1u);
            asm volatile("s_waitcnt vmcnt(0)" ::: "memory");
        } else {
            XB_SPIN(xb_ld(&bar[XB_XGEN(b.x)]) == gen, bar);
            __builtin_amdgcn_fence(__ATOMIC_ACQUIRE, "agent");
            asm volatile("s_waitcnt vmcnt(0)" ::: "memory");
        }
    }
    __syncthreads();
}

DI void run_phase(const Params& p, char* lds, int ph) {
    if (ph == 0) phase_prep(p, lds);
    else if (ph == 1) { Epi1 e{&p}; gemm_phase((const u16*)(p.ws + W_XB), (const u16*)(p.ws + W_WINT), 132, 33, lds, e); }
    else if (ph == 2) phase_rwkv_prep(p, lds);
    else if (ph == 3) phase_scan_attn(p, lds);
    else if (ph == 4) phase_rwkv_out(p, lds);
    else gemm_out(p, lds);
}

extern "C" __global__ void __launch_bounds__(256, 2) hymba_mega(Params p, int ph_lo, int ph_hi) {
    extern __shared__ __attribute__((aligned(16))) char lds[];
#if ONE_LAUNCH
    volatile LAS unsigned* st = (volatile LAS unsigned*)(lds + 75520);
    if (threadIdx.x == 0) { st[0] = 0u; st[1] = 0u; st[2] = 0u; st[3] = 0u; }
    __syncthreads();
    const XcdBarrier xb = xcd_barrier_post((unsigned*)(p.ws + W_BAR), st);
#ifndef PROBE_REP
#define PROBE_REP -1
#endif
#define RUNP(k) do { run_phase(p, lds, k); if (PROBE_REP == k) { xcd_barrier(xb); run_phase(p, lds, k); } } while (0)
    RUNP(0); xcd_barrier(xb);
    RUNP(1); xcd_barrier(xb);
    RUNP(2); xcd_barrier(xb);
    RUNP(3); xcd_barrier(xb);
    run_phase(p, lds, 4); xcd_barrier(xb);
    RUNP(5);
#else
    run_phase(p, lds, ph_lo);
#endif
}

extern "C" void kernel_launch(void* const* d_in, const int* in_sizes, int n_in, void* d_out, int out_size, void* d_ws, size_t ws_size, hipStream_t stream) {
    Params p{};
    const float** f = (const float**)&p;
    for (int i = 0; i < 22; ++i) f[i] = (const float*)d_in[i];
    p.out = (float*)d_out; p.ws = (char*)d_ws;
    static int grid_blocks = 0;
    if (!grid_blocks) {
        hipFuncSetAttribute((const void*)hymba_mega, hipFuncAttributeMaxDynamicSharedMemorySize, LDS_BYTES);
        int dev = 0, cus = 0, per_cu = 0;
        hipGetDevice(&dev);
        hipDeviceGetAttribute(&cus, hipDeviceAttributeMultiprocessorCount, dev);
        hipOccupancyMaxActiveBlocksPerMultiprocessor(&per_cu, hymba_mega, 256, LDS_BYTES);
        if (per_cu > 2) per_cu = 2;
        if (per_cu < 1) per_cu = 1;
        grid_blocks = cus * per_cu;
    }
#if ONE_LAUNCH
    int lo = 0, hi = 5;
    (void)hipMemsetAsync((char*)d_ws + W_BAR, 0, (XCD_BAR_WORDS + 128) * 4, stream);
    void* args[] = {&p, &lo, &hi};
    hipError_t e = hipLaunchCooperativeKernel((void*)hymba_mega, dim3(grid_blocks), dim3(256), args, LDS_BYTES, stream);
    if (e != hipSuccess) fprintf(stderr, "cooperative launch failed: %s (grid %d)\n", hipGetErrorString(e), grid_blocks);
#else
    for (int ph = 0; ph < 6; ++ph) hipLaunchKernelGGL(hymba_mega, dim3(grid_blocks), dim3(256), LDS_BYTES, stream, p, ph, ph);
#endif
}
```

```cpp
#include <hip/hip_runtime.h>
#include <hip/hip_cooperative_groups.h>
#include <cstdio>
#include <cstdint>
namespace cg = cooperative_groups;

#ifndef ONE_LAUNCH
#define ONE_LAUNCH 1
#endif

#define DI __device__ __forceinline__
#define LAS __attribute__((address_space(3)))
typedef unsigned short u16;
typedef short bf16x8 __attribute__((ext_vector_type(8)));
typedef short s16x4 __attribute__((ext_vector_type(4)));
typedef float f32x4 __attribute__((ext_vector_type(4)));
typedef float f32x16 __attribute__((ext_vector_type(16)));
typedef float f32x2_t __attribute__((ext_vector_type(2)));
typedef __bf16 bf16x2_t __attribute__((ext_vector_type(2)));
typedef __attribute__((address_space(3))) s16x4 lds_s16x4;

constexpr int DM = 1024, NC = 4224, NTP = 16384, NTS = 512, NTOK = 16896;
constexpr int C_Q = 0, C_K = 512, C_V = 1024, C_GA = 1536, C_R = 2048, C_RK = 2560, C_RV = 3072, C_WD = 3584, C_AD = 3648, C_GR = 3712;
constexpr int NUNIT = 2304;
constexpr size_t O_YP = 0, O_YS = 16777216, O_KP = 17301504, O_VP = 17825792, O_KS = 18350080, O_VS = 18612224,
                 O_SP = 18874368, O_SS = 18939904, O_SHP = 19988480, O_SHS = 19991808;
constexpr size_t W_XB = 0, W_WINT = 34603008, W_WOUTT = 43253760, W_WUPT = 45350912, W_AUPT = 45416448, W_RSTD = 45481984,
                 W_BONUS = 264339456  , W_PROJ = 46090240, W_GT = 188827648, W_HH = 207702016, W_QT = 226576384, W_SST = 245450752, W_BAR = 264325120;
constexpr int LDS_BYTES = 75776;
constexpr float LOG2E = 1.4426950408889634f;

struct Params {
    const float *x_p, *x_s, *cache_k, *cache_v, *st_wkv, *st_shift, *norm_g, *w_in, *q_g, *k_g, *relb, *mix, *w0, *w_up, *a0, *a_up,
        *k_k, *k_a, *r_k, *gn_g, *gn_b, *w_out;
    float* out;
    char* ws;
};

DI unsigned pack2(float lo, float hi) { f32x2_t v = {lo, hi}; bf16x2_t b = __builtin_convertvector(v, bf16x2_t); return __builtin_bit_cast(unsigned, b); }
DI u16 f2bf(float f) { return (u16)(pack2(f, 0.f) & 0xffffu); }
DI float bflo(unsigned u) { return __uint_as_float(u << 16); }
DI float bfhi(unsigned u) { return __uint_as_float(u & 0xffff0000u); }
DI float bf2f(u16 h) { return __uint_as_float((unsigned)h << 16); }
DI float4 ntld4(const float* p) { const f32x4 v = __builtin_nontemporal_load((const f32x4*)p); return (float4){v[0], v[1], v[2], v[3]}; }
DI int swz(int row, int ch) { return row * 128 + ((ch ^ ((row >> 1) & 7)) << 4); }
DI float dpp_add(float v, const int ctrl_sel) {
    int x = __float_as_int(v), y;
    if (ctrl_sel == 0) y = __builtin_amdgcn_update_dpp(0, x, 0xB1, 0xf, 0xf, true);
    else if (ctrl_sel == 1) y = __builtin_amdgcn_update_dpp(0, x, 0x4E, 0xf, 0xf, true);
    else if (ctrl_sel == 2) y = __builtin_amdgcn_update_dpp(0, x, 0x141, 0xf, 0xf, true);
    else y = __builtin_amdgcn_update_dpp(0, x, 0x140, 0xf, 0xf, true);
    return v + __int_as_float(y);
}
DI float wave_sum(float v) {
    v = dpp_add(v, 0); v = dpp_add(v, 1); v = dpp_add(v, 2); v = dpp_add(v, 3);
    const int x = __float_as_int(v);
    const float a = __int_as_float(__builtin_amdgcn_readlane(x, 0)), b = __int_as_float(__builtin_amdgcn_readlane(x, 16)),
                c = __int_as_float(__builtin_amdgcn_readlane(x, 32)), d = __int_as_float(__builtin_amdgcn_readlane(x, 48));
    return (a + b) + (c + d);
}
DI float rcpf_(float x) { return __builtin_amdgcn_rcpf(x); }
DI float silu(float x) { return x * rcpf_(1.f + __expf(-x)); }
DI float xadd16(float v) { const unsigned x = __float_as_uint(v); auto r = __builtin_amdgcn_permlane16_swap(x, x, false, false); return __uint_as_float(r[0]) + __uint_as_float(r[1]); }
DI float xadd32(float v) { const unsigned x = __float_as_uint(v); auto r = __builtin_amdgcn_permlane32_swap(x, x, false, false); return __uint_as_float(r[0]) + __uint_as_float(r[1]); }
DI float xmax16(float v) { const unsigned x = __float_as_uint(v); auto r = __builtin_amdgcn_permlane16_swap(x, x, false, false); return fmaxf(__uint_as_float(r[0]), __uint_as_float(r[1])); }
DI uint4 widen16(uint2 w0, uint2 w1) {
    auto rx = __builtin_amdgcn_permlane16_swap(w0.x, w1.x, false, false); auto ry = __builtin_amdgcn_permlane16_swap(w0.y, w1.y, false, false);
    return (uint4){rx[0], ry[0], rx[1], ry[1]};
}
DI void unwiden16(uint4 L, uint2& w0, uint2& w1) {
    auto rx = __builtin_amdgcn_permlane16_swap(L.x, L.z, false, false); auto ry = __builtin_amdgcn_permlane16_swap(L.y, L.w, false, false);
    w0 = (uint2){rx[0], ry[0]}; w1 = (uint2){rx[1], ry[1]};
}
DI float xmax32(float v) { const unsigned x = __float_as_uint(v); auto r = __builtin_amdgcn_permlane32_swap(x, x, false, false); return fmaxf(__uint_as_float(r[0]), __uint_as_float(r[1])); }
DI void unpack8(uint4 u, float* o) {
    o[0] = bflo(u.x); o[1] = bfhi(u.x); o[2] = bflo(u.y); o[3] = bfhi(u.y); o[4] = bflo(u.z); o[5] = bfhi(u.z); o[6] = bflo(u.w); o[7] = bfhi(u.w);
}

DI void transpose_tile(const float* W, int K, int N, const float* gain, u16* dst, float* tile, int t) {
    const int nkt = K / 64; const int kt = t % nkt, nt = t / nkt; const int k0 = kt * 64, n0 = nt * 64;
    const int tid = threadIdx.x, lane = tid & 63, wave = tid >> 6;
    float4 wv[4];
#pragma unroll
    for (int i = 0; i < 4; ++i) { const int idx = tid + 256 * i; wv[i] = ntld4(W + (size_t)(k0 + (idx >> 4)) * N + n0 + 4 * (idx & 15)); }
    const float gl = gain ? gain[k0 + lane] : 1.f;
#pragma unroll
    for (int i = 0; i < 4; ++i) { const int kr = 16 * i + 4 * wave + (lane >> 4);
        const float g = __shfl(gl, kr); float* tp = tile + kr * 65 + 4 * (lane & 15);
        tp[0] = wv[i].x * g; tp[1] = wv[i].y * g; tp[2] = wv[i].z * g; tp[3] = wv[i].w * g; }
    __syncthreads();
#pragma unroll 4
    for (int i = 0; i < 8; ++i) { const int n = i * 8 + (tid >> 5); const int kp = tid & 31;
        const unsigned v = pack2(tile[(2 * kp) * 65 + n], tile[(2 * kp + 1) * 65 + n]); *(unsigned*)(dst + (size_t)(n0 + n) * K + k0 + 2 * kp) = v; }
    __syncthreads();
}
DI void phase_prep(const Params& p, char* lds) {
    const int tid = threadIdx.x, lane = tid & 63, wave = tid >> 6;
    u16* xb = (u16*)(p.ws + W_XB); float* rstd = (float*)(p.ws + W_RSTD);
    for (int rg = blockIdx.x * 4 + wave; rg < NTOK / 4; rg += gridDim.x * 4) {
        float4 v[4][4]; float ss[4];
#pragma unroll
        for (int k = 0; k < 4; ++k) { const int row = rg * 4 + k; const float* src = row < NTP ? p.x_p + (size_t)row * DM : p.x_s + (size_t)(row - NTP) * DM;
#pragma unroll
            for (int i = 0; i < 4; ++i) v[k][i] = ((const float4*)src)[i * 64 + lane]; }
#pragma unroll
        for (int k = 0; k < 4; ++k) { float a = 0.f;
#pragma unroll
            for (int i = 0; i < 4; ++i) a += v[k][i].x * v[k][i].x + v[k][i].y * v[k][i].y + v[k][i].z * v[k][i].z + v[k][i].w * v[k][i].w;
            ss[k] = wave_sum(a); }
#pragma unroll
        for (int k = 0; k < 4; ++k) { const int row = rg * 4 + k;
            if (lane == 0) rstd[row] = rsqrtf(ss[k] * (1.f / 1024.f) + 1e-6f);
#pragma unroll
            for (int i = 0; i < 4; ++i) { uint2 w; w.x = pack2(v[k][i].x, v[k][i].y); w.y = pack2(v[k][i].z, v[k][i].w); *(uint2*)(xb + (size_t)row * DM + (i * 64 + lane) * 4) = w; } }
    }
    float* tile = (float*)lds;
    for (int t = blockIdx.x; t < 1056 + 256 + 16; t += gridDim.x) {
        if (t < 1056) transpose_tile(p.w_in, 1024, NC, p.norm_g, (u16*)(p.ws + W_WINT), tile, t);
        else if (t < 1312) transpose_tile(p.w_out, 1024, 1024, nullptr, (u16*)(p.ws + W_WOUTT), tile, t - 1056);
        else if (t < 1320) transpose_tile(p.w_up, 64, 512, nullptr, (u16*)(p.ws + W_WUPT), tile, t - 1312);
        else transpose_tile(p.a_up, 64, 512, nullptr, (u16*)(p.ws + W_AUPT), tile, t - 1320);
    }
}

template <class Epi>
DI void gemm_phase(const u16* __restrict__ A, const u16* __restrict__ B, int mtiles, int ntiles, char* lds, const Epi& epi) {
    const int ntile = mtiles * ntiles;
    const int vb = (blockIdx.x & 7) * (gridDim.x >> 3) + (blockIdx.x >> 3);
    const int npan = ntiles >> 3;
    int tile = vb; if (tile >= ntile) return;
#define TILE_MN(t, M0, N0) do { int pan_ = (t) / (mtiles * 8); if (pan_ >= npan) pan_ = npan - 1; const int pw_ = (pan_ == npan - 1) ? ntiles - 8 * pan_ : 8; const int loc_ = (t) - pan_ * mtiles * 8; \
        M0 = (loc_ / pw_) * 128; N0 = (8 * pan_ + loc_ % pw_) * 128; } while (0)
#define GSTAGE(buf, kt, GA, GB) do { _Pragma("unroll") for (int i = 0; i < 4; ++i) { \
            __builtin_amdgcn_global_load_lds((const unsigned*)((GA) + soff[i] + (kt) * 64), (LAS unsigned*)(lds + (buf) * 32768 + (i * 4 + wave) * 1024), 16, 0, 0); \
            __builtin_amdgcn_global_load_lds((const unsigned*)((GB) + soff[i] + (kt) * 64), (LAS unsigned*)(lds + (buf) * 32768 + 16384 + (i * 4 + wave) * 1024), 16, 0, 0); } } while (0)
    int m0, n0; TILE_MN(tile, m0, n0);
    {
        const int lane = threadIdx.x & 63, wave = __builtin_amdgcn_readfirstlane(threadIdx.x >> 6);
        unsigned soff[4];
#pragma unroll
        for (int i = 0; i < 4; ++i) { const int row = 8 * (i * 4 + wave) + (lane >> 3); const int ch = (lane & 7) ^ ((row >> 1) & 7); soff[i] = (unsigned)(row * 1024 + ch * 8); }
        GSTAGE(0, 0, A + (size_t)m0 * 1024, B + (size_t)n0 * 1024);
    }
    for (;;) {
        int tid = threadIdx.x; asm volatile("" : "+v"(tid));
        const int lane = tid & 63, wave = __builtin_amdgcn_readfirstlane(tid >> 6); const int wn = wave >> 1, wm = wave & 1; const int r = lane & 31, h = lane >> 5;
        f32x16 acc[2][2];
#pragma unroll
        for (int a = 0; a < 2; ++a)
#pragma unroll
            for (int b = 0; b < 2; ++b)
#pragma unroll
                for (int e = 0; e < 16; ++e) acc[a][b][e] = 0.f;
        unsigned soff[4];
#pragma unroll
        for (int i = 0; i < 4; ++i) { const int row = 8 * (i * 4 + wave) + (lane >> 3); const int ch = (lane & 7) ^ ((row >> 1) & 7); soff[i] = (unsigned)(row * 1024 + ch * 8); }
        const u16* ga = A + (size_t)m0 * 1024; const u16* gb = B + (size_t)n0 * 1024;
        __syncthreads();
        for (int kt = 0; kt < 16; ++kt) {
            if (kt + 1 < 16) GSTAGE((kt + 1) & 1, kt + 1, ga, gb);
            const char* sa = lds + (kt & 1) * 32768; const char* sb = sa + 16384;
#pragma unroll
            for (int ks = 0; ks < 4; ++ks) {
                bf16x8 fw[2], fx[2];
#pragma unroll
                for (int ct = 0; ct < 2; ++ct) fw[ct] = *(const bf16x8*)(sb + swz(wn * 64 + ct * 32 + r, 2 * ks + h));
#pragma unroll
                for (int tt = 0; tt < 2; ++tt) fx[tt] = *(const bf16x8*)(sa + swz(wm * 64 + tt * 32 + r, 2 * ks + h));
#pragma unroll
                for (int ct = 0; ct < 2; ++ct)
#pragma unroll
                    for (int tt = 0; tt < 2; ++tt) acc[ct][tt] = __builtin_amdgcn_mfma_f32_32x32x16_bf16(fw[ct], fx[tt], acc[ct][tt], 0, 0, 0);
            }
            __syncthreads();
        }
        const int nxt = tile + (int)gridDim.x; int m1 = 0, n1 = 0;
        if (nxt < ntile) { TILE_MN(nxt, m1, n1); GSTAGE(0, 0, A + (size_t)m1 * 1024, B + (size_t)n1 * 1024); }
        epi(acc, m0 + wm * 64, n0 + wn * 64, lane);
        if (nxt >= ntile) break;
        tile = nxt; m0 = m1; n0 = n1;
    }
#undef GSTAGE
#undef TILE_MN
}

struct Epi1 {
    const Params* p;
    DI void operator()(f32x16 (&acc)[2][2], int mrow0, int ncol0, int lane) const {
        const int r = lane & 31, h = lane >> 5; const int cb = ncol0 >> 6;
        u16* proj = (u16*)(p->ws + W_PROJ); const float* rstd = (const float*)(p->ws + W_RSTD); float* out = p->out;
#pragma unroll
        for (int tt = 0; tt < 2; ++tt) {
            const int row = mrow0 + tt * 32 + r; const float rs = rstd[row];
            float v[2][16];
#pragma unroll
            for (int ct = 0; ct < 2; ++ct)
#pragma unroll
                for (int e = 0; e < 16; ++e) v[ct][e] = acc[ct][tt][e] * rs;
            if (cb < 16) {
                float ss = 0.f;
#pragma unroll
                for (int ct = 0; ct < 2; ++ct)
#pragma unroll
                    for (int e = 0; e < 16; ++e) ss += v[ct][e] * v[ct][e];
                ss = xadd32(ss);
                const float inv = __builtin_amdgcn_rsqf(ss * (1.f / 64.f) + 1e-6f);
                const float* g = cb < 8 ? p->q_g : p->k_g;
#pragma unroll
                for (int ct = 0; ct < 2; ++ct)
#pragma unroll
                    for (int gq = 0; gq < 4; ++gq) { const float4 gg = *(const float4*)(g + ct * 32 + 8 * gq + 4 * h);
                        v[ct][4 * gq] *= inv * gg.x; v[ct][4 * gq + 1] *= inv * gg.y; v[ct][4 * gq + 2] *= inv * gg.z; v[ct][4 * gq + 3] *= inv * gg.w; }
            }
#pragma unroll
            for (int ct = 0; ct < 2; ++ct)
#pragma unroll
                for (int gq = 0; gq < 4; gq += 2) {
                    unsigned ax = pack2(v[ct][4 * gq], v[ct][4 * gq + 1]), ay = pack2(v[ct][4 * gq + 2], v[ct][4 * gq + 3]);
                    unsigned bx = pack2(v[ct][4 * gq + 4], v[ct][4 * gq + 5]), by = pack2(v[ct][4 * gq + 6], v[ct][4 * gq + 7]);
                    { auto rr = __builtin_amdgcn_permlane32_swap(ax, bx, false, false); ax = rr[0]; bx = rr[1]; }
                    { auto rr = __builtin_amdgcn_permlane32_swap(ay, by, false, false); ay = rr[0]; by = rr[1]; }
                    *(uint4*)(proj + (size_t)row * NC + ncol0 + ct * 32 + 8 * gq + 8 * h) = (uint4){ax, ay, bx, by};
                }
            float* dst = nullptr;
            if (cb >= 8 && cb < 24) {
                const int hh = cb & 7;
                if (row < NTP) { const int b = row >> 13, t = row & 8191; if (t >= 7680) dst = out + (cb < 16 ? O_KP : O_VP) + ((size_t)(b * 8 + hh) * 512 + (t - 7680)) * 64; }
                else { const int s = row - NTP; const int b = s >> 4, t = s & 15; dst = out + (cb < 16 ? O_KS : O_VS) + ((size_t)(b * 8 + hh) * 16 + t) * 64; }
            } else if (cb >= 32 && cb < 58) {
                if (row < NTP) { if ((row & 8191) == 8191) dst = out + O_SHP + (size_t)(row >> 13) * 1664 + (cb - 32) * 64; }
                else { const int s = row - NTP; if ((s & 15) == 15) dst = out + O_SHS + (size_t)(s >> 4) * 1664 + (cb - 32) * 64; }
            }
            if (dst) {
#pragma unroll
                for (int ct = 0; ct < 2; ++ct)
#pragma unroll
                    for (int gq = 0; gq < 4; ++gq) { float4 w = {v[ct][4 * gq], v[ct][4 * gq + 1], v[ct][4 * gq + 2], v[ct][4 * gq + 3]}; *(float4*)(dst + ct * 32 + 8 * gq + 4 * h) = w; }
            }
        }
    }
};
struct Epi2 {
    const Params* p;
    DI void operator()(f32x16 (&acc)[2][2], int mrow0, int ncol0, int lane) const {
        const int r = lane & 31, h = lane >> 5;
#pragma unroll
        for (int tt = 0; tt < 2; ++tt) {
            const int row = mrow0 + tt * 32 + r;
            const float* xr = row < NTP ? p->x_p + (size_t)row * DM : p->x_s + (size_t)(row - NTP) * DM;
            float* o = p->out + (size_t)row * DM;
#pragma unroll
            for (int ct = 0; ct < 2; ++ct)
#pragma unroll
                for (int gq = 0; gq < 4; ++gq) { const int col = ncol0 + ct * 32 + 8 * gq + 4 * h; const float4 xv = *(const float4*)(xr + col);
                    float4 w = {xv.x + acc[ct][tt][4 * gq], xv.y + acc[ct][tt][4 * gq + 1], xv.z + acc[ct][tt][4 * gq + 2], xv.w + acc[ct][tt][4 * gq + 3]}; *(float4*)(o + col) = w; }
        }
    }
};

DI void gemm_out(const Params& p, char* lds) {
    const u16* __restrict__ A = (const u16*)(p.ws + W_XB); const u16* __restrict__ B = (const u16*)(p.ws + W_WOUTT);
    const int ntile = 176 * 8;
    const int vb = (blockIdx.x & 7) * (gridDim.x >> 3) + (blockIdx.x >> 3);
    for (int tile = vb; tile < ntile; tile += gridDim.x) {
        int tid = threadIdx.x; asm volatile("" : "+v"(tid));
        const int lane = tid & 63, wave = __builtin_amdgcn_readfirstlane(tid >> 6); const int wn = wave >> 1, wm = wave & 1; const int q = lane & 15, g = lane >> 4;
        const int mt = tile >> 3, nt = tile & 7; const int m0 = mt * 96, n0 = nt * 128;
        f32x4 acc[4][3];
#pragma unroll
        for (int a = 0; a < 4; ++a)
#pragma unroll
            for (int b = 0; b < 3; ++b) acc[a][b] = (f32x4){0.f, 0.f, 0.f, 0.f};
        unsigned soffb[4], soffa[3];
#pragma unroll
        for (int i = 0; i < 4; ++i) { const int row = 8 * (i * 4 + wave) + (lane >> 3); const int ch = (lane & 7) ^ ((row >> 1) & 7); soffb[i] = (unsigned)(row * 1024 + ch * 8); }
#pragma unroll
        for (int i = 0; i < 3; ++i) { const int row = 8 * (i * 4 + wave) + (lane >> 3); const int ch = (lane & 7) ^ ((row >> 1) & 7); soffa[i] = (unsigned)(row * 1024 + ch * 8); }
        const u16* ga = A + (size_t)m0 * 1024; const u16* gb = B + (size_t)n0 * 1024;
#define OSTAGE(buf, kt) do { _Pragma("unroll") for (int i = 0; i < 4; ++i) \
            __builtin_amdgcn_global_load_lds((const unsigned*)(gb + soffb[i] + (kt) * 64), (LAS unsigned*)(lds + (buf) * 28672 + (i * 4 + wave) * 1024), 16, 0, 0); \
        _Pragma("unroll") for (int i = 0; i < 3; ++i) \
            __builtin_amdgcn_global_load_lds((const unsigned*)(ga + soffa[i] + (kt) * 64), (LAS unsigned*)(lds + (buf) * 28672 + 16384 + (i * 4 + wave) * 1024), 16, 0, 0); } while (0)
        OSTAGE(0, 0);
        float4 xres[3][4];
#pragma unroll
        for (int tt = 0; tt < 3; ++tt) { const int row = m0 + wm * 48 + tt * 16 + q; const float* xr = row < NTP ? p.x_p + (size_t)row * DM : p.x_s + (size_t)(row - NTP) * DM;
#pragma unroll
            for (int ct = 0; ct < 4; ++ct) xres[tt][ct] = ntld4(xr + n0 + wn * 64 + ct * 16 + 4 * g); }
        __syncthreads();
        for (int kt = 0; kt < 16; ++kt) {
            if (kt + 1 < 16) OSTAGE((kt + 1) & 1, kt + 1);
            const char* sb = lds + (kt & 1) * 28672; const char* sa = sb + 16384;
#pragma unroll
            for (int ks = 0; ks < 2; ++ks) {
                bf16x8 fw[4], fx[3];
#pragma unroll
                for (int ct = 0; ct < 4; ++ct) fw[ct] = *(const bf16x8*)(sb + swz(wn * 64 + ct * 16 + q, 4 * ks + g));
#pragma unroll
                for (int tt = 0; tt < 3; ++tt) fx[tt] = *(const bf16x8*)(sa + swz(wm * 48 + tt * 16 + q, 4 * ks + g));
#pragma unroll
                for (int ct = 0; ct < 4; ++ct)
#pragma unroll
                    for (int tt = 0; tt < 3; ++tt) acc[ct][tt] = __builtin_amdgcn_mfma_f32_16x16x32_bf16(fw[ct], fx[tt], acc[ct][tt], 0, 0, 0);
            }
            __syncthreads();
        }
#undef OSTAGE
#pragma unroll
        for (int tt = 0; tt < 3; ++tt) {
            const int row = m0 + wm * 48 + tt * 16 + q;
            const float* xr = row < NTP ? p.x_p + (size_t)row * DM : p.x_s + (size_t)(row - NTP) * DM;
            float* o = p.out + (size_t)row * DM;
#pragma unroll
            for (int ct = 0; ct < 4; ++ct) { const int col = n0 + wn * 64 + ct * 16 + 4 * g; const float4 xv = xres[tt][ct];
                const f32x4 w = {xv.x + acc[ct][tt][0], xv.y + acc[ct][tt][1], xv.z + acc[ct][tt][2], xv.w + acc[ct][tt][3]}; __builtin_nontemporal_store(w, (f32x4*)(o + col)); }
        }
    }
}

DI f32x16 mmq(const char* X, const char* Y, int qm, int qn, f32x16 acc, int lane) {
    const int r = lane & 31, h = lane >> 5;
#pragma unroll
    for (int ks = 0; ks < 4; ++ks) {
        const bf16x8 a = *(const bf16x8*)(X + swz(32 * qm + r, 2 * ks + h));
        const bf16x8 b = *(const bf16x8*)(Y + swz(32 * qn + r, 2 * ks + h));
        acc = __builtin_amdgcn_mfma_f32_32x32x16_bf16(a, b, acc, 0, 0, 0);
    }
    return acc;
}
DI void st_nat(char* img, const f32x16& a, int qm, int qn, int lane) {
    const int n = 32 * qn + (lane & 31), h = lane >> 5;
#pragma unroll
    for (int g = 0; g < 4; ++g) { const int m = 32 * qm + 8 * g + 4 * h; uint2 w; w.x = pack2(a[4 * g], a[4 * g + 1]); w.y = pack2(a[4 * g + 2], a[4 * g + 3]);
        *(uint2*)(img + swz(n, m >> 3) + (m & 7) * 2) = w; }
}
DI void st_nat_g(u16* gimg, const f32x16& a, int qm, int qn, int lane) {
    const int n = 32 * qn + (lane & 31), h = lane >> 5;
#pragma unroll
    for (int g = 0; g < 4; ++g) { const int m = 32 * qm + 8 * g + 4 * h; uint2 w; w.x = pack2(a[4 * g], a[4 * g + 1]); w.y = pack2(a[4 * g + 2], a[4 * g + 3]);
        *(uint2*)(gimg + n * 64 + m) = w; }
}
DI void st_nat_gp(u16* gimg, const f32x16& a, int qm, int qn, int lane) {
    const int n = 32 * qn + (lane & 31), h = lane >> 5;
#pragma unroll
    for (int g = 0; g < 2; ++g) { const int m = 32 * qm + 8 * g + 4 * h; const int mp = (m & ~0x1c) | ((m & 0xc) << 1) | ((m & 0x10) >> 2);
        uint4 w; w.x = pack2(a[4 * g], a[4 * g + 1]); w.y = pack2(a[4 * g + 2], a[4 * g + 3]); w.z = pack2(a[4 * g + 8], a[4 * g + 9]); w.w = pack2(a[4 * g + 10], a[4 * g + 11]);
        *(uint4*)(gimg + n * 64 + mp) = w; }
}
DI void st_sc(char* img, const f32x16& a, int qm, int qn, int lane) {
    const int n = 32 * qn + (lane & 31), h = lane >> 5;
#pragma unroll
    for (int e = 0; e < 16; ++e) { const int m = 32 * qm + (e & 3) + 8 * (e >> 2) + 4 * h; *(u16*)(img + swz(m, n >> 3) + (n & 7) * 2) = f2bf(a[e]); }
}
DI f32x16 ld_nat(const char* img, int qm, int qn, int lane) {
    const int n = 32 * qn + (lane & 31), h = lane >> 5; f32x16 a;
#pragma unroll
    for (int g = 0; g < 4; ++g) { const int m = 32 * qm + 8 * g + 4 * h; const uint2 w = *(const uint2*)(img + swz(n, m >> 3) + (m & 7) * 2);
        a[4 * g] = bflo(w.x); a[4 * g + 1] = bfhi(w.x); a[4 * g + 2] = bflo(w.y); a[4 * g + 3] = bfhi(w.y); }
    return a;
}
DI void ld_cur_prev8(const Params& p, int row, int col, int mode, int sb, float* cur, float* prev) {
    const u16* proj = (const u16*)(p.ws + W_PROJ);
    unpack8(*(const uint4*)(proj + (size_t)row * NC + col), cur);
    if (mode == 0) unpack8(*(const uint4*)(proj + (size_t)(row - 1) * NC + col), prev);
    else if (mode == 1) { for (int i = 0; i < 8; ++i) prev[i] = 0.f; }
    else { const float* s = p.st_shift + (size_t)sb * 1664 + (col - C_R); const float4 a = *(const float4*)s, b = *(const float4*)(s + 4);
        prev[0] = a.x; prev[1] = a.y; prev[2] = a.z; prev[3] = a.w; prev[4] = b.x; prev[5] = b.y; prev[6] = b.z; prev[7] = b.w; }
}
DI float ld_prev1(const Params& p, int row, int col, int mode, int sb) {
    const u16* proj = (const u16*)(p.ws + W_PROJ);
    if (mode == 0) return bf2f(proj[(size_t)(row - 1) * NC + col]);
    if (mode == 1) return 0.f;
    return p.st_shift[(size_t)sb * 1664 + (col - C_R)];
}

DI void phase_rwkv_prep(const Params& p, char* lds) {
    const u16* proj = (const u16*)(p.ws + W_PROJ);
    char* R0 = lds; char* R1 = lds + 8192; char* R2 = lds + 2 * 8192; char* R3 = lds + 3 * 8192; char* R4 = lds + 4 * 8192; char* R5 = lds + 5 * 8192;
    char* R6 = lds + 6 * 8192; char* R7 = lds + 7 * 8192; char* R8 = lds + 8 * 8192;
    float* tot = (float*)(lds + 9 * 8192); float* gam = tot + 256;
    for (int u = blockIdx.x; u < NUNIT; u += gridDim.x) {
        int tid = threadIdx.x; asm volatile("" : "+v"(tid));
        const int lane = tid & 63, wave = __builtin_amdgcn_readfirstlane(tid >> 6); const int qm = wave >> 1, qn = wave & 1; const int r = lane & 31, h5 = lane >> 5;
        int b, h, c, row0, ntok; bool prm = u < 2048;
        if (prm) { b = u >> 10; h = (u >> 7) & 7; c = u & 127; row0 = b * 8192 + c * 64; ntok = 64; }
        else { const int s = u - 2048; b = s >> 3; h = s & 7; c = 0; row0 = NTP + b * 16; ntok = 16; }
        const int mode0 = prm ? (c > 0 ? 0 : 1) : 2;
        uint4 wr_[2], wk_[2], wv_[2];
#pragma unroll
        for (int i = 0; i < 2; ++i) { wr_[i] = (uint4){0, 0, 0, 0}; wk_[i] = wr_[i]; wv_[i] = wr_[i];
            if (16 * wave < ntok) { const u16* src = proj + (size_t)(row0 + 16 * wave + 8 * i + (lane >> 3)) * NC + h * 64 + 8 * (lane & 7);
                wr_[i] = *(const uint4*)(src + C_R); wk_[i] = *(const uint4*)(src + C_RK); wv_[i] = *(const uint4*)(src + C_RV); } }
        {
            const int t = tid >> 2, q = tid & 3;
#pragma unroll
            for (int half = 0; half < 2; ++half) {
                const int cw = q * 16 + half * 8;
                uint4 ow = {0, 0, 0, 0}, oa = {0, 0, 0, 0};
                if (t < ntok) {
                    const int mode = t > 0 ? 0 : mode0; float cur[8], prv[8], xw[8], xa[8];
                    ld_cur_prev8(p, row0 + t, C_WD + cw, mode, b, cur, prv);
                    { const float4 ma = *(const float4*)(p.mix + 1536 + cw), mb = *(const float4*)(p.mix + 1540 + cw); const float mx_[8] = {ma.x, ma.y, ma.z, ma.w, mb.x, mb.y, mb.z, mb.w};
#pragma unroll
                    for (int i = 0; i < 8; ++i) { const float x = cur[i] + (prv[i] - cur[i]) * mx_[i]; const float e2 = __expf(2.f * x); xw[i] = 1.f - 2.f * rcpf_(e2 + 1.f); } }
                    ld_cur_prev8(p, row0 + t, C_AD + cw, mode, b, cur, prv);
                    { const float4 ma = *(const float4*)(p.mix + 1600 + cw), mb = *(const float4*)(p.mix + 1604 + cw); const float mx_[8] = {ma.x, ma.y, ma.z, ma.w, mb.x, mb.y, mb.z, mb.w};
#pragma unroll
                    for (int i = 0; i < 8; ++i) xa[i] = cur[i] + (prv[i] - cur[i]) * mx_[i]; }
                    ow.x = pack2(xw[0], xw[1]); ow.y = pack2(xw[2], xw[3]); ow.z = pack2(xw[4], xw[5]); ow.w = pack2(xw[6], xw[7]);
                    oa.x = pack2(xa[0], xa[1]); oa.y = pack2(xa[2], xa[3]); oa.z = pack2(xa[4], xa[5]); oa.w = pack2(xa[6], xa[7]);
                }
                *(uint4*)(R0 + swz(t, 2 * q + half)) = ow; *(uint4*)(R1 + swz(t, 2 * q + half)) = oa;
            }
        }
        __syncthreads();
        {
            f32x16 adw, ada;
#pragma unroll
            for (int e = 0; e < 16; ++e) { adw[e] = 0.f; ada[e] = 0.f; }
            const u16* wup = (const u16*)(p.ws + W_WUPT) + (size_t)(h * 64 + 32 * qn + r) * 64; const u16* aup = (const u16*)(p.ws + W_AUPT) + (size_t)(h * 64 + 32 * qn + r) * 64;
#pragma unroll
            for (int ks = 0; ks < 4; ++ks) {
                const bf16x8 xa = *(const bf16x8*)(R0 + swz(32 * qm + r, 2 * ks + h5)); const bf16x8 xb = *(const bf16x8*)(R1 + swz(32 * qm + r, 2 * ks + h5));
                const bf16x8 ya = *(const bf16x8*)(wup + 16 * ks + 8 * h5); const bf16x8 yb = *(const bf16x8*)(aup + 16 * ks + 8 * h5);
                adw = __builtin_amdgcn_mfma_f32_32x32x16_bf16(xa, ya, adw, 0, 0, 0); ada = __builtin_amdgcn_mfma_f32_32x32x16_bf16(xb, yb, ada, 0, 0, 0);
            }
            float* DW = (float*)R4; float* DA = (float*)R6; const int n = 32 * qn + r;
#pragma unroll
            for (int e = 0; e < 16; ++e) { const int m = 32 * qm + (e & 3) + 8 * (e >> 2) + 4 * h5; DW[m * 64 + n] = adw[e]; DA[m * 64 + n] = ada[e]; }
        }
        __syncthreads();
        {
            const int tg = wave, j = lane, hj = h * 64 + j;
            float* DW = (float*)R4; const float* DA = (const float*)R6;
            { const float w0j = p.w0[hj];
                float run = 0.f;
#pragma unroll 4
                for (int i = 0; i < 16; ++i) { const int t = 16 * tg + i; const float x = w0j + DW[t * 64 + j];
                    const float z = -x; const float sp = fmaxf(z, 0.f) + __logf(1.f + __expf(-fabsf(z))); float l = -__expf(-sp - 0.5f); if (t >= ntok) l = 0.f; DW[t * 64 + j] = l; run += l; }
                tot[tg * 64 + j] = run;
            }
            __syncthreads();
            float prefix = 0.f, ctot = 0.f;
#pragma unroll
            for (int g = 0; g < 4; ++g) { const float v = tot[g * 64 + j]; if (g < tg) prefix += v; ctot += v; }
            if (tg == 0) gam[j] = __expf(ctot);
            const float a0j = p.a0[hj], kkj = p.k_k[hj], kaj = p.k_a[hj], rkj = p.r_k[hj];
            const float mr = p.mix[hj], mk = p.mix[512 + hj], mv = p.mix[1024 + hj];
            float* bonus = (float*)(p.ws + W_BONUS);
            float mybon = 0.f;
            u16 gcr[16], gck[16], gcv[16];
            { char* tb = R8 + wave * 2048; char* wp = tb + (lane >> 3) * 128 + (lane & 7) * 16; const char* rp = tb + lane * 2;
#define XPOSE16(W, OUT) do { asm volatile("s_waitcnt lgkmcnt(0)" ::: "memory"); *(uint4*)wp = W[0]; *(uint4*)(wp + 1024) = W[1]; asm volatile("s_waitcnt lgkmcnt(0)" ::: "memory"); \
                    _Pragma("unroll") for (int tt = 0; tt < 16; ++tt) OUT[tt] = *(const u16*)(rp + tt * 128); } while (0)
                XPOSE16(wr_, gcr); XPOSE16(wk_, gck); XPOSE16(wv_, gcv);
#undef XPOSE16
            }
            float pr = 0.f, pk = 0.f, pv = 0.f;
            { const int t0 = 16 * tg; if (t0 < ntok) { const int mode = t0 > 0 ? 0 : mode0; pr = ld_prev1(p, row0 + t0, C_R + hj, mode, b); pk = ld_prev1(p, row0 + t0, C_RK + hj, mode, b); pv = ld_prev1(p, row0 + t0, C_RV + hj, mode, b); } }
            float ecl = __expf(prefix); const float etot = __expf(ctot);
            unsigned pAt[8], pV[8], pKb[8], pBb[8]; float hAt = 0.f, hV = 0.f, hKb = 0.f, hBb = 0.f;
#pragma unroll
            for (int i = 0; i < 16; ++i) {
                const int t = 16 * tg + i; const bool valid = t < ntok;
                float xr = 0.f, xk = 0.f, xv = 0.f;
                if (valid) { const float cr = bf2f(gcr[i]), ck = bf2f(gck[i]), cv = bf2f(gcv[i]);
                    xr = cr + (pr - cr) * mr; xk = ck + (pk - ck) * mk; xv = cv + (pv - cv) * mv; pr = cr; pk = ck; pv = cv; }
                const float a = rcpf_(1.f + __expf(-(a0j + DA[t * 64 + j])));
                const float kx = xk * kkj; const float ss = wave_sum(kx * kx); const float kk = kx * __builtin_amdgcn_rsqf(fmaxf(ss, 1e-24f));
                const float kmod = xk * (1.f + (a - 1.f) * kaj);
                const float bon = wave_sum(xr * kmod * rkj);
                if (lane == i) mybon = bon;
                const float e_ce = ecl; ecl *= __expf(DW[t * 64 + j]);
                const float e_cl = ecl, e_n = rcpf_(ecl), e_t = etot * e_n;
                const float vAt = -kk * e_ce, vRt = xr * e_cl, vBt = kk * a * e_n, vKt = kmod * e_n, vBb = kk * a * e_t, vKb = kmod * e_t;
                const int so = swz(t, j >> 3) + (j & 7) * 2;
                *(u16*)(R0 + so) = f2bf(vAt); *(u16*)(R1 + so) = f2bf(vRt); *(u16*)(R2 + so) = f2bf(vBt); *(u16*)(R3 + so) = f2bf(vKt);
                if (i & 1) { pAt[i >> 1] = pack2(hAt, vAt); pV[i >> 1] = pack2(hV, xv); pKb[i >> 1] = pack2(hKb, vKb); pBb[i >> 1] = pack2(hBb, vBb); }
                else { hAt = vAt; hV = xv; hKb = vKb; hBb = vBb; }
            }
            if (lane < 16) bonus[(size_t)u * 64 + 16 * tg + lane] = mybon;
            __syncthreads();
#pragma unroll
            for (int half = 0; half < 2; ++half) { const int o = swz(j, 2 * tg + half);
                *(uint4*)(R4 + o) = (uint4){pAt[4 * half], pAt[4 * half + 1], pAt[4 * half + 2], pAt[4 * half + 3]};
                *(uint4*)(R5 + o) = (uint4){pV[4 * half], pV[4 * half + 1], pV[4 * half + 2], pV[4 * half + 3]};
                *(uint4*)(R6 + o) = (uint4){pKb[4 * half], pKb[4 * half + 1], pKb[4 * half + 2], pKb[4 * half + 3]};
                *(uint4*)(R7 + o) = (uint4){pBb[4 * half], pBb[4 * half + 1], pBb[4 * half + 2], pBb[4 * half + 3]}; }
        }
        __syncthreads();
        f32x16 z16;
#pragma unroll
        for (int e = 0; e < 16; ++e) z16[e] = 0.f;
        f32x16 aN = mmq(R2, R0, qm, qn, z16, lane);
        f32x16 aKa = mmq(R3, R0, qm, qn, z16, lane);
        f32x16 aW1 = mmq(R2, R1, qm, qn, z16, lane);
        f32x16 aKr = mmq(R3, R1, qm, qn, z16, lane);
        {
            const int n = 32 * qn + r;
#pragma unroll
            for (int e = 0; e < 16; ++e) { const int m = 32 * qm + (e & 3) + 8 * (e >> 2) + 4 * h5;
                if (!(m < n)) { aN[e] = 0.f; aKa[e] = 0.f; } if (!(m <= n)) { aW1[e] = 0.f; aKr[e] = 0.f; } }
        }
        f32x16 aW2 = ld_nat(R7, qm, qn, lane);
        __syncthreads();
        st_sc(R0, aN, qm, qn, lane);
        st_nat(R2, aN, qm, qn, lane);
        st_sc(R3, aKa, qm, qn, lane);
        st_nat(R8, aW1, qm, qn, lane);
        __syncthreads();
        for (int it = 0; it < 6; ++it) {
            aW1 = mmq(R0, R8, qm, qn, aW1, lane);
            aW2 = mmq(R0, R7, qm, qn, aW2, lane);
            if (it < 5) aN = mmq(R0, R2, qm, qn, z16, lane);
            __syncthreads();
            st_nat(R8, aW1, qm, qn, lane); st_nat(R7, aW2, qm, qn, lane);
            if (it < 5) { st_sc(R0, aN, qm, qn, lane); st_nat(R2, aN, qm, qn, lane); }
            __syncthreads();
        }
        {
            f32x16 aG = mmq(R4, R7, qm, qn, z16, lane);
            { const int n = 32 * qn + r; const float gn = gam[n];
#pragma unroll
                for (int e = 0; e < 16; ++e) { const int m = 32 * qm + (e & 3) + 8 * (e >> 2) + 4 * h5; if (m == n) aG[e] += gn; } }
            st_nat_gp((u16*)(p.ws + W_GT) + (size_t)u * 4096, aG, qm, qn, lane);
            f32x16 aQ = ld_nat(R1, qm, qn, lane);
            aQ = mmq(R4, R8, qm, qn, aQ, lane);
            st_nat_gp((u16*)(p.ws + W_QT) + (size_t)u * 4096, aQ, qm, qn, lane);
            f32x16 aP1 = ld_nat(R6, qm, qn, lane);
            aP1 = mmq(R3, R7, qm, qn, aP1, lane);
            aKr = mmq(R3, R8, qm, qn, aKr, lane);
            st_nat(R0, aP1, qm, qn, lane);
            st_nat(R2, aKr, qm, qn, lane);
        }
        __syncthreads();
        {
            f32x16 aH = mmq(R0, R5, qm, qn, z16, lane);
            st_nat_gp((u16*)(p.ws + W_HH) + (size_t)u * 4096, aH, qm, qn, lane);
            f32x16 aY = mmq(R5, R2, qm, qn, z16, lane);
            const int n = 32 * qn + r;

#pragma unroll
            for (int g = 0; g < 4; g += 2) {
                unsigned ax = pack2(aY[4 * g], aY[4 * g + 1]), ay = pack2(aY[4 * g + 2], aY[4 * g + 3]), bx = pack2(aY[4 * g + 4], aY[4 * g + 5]), by = pack2(aY[4 * g + 6], aY[4 * g + 7]);
                { auto rr = __builtin_amdgcn_permlane32_swap(ax, bx, false, false); ax = rr[0]; bx = rr[1]; }
                { auto rr = __builtin_amdgcn_permlane32_swap(ay, by, false, false); ay = rr[0]; by = rr[1]; }
                if (n < ntok) *(uint4*)((u16*)(p.ws + W_XB) + (size_t)(row0 + n) * DM + 512 + h * 64 + 32 * qm + 8 * g + 8 * h5) = (uint4){ax, ay, bx, by};
            }
        }
        __syncthreads();
    }
}

struct ScanSlot { uint4 ga[4][2]; uint4 gh[2]; };
DI void scan_load(ScanSlot& s, const u16* GT, const u16* HH, int u, int irow, int i16, int g) {
    const u16* gt = GT + (size_t)u * 4096; const u16* hh = HH + (size_t)u * 4096 + irow * 64;
#pragma unroll
    for (int mt = 0; mt < 4; ++mt) {
#pragma unroll
        for (int ks = 0; ks < 2; ++ks) s.ga[mt][ks] = *(const uint4*)(gt + (16 * mt + i16) * 64 + 32 * ks + 8 * g);
    }
#pragma unroll
    for (int ks = 0; ks < 2; ++ks) s.gh[ks] = *(const uint4*)(hh + 32 * ks + 8 * g);
}
DI void scan_step(const ScanSlot& s, f32x4 (&acc)[4], u16* sst, int irow, int g) {
    unsigned pk[4][2];
#pragma unroll
    for (int mt = 0; mt < 4; ++mt) { pk[mt][0] = pack2(acc[mt][0], acc[mt][1]); pk[mt][1] = pack2(acc[mt][2], acc[mt][3]); }
    bf16x8 bfr[2];
#pragma unroll
    for (int ks = 0; ks < 2; ++ks) { uint4 w = {pk[2 * ks][0], pk[2 * ks][1], pk[2 * ks + 1][0], pk[2 * ks + 1][1]}; bfr[ks] = __builtin_bit_cast(bf16x8, w);
        { typedef unsigned u32x4_ __attribute__((ext_vector_type(4))); const u32x4_ wv_ = {w.x, w.y, w.z, w.w}; __builtin_nontemporal_store(wv_, (u32x4_*)(sst + irow * 64 + 32 * ks + 8 * g)); } }
#pragma unroll
    for (int mt = 0; mt < 4; ++mt) {
        const unsigned hx = (mt & 1) ? s.gh[mt >> 1].z : s.gh[mt >> 1].x, hy = (mt & 1) ? s.gh[mt >> 1].w : s.gh[mt >> 1].y;
        f32x4 c = {bflo(hx), bfhi(hx), bflo(hy), bfhi(hy)};
#pragma unroll
        for (int ks = 0; ks < 2; ++ks) c = __builtin_amdgcn_mfma_f32_16x16x32_bf16(__builtin_bit_cast(bf16x8, s.ga[mt][ks]), bfr[ks], c, 0, 0, 0);
        acc[mt] = c;
    }
}
DI void scan_item(const Params& p, int item, int lane) {
    const int i16 = lane & 15, g = lane >> 4;
    const u16* GT = (const u16*)(p.ws + W_GT); const u16* HH = (const u16*)(p.ws + W_HH); u16* SST = (u16*)(p.ws + W_SST);
    f32x4 acc[4];
    if (item < 64) {
        const int bh = item >> 2, iq = item & 3, u0 = bh * 128, irow = 16 * iq + i16;
#pragma unroll
        for (int mt = 0; mt < 4; ++mt) acc[mt] = (f32x4){0.f, 0.f, 0.f, 0.f};
        ScanSlot s0, s1, s2, s3, s4;
        scan_load(s0, GT, HH, u0, irow, i16, g); scan_load(s1, GT, HH, u0 + 1, irow, i16, g); scan_load(s2, GT, HH, u0 + 2, irow, i16, g); scan_load(s3, GT, HH, u0 + 3, irow, i16, g);
        scan_load(s4, GT, HH, u0 + 4, irow, i16, g);
        const int ul = u0 + 127;
#define PINM do { asm volatile("" ::: "memory"); __builtin_amdgcn_sched_barrier(0); } while (0)
        for (int st = 0; st < 125; st += 5) {
            const int u = u0 + st;
            scan_step(s0, acc, SST + (size_t)u * 4096, irow, g);       PINM; scan_load(s0, GT, HH, min(u + 5, ul), irow, i16, g); PINM;
            scan_step(s1, acc, SST + (size_t)(u + 1) * 4096, irow, g); PINM; scan_load(s1, GT, HH, min(u + 6, ul), irow, i16, g); PINM;
            scan_step(s2, acc, SST + (size_t)(u + 2) * 4096, irow, g); PINM; scan_load(s2, GT, HH, min(u + 7, ul), irow, i16, g); PINM;
            scan_step(s3, acc, SST + (size_t)(u + 3) * 4096, irow, g); PINM; scan_load(s3, GT, HH, min(u + 8, ul), irow, i16, g); PINM;
            scan_step(s4, acc, SST + (size_t)(u + 4) * 4096, irow, g); PINM; scan_load(s4, GT, HH, min(u + 9, ul), irow, i16, g); PINM;
        }
        scan_step(s0, acc, SST + (size_t)(u0 + 125) * 4096, irow, g); PINM;
        scan_step(s1, acc, SST + (size_t)(u0 + 126) * 4096, irow, g); PINM;
        scan_step(s2, acc, SST + (size_t)(u0 + 127) * 4096, irow, g);
#undef PINM
        float* fout = p.out + O_SP + (size_t)bh * 4096;
#pragma unroll
        for (int mt = 0; mt < 4; ++mt) *(f32x4*)(fout + irow * 64 + 16 * mt + 4 * g) = acc[mt];
    } else {
        const int s = (item - 64) >> 2, iq = item & 3, u = 2048 + s, irow = 16 * iq + i16;
        const float* st0 = p.st_wkv + (size_t)s * 4096 + irow * 64;
#pragma unroll
        for (int mt = 0; mt < 4; ++mt) acc[mt] = *(const f32x4*)(st0 + 16 * mt + 4 * g);
        ScanSlot s0; scan_load(s0, GT, HH, u, irow, i16, g);
        scan_step(s0, acc, SST + (size_t)u * 4096, irow, g);
        float* fout = p.out + O_SS + (size_t)s * 4096;
#pragma unroll
        for (int mt = 0; mt < 4; ++mt) *(f32x4*)(fout + irow * 64 + 16 * mt + 4 * g) = acc[mt];
    }
}

DI s16x4 tr16(const char* p) { return __builtin_bit_cast(s16x4, __builtin_amdgcn_ds_read_tr16_b64_v4i16((__attribute__((address_space(3))) s16x4*)p)); }

DI void attn_tile(const char* sk, const char* sv, const float* tab, const bf16x8& qf0, const bf16x8& qf1, float& m, float& l, f32x4 (&o)[4], int qpos, int dlt, int nvalid, int lane) {
    const int q = lane & 15, g = lane >> 4;
    const float C2 = 0.125f * LOG2E;
    f32x4 sc[4];
#pragma unroll
    for (int kt = 0; kt < 4; ++kt) {
        const bf16x8 a0 = *(const bf16x8*)(sk + swz(16 * kt + q, g)); const bf16x8 a1 = *(const bf16x8*)(sk + swz(16 * kt + q, 4 + g));
        f32x4 s = {0.f, 0.f, 0.f, 0.f};
        s = __builtin_amdgcn_mfma_f32_16x16x32_bf16(a0, qf0, s, 0, 0, 0); s = __builtin_amdgcn_mfma_f32_16x16x32_bf16(a1, qf1, s, 0, 0, 0);
        sc[kt] = s;
    }
    float mx = -INFINITY;
    if (dlt >= 3) {
        const float bc = tab[256];
#pragma unroll
        for (int kt = 0; kt < 4; ++kt)
#pragma unroll
            for (int e = 0; e < 4; ++e) { const float s = sc[kt][e] * C2 + bc; sc[kt][e] = s; mx = fmaxf(mx, s); }
    } else {
#pragma unroll
        for (int kt = 0; kt < 4; ++kt)
#pragma unroll
            for (int e = 0; e < 4; ++e) { const int key = 16 * kt + 4 * g + e; int rel = qpos - key + dlt * 64; rel = rel < -128 ? -128 : (rel > 128 ? 128 : rel);
                float s = sc[kt][e] * C2 + tab[rel + 128]; if (key >= nvalid) s = -INFINITY; sc[kt][e] = s; mx = fmaxf(mx, s); }
    }
    mx = xmax16(mx); mx = xmax32(mx);
    const float mn = fmaxf(m, mx); const float alpha = __builtin_amdgcn_exp2f(m - mn); m = mn;
    float ps = 0.f;
#pragma unroll
    for (int kt = 0; kt < 4; ++kt)
#pragma unroll
        for (int e = 0; e < 4; ++e) { const float pe = __builtin_amdgcn_exp2f(sc[kt][e] - mn); sc[kt][e] = pe; ps += pe; }
    l = l * alpha + ps;
#pragma unroll
    for (int dt = 0; dt < 4; ++dt) o[dt] *= alpha;
    bf16x8 pf[2];
#pragma unroll
    for (int ks = 0; ks < 2; ++ks) { uint4 w = {pack2(sc[2 * ks][0], sc[2 * ks][1]), pack2(sc[2 * ks][2], sc[2 * ks][3]), pack2(sc[2 * ks + 1][0], sc[2 * ks + 1][1]), pack2(sc[2 * ks + 1][2], sc[2 * ks + 1][3])};
        pf[ks] = __builtin_bit_cast(bf16x8, w); }
#pragma unroll
    for (int dt = 0; dt < 4; ++dt)
#pragma unroll
        for (int ks = 0; ks < 2; ++ks) {
            const int vr = 32 * ks + 4 * g + (q >> 2); const int col = 16 * dt + 4 * (q & 3);
            const s16x4 lo = tr16(sv + swz(vr, col >> 3) + (col & 7) * 2); const s16x4 hi = tr16(sv + swz(vr + 16, col >> 3) + (col & 7) * 2);
            const bf16x8 vf = {lo[0], lo[1], lo[2], lo[3], hi[0], hi[1], hi[2], hi[3]};
            o[dt] = __builtin_amdgcn_mfma_f32_16x16x32_bf16(vf, pf[ks], o[dt], 0, 0, 0);
        }
}
DI void attn_finish(const Params& p, float l, const f32x4 (&o)[4], int qrow, int h, int lane) {
    const int g = lane >> 4; const u16* proj = (const u16*)(p.ws + W_PROJ);
    l = xadd16(l); l = xadd32(l);
    const float inv = rcpf_(l);
    u16* z = (u16*)(p.ws + W_XB) + (size_t)qrow * DM + h * 64; const u16* ga = proj + (size_t)qrow * NC + C_GA + h * 64;
    uint2 w[4];
#pragma unroll
    for (int dt = 0; dt < 4; ++dt) { const int d = 16 * dt + 4 * g; const uint2 gg = *(const uint2*)(ga + d);
        w[dt].x = pack2(o[dt][0] * inv * silu(bflo(gg.x)), o[dt][1] * inv * silu(bfhi(gg.x))); w[dt].y = pack2(o[dt][2] * inv * silu(bflo(gg.y)), o[dt][3] * inv * silu(bfhi(gg.y))); }
#pragma unroll
    for (int dt = 0; dt < 4; dt += 2) *(uint4*)(z + 16 * (dt + (g & 1)) + 8 * (g >> 1)) = widen16(w[dt], w[dt + 1]);
}
DI void attn_block(const Params& p, int u, char* lds) {
    int tid = threadIdx.x; asm volatile("" : "+v"(tid));
    const int lane = tid & 63, wave = __builtin_amdgcn_readfirstlane(tid >> 6);
    const u16* proj = (const u16*)(p.ws + W_PROJ);
    const int b = u >> 10, h = (u >> 7) & 7, c = u & 127; const int qrow = b * 8192 + c * 64 + wave * 16 + (lane & 15); const int ndl = c < 8 ? c : 8;
    float* tab = (float*)(lds + 49152);
    __syncthreads();
    for (int i = tid; i < 257; i += 256) tab[i] = p.relb[h * 257 + i] * LOG2E;
    const u16* qp = proj + (size_t)qrow * NC + C_Q + h * 64 + 8 * (lane >> 4);
    const bf16x8 qf0 = *(const bf16x8*)qp, qf1 = *(const bf16x8*)(qp + 32);
    float m = -INFINITY, l = 0.f; f32x4 o[4];
#pragma unroll
    for (int dt = 0; dt < 4; ++dt) o[dt] = (f32x4){0.f, 0.f, 0.f, 0.f};
    unsigned soff[2];
#pragma unroll
    for (int i = 0; i < 2; ++i) { const int row = 8 * (i * 4 + wave) + (lane >> 3); const int ch = (lane & 7) ^ ((row >> 1) & 7); soff[i] = (unsigned)(row * NC + ch * 8); }
    const u16* kbase = proj + (size_t)(b * 8192) * NC + h * 64;
#define ASTAGE(buf, dl) do { const u16* kr = kbase + (size_t)((c - (dl)) * 64) * NC; _Pragma("unroll") for (int i = 0; i < 2; ++i) { \
        __builtin_amdgcn_global_load_lds((const unsigned*)(kr + soff[i] + C_K), (LAS unsigned*)(lds + (buf) * 8192 + (i * 4 + wave) * 1024), 16, 0, 0); \
        __builtin_amdgcn_global_load_lds((const unsigned*)(kr + soff[i] + C_V), (LAS unsigned*)(lds + 24576 + (buf) * 8192 + (i * 4 + wave) * 1024), 16, 0, 0); } } while (0)
    __syncthreads();
    ASTAGE(0, ndl); if (ndl >= 1) ASTAGE(1, ndl - 1);
    int buf = 0;
    for (int dlt = ndl; dlt >= 0; --dlt) {
        if (dlt >= 1) asm volatile("s_waitcnt vmcnt(4) lgkmcnt(0)" ::: "memory"); else asm volatile("s_waitcnt vmcnt(0) lgkmcnt(0)" ::: "memory");
        __builtin_amdgcn_s_barrier();
        asm volatile("" ::: "memory");
        const int nb2 = buf >= 1 ? buf - 1 : 2;
        if (dlt >= 2) ASTAGE(nb2, dlt - 2);
        attn_tile(lds + buf * 8192, lds + 24576 + buf * 8192, tab, qf0, qf1, m, l, o, wave * 16 + (lane & 15), dlt, 64, lane);
        buf = buf == 2 ? 0 : buf + 1;
    }
#undef ASTAGE
    attn_finish(p, l, o, qrow, h, lane);
}
struct QG { bf16x8 q0, q1; float m, l; f32x4 o[4]; };
DI void attn_softmax(f32x4 (&sc)[4], const float* tab, QG& G, int qpos, int dlt, int g, bf16x8 (&pf)[2]) {
    const float C2 = 0.125f * LOG2E;
    float mx = -INFINITY;
    if (dlt >= 3) {
        const float bc = tab[256];
#pragma unroll
        for (int kt = 0; kt < 4; ++kt)
#pragma unroll
            for (int e = 0; e < 4; ++e) { const float s = sc[kt][e] * C2 + bc; sc[kt][e] = s; mx = fmaxf(mx, s); }
    } else {
#pragma unroll
        for (int kt = 0; kt < 4; ++kt)
#pragma unroll
            for (int e = 0; e < 4; ++e) { const int key = 16 * kt + 4 * g + e; int rel = qpos - key + dlt * 64; rel = rel < -128 ? -128 : (rel > 128 ? 128 : rel);
                const float s = sc[kt][e] * C2 + tab[rel + 128]; sc[kt][e] = s; mx = fmaxf(mx, s); }
    }
    mx = xmax16(mx); mx = xmax32(mx);
    const float mn = fmaxf(G.m, mx); const float alpha = __builtin_amdgcn_exp2f(G.m - mn); G.m = mn;
    float ps = 0.f;
#pragma unroll
    for (int kt = 0; kt < 4; ++kt)
#pragma unroll
        for (int e = 0; e < 4; ++e) { const float pe = __builtin_amdgcn_exp2f(sc[kt][e] - mn); sc[kt][e] = pe; ps += pe; }
    G.l = G.l * alpha + ps;
#pragma unroll
    for (int dt = 0; dt < 4; ++dt) G.o[dt] *= alpha;
#pragma unroll
    for (int ks = 0; ks < 2; ++ks) { uint4 w = {pack2(sc[2 * ks][0], sc[2 * ks][1]), pack2(sc[2 * ks][2], sc[2 * ks][3]), pack2(sc[2 * ks + 1][0], sc[2 * ks + 1][1]), pack2(sc[2 * ks + 1][2], sc[2 * ks + 1][3])};
        pf[ks] = __builtin_bit_cast(bf16x8, w); }
}
DI void attn_tile2(const char* sk, const char* sv, const float* tab, QG& A, QG& B, int qposA, int dlt, int lane) {
    const int q = lane & 15, g = lane >> 4;
    f32x4 sa[4], sb[4];
#pragma unroll
    for (int kt = 0; kt < 4; ++kt) {
        const bf16x8 a0 = *(const bf16x8*)(sk + swz(16 * kt + q, g)); const bf16x8 a1 = *(const bf16x8*)(sk + swz(16 * kt + q, 4 + g));
        f32x4 x = {0.f, 0.f, 0.f, 0.f}, y = {0.f, 0.f, 0.f, 0.f};
        x = __builtin_amdgcn_mfma_f32_16x16x32_bf16(a0, A.q0, x, 0, 0, 0); y = __builtin_amdgcn_mfma_f32_16x16x32_bf16(a0, B.q0, y, 0, 0, 0);
        x = __builtin_amdgcn_mfma_f32_16x16x32_bf16(a1, A.q1, x, 0, 0, 0); y = __builtin_amdgcn_mfma_f32_16x16x32_bf16(a1, B.q1, y, 0, 0, 0);
        sa[kt] = x; sb[kt] = y;
    }
    bf16x8 pa[2], pb[2];
    attn_softmax(sa, tab, A, qposA, dlt, g, pa);
    attn_softmax(sb, tab, B, qposA + 16, dlt, g, pb);
#pragma unroll
    for (int dt = 0; dt < 4; ++dt)
#pragma unroll
        for (int ks = 0; ks < 2; ++ks) {
            const int vr = 32 * ks + 4 * g + (q >> 2); const int col = 16 * dt + 4 * (q & 3);
            const s16x4 lo = tr16(sv + swz(vr, col >> 3) + (col & 7) * 2); const s16x4 hi = tr16(sv + swz(vr + 16, col >> 3) + (col & 7) * 2);
            const bf16x8 vf = {lo[0], lo[1], lo[2], lo[3], hi[0], hi[1], hi[2], hi[3]};
            A.o[dt] = __builtin_amdgcn_mfma_f32_16x16x32_bf16(vf, pa[ks], A.o[dt], 0, 0, 0);
            B.o[dt] = __builtin_amdgcn_mfma_f32_16x16x32_bf16(vf, pb[ks], B.o[dt], 0, 0, 0);
        }
}
DI void attn_block2(const Params& p, int bh, int cp, char* lds) {
    int tid = threadIdx.x; asm volatile("" : "+v"(tid));
    const int lane = tid & 63, wave = __builtin_amdgcn_readfirstlane(tid >> 6);
    const u16* proj = (const u16*)(p.ws + W_PROJ);
    const int b = bh >> 3, h = bh & 7, c0 = 2 * cp, cq = c0 + (wave >> 1);
    const int qposA = (wave & 1) * 32 + (lane & 15); const int qrowA = b * 8192 + cq * 64 + qposA;
    float* tab = (float*)(lds + 49152);
    __syncthreads();
    for (int i = tid; i < 257; i += 256) tab[i] = p.relb[h * 257 + i] * LOG2E;
    QG A, B;
    { const u16* qp = proj + (size_t)qrowA * NC + C_Q + h * 64 + 8 * (lane >> 4); A.q0 = *(const bf16x8*)qp; A.q1 = *(const bf16x8*)(qp + 32);
      const u16* qb = qp + (size_t)16 * NC; B.q0 = *(const bf16x8*)qb; B.q1 = *(const bf16x8*)(qb + 32); }
    A.m = -INFINITY; A.l = 0.f; B.m = -INFINITY; B.l = 0.f;
#pragma unroll
    for (int dt = 0; dt < 4; ++dt) { A.o[dt] = (f32x4){0.f, 0.f, 0.f, 0.f}; B.o[dt] = (f32x4){0.f, 0.f, 0.f, 0.f}; }
    unsigned soff[2];
#pragma unroll
    for (int i = 0; i < 2; ++i) { const int row = 8 * (i * 4 + wave) + (lane >> 3); const int ch = (lane & 7) ^ ((row >> 1) & 7); soff[i] = (unsigned)(row * NC + ch * 8); }
    const u16* kbase = proj + (size_t)(b * 8192) * NC + h * 64;
#define ASTAGE2(buf, kc) do { const u16* kr = kbase + (size_t)((kc) * 64) * NC; _Pragma("unroll") for (int i = 0; i < 2; ++i) { \
        __builtin_amdgcn_global_load_lds((const unsigned*)(kr + soff[i] + C_K), (LAS unsigned*)(lds + (buf) * 8192 + (i * 4 + wave) * 1024), 16, 0, 0); \
        __builtin_amdgcn_global_load_lds((const unsigned*)(kr + soff[i] + C_V), (LAS unsigned*)(lds + 24576 + (buf) * 8192 + (i * 4 + wave) * 1024), 16, 0, 0); } } while (0)
    const int lo = c0 >= 8 ? c0 - 8 : 0, hi = c0 + 1;
    __syncthreads();
    ASTAGE2(0, lo); ASTAGE2(1, lo + 1);
    int buf = 0;
    for (int kc = lo; kc <= hi; ++kc) {
        if (kc < hi) asm volatile("s_waitcnt vmcnt(4) lgkmcnt(0)" ::: "memory"); else asm volatile("s_waitcnt vmcnt(0) lgkmcnt(0)" ::: "memory");
        __builtin_amdgcn_s_barrier();
        asm volatile("" ::: "memory");
        const int nb2 = buf >= 1 ? buf - 1 : 2;
        if (kc + 2 <= hi) ASTAGE2(nb2, kc + 2);
        const int dlt = cq - kc;
        if (dlt >= 0 && dlt <= 8) attn_tile2(lds + buf * 8192, lds + 24576 + buf * 8192, tab, A, B, qposA, dlt, lane);
        buf = buf == 2 ? 0 : buf + 1;
    }
#undef ASTAGE2
    attn_finish(p, A.l, A.o, qrowA, h, lane);
    attn_finish(p, B.l, B.o, qrowA + 16, h, lane);
}

DI void attn_block_sample(const Params& p, int s, char* lds) {
    int tid = threadIdx.x; asm volatile("" : "+v"(tid));
    const int lane = tid & 63, wave = __builtin_amdgcn_readfirstlane(tid >> 6);
    char* wl = lds + wave * 18432;
    char* sk = wl; char* sv = wl + 8192; float* tab = (float*)(wl + 16384);
    const u16* proj = (const u16*)(p.ws + W_PROJ);
    const int b = s >> 3, h = s & 7; const int qrow0 = NTP + b * 16;
    for (int i = lane; i < 257; i += 64) tab[i] = p.relb[h * 257 + i] * LOG2E;
    const int q = lane & 15, g = lane >> 4;
    const u16* qp = proj + (size_t)(qrow0 + q) * NC + C_Q + h * 64 + 8 * g;
    const bf16x8 qf0 = *(const bf16x8*)qp, qf1 = *(const bf16x8*)(qp + 32);
    float m = -INFINITY, l = 0.f; f32x4 o[4];
#pragma unroll
    for (int dt = 0; dt < 4; ++dt) o[dt] = (f32x4){0.f, 0.f, 0.f, 0.f};
    const int lrow = lane >> 3, lch = lane & 7;
    float4 rk[16], rv[16];
#define SLOAD(dl) do { const size_t off_ = ((size_t)(b * 8 + h) * 512 + (8 - (dl)) * 64) * 64 + lrow * 64 + lch * 8; \
        _Pragma("unroll") for (int i = 0; i < 8; ++i) { const float* a_ = p.cache_k + off_ + i * 512; const float* c_ = p.cache_v + off_ + i * 512; \
            rk[2 * i] = ntld4(a_); rk[2 * i + 1] = ntld4(a_ + 4); rv[2 * i] = ntld4(c_); rv[2 * i + 1] = ntld4(c_ + 4); } } while (0)
#define SWRITE() do { _Pragma("unroll") for (int i = 0; i < 8; ++i) { const int row = i * 8 + lrow; \
            uint4 kv = {pack2(rk[2 * i].x, rk[2 * i].y), pack2(rk[2 * i].z, rk[2 * i].w), pack2(rk[2 * i + 1].x, rk[2 * i + 1].y), pack2(rk[2 * i + 1].z, rk[2 * i + 1].w)}; \
            uint4 vv = {pack2(rv[2 * i].x, rv[2 * i].y), pack2(rv[2 * i].z, rv[2 * i].w), pack2(rv[2 * i + 1].x, rv[2 * i + 1].y), pack2(rv[2 * i + 1].z, rv[2 * i + 1].w)}; \
            *(uint4*)(sk + swz(row, lch)) = kv; *(uint4*)(sv + swz(row, lch)) = vv; } } while (0)
    const int d0 = 8 - 2 * wave;
    SLOAD(d0);
    asm volatile("s_waitcnt lgkmcnt(0)" ::: "memory");
    SWRITE();
    SLOAD(d0 - 1);
    asm volatile("s_waitcnt lgkmcnt(0)" ::: "memory");
    attn_tile(sk, sv, tab, qf0, qf1, m, l, o, q, d0, 64, lane);
    asm volatile("s_waitcnt lgkmcnt(0)" ::: "memory");
    SWRITE();
    asm volatile("s_waitcnt lgkmcnt(0)" ::: "memory");
    attn_tile(sk, sv, tab, qf0, qf1, m, l, o, q, d0 - 1, 64, lane);
#undef SLOAD
#undef SWRITE
    if (wave == 3) {
        asm volatile("s_waitcnt lgkmcnt(0)" ::: "memory");
#pragma unroll
        for (int i = 0; i < 8; ++i) { const int row = i * 8 + lrow; uint4 kv = {0, 0, 0, 0}, vv = {0, 0, 0, 0};
            if (row < 16) { const u16* sp = proj + (size_t)(qrow0 + row) * NC + h * 64 + lch * 8; kv = *(const uint4*)(sp + C_K); vv = *(const uint4*)(sp + C_V); }
            *(uint4*)(sk + swz(row, lch)) = kv; *(uint4*)(sv + swz(row, lch)) = vv; }
        asm volatile("s_waitcnt lgkmcnt(0)" ::: "memory");
        attn_tile(sk, sv, tab, qf0, qf1, m, l, o, q, 0, 16, lane);
    }
    l = xadd16(l); l = xadd32(l);
    asm volatile("s_waitcnt lgkmcnt(0)" ::: "memory");
    float* cm = (float*)wl; float* cl = cm + 16; float* co = cm + 32;
    if (g == 0) { cm[q] = m; cl[q] = l; }
#pragma unroll
    for (int dt = 0; dt < 4; ++dt) *(f32x4*)(co + q * 64 + 16 * dt + 4 * g) = o[dt];
    __syncthreads();
    {
        float mw[4], M = -INFINITY;
#pragma unroll
        for (int w = 0; w < 4; ++w) { mw[w] = ((const float*)(lds + w * 18432))[q]; M = fmaxf(M, mw[w]); }
        float L = 0.f; f32x4 O = {0.f, 0.f, 0.f, 0.f};
#pragma unroll
        for (int w = 0; w < 4; ++w) { const float* base = (const float*)(lds + w * 18432); const float f = __builtin_amdgcn_exp2f(mw[w] - M);
            L += base[16 + q] * f; const f32x4 ov = *(const f32x4*)(base + 32 + q * 64 + 16 * wave + 4 * g); O += ov * f; }
        const float inv = rcpf_(L); const int qrow = qrow0 + q; const int d = 16 * wave + 4 * g;
        const uint2 gg = *(const uint2*)(proj + (size_t)qrow * NC + C_GA + h * 64 + d);
        uint2 w2; w2.x = pack2(O[0] * inv * silu(bflo(gg.x)), O[1] * inv * silu(bfhi(gg.x))); w2.y = pack2(O[2] * inv * silu(bflo(gg.y)), O[3] * inv * silu(bfhi(gg.y)));
        *(uint2*)((u16*)(p.ws + W_XB) + (size_t)qrow * DM + h * 64 + d) = w2;
    }
    __syncthreads();
}

DI void phase_scan_attn(const Params& p, char* lds) {
    const int tid = threadIdx.x, lane = tid & 63, wave = __builtin_amdgcn_readfirstlane(tid >> 6);
    if (blockIdx.x < 64) {
        if (wave == 0) { const int x_ = blockIdx.x & 7, k_ = blockIdx.x >> 3;
            scan_item(p, (x_ + 8 * (k_ >> 2)) * 4 + (k_ & 3), lane); }
        return;
    }
    unsigned* ctr = (unsigned*)(p.ws + W_BAR) + 3456;
    volatile LAS int* slot = (volatile LAS int*)(lds + 75264);
    const int q0 = (int)((unsigned)__builtin_amdgcn_s_getreg((3 << 11) | 20) & 7u);
    for (int v = 0; v < 8; ++v) {
        const int q = (q0 + v) & 7;
        for (;;) {
            __syncthreads();
            if (tid == 0) *slot = (int)__hip_atomic_fetch_add(ctr + 16 * q, 1u, __ATOMIC_RELAXED, __HIP_MEMORY_SCOPE_AGENT);
            __syncthreads();
            const int item = *slot;
            if (item >= 32 + 128 + 32) break;
            if (item < 32) attn_block_sample(p, 32 * q + item, lds);
            else if (item < 160) { const int j = item - 32; attn_block2(p, 2 * q + (j & 1), 63 - (j >> 1), lds); }
            else scan_item(p, 64 + (32 * q + item - 160) * 4 + wave, lane);
        }
    }
}

DI void phase_rwkv_out(const Params& p, char* lds) {
    const int tid = threadIdx.x, lane = tid & 63, wave = tid >> 6;
    float* pw = (float*)(lds + wave * 1024);
    const int gw = blockIdx.x * 4 + wave, nw = gridDim.x * 4;
    const int i16 = lane & 15, g = lane >> 4;
    const u16* proj = (const u16*)(p.ws + W_PROJ); const u16* QT = (const u16*)(p.ws + W_QT); const u16* SST = (const u16*)(p.ws + W_SST);
    const float* bonus = (const float*)(p.ws + W_BONUS);
    for (int wu = gw; wu < 8192 + 256; wu += nw) {
        int u, tg, b, h, c = 0, row0; bool prm = wu < 8192;
        if (prm) { u = wu >> 2; tg = wu & 3; b = u >> 10; h = (u >> 7) & 7; c = u & 127; row0 = b * 8192 + c * 64; }
        else { const int s = wu - 8192; u = 2048 + s; tg = 0; b = s >> 3; h = s & 7; row0 = NTP + b * 16; }
        const int t = 16 * tg + i16; const int row = row0 + t;
        u16* z = (u16*)(p.ws + W_XB) + (size_t)row * DM + 512 + h * 64;
        const u16* qt = QT + (size_t)u * 4096 + t * 64 + 8 * g; const bf16x8 bq0 = *(const bf16x8*)qt, bq1 = *(const bf16x8*)(qt + 32);
        { const float a_ = p.mix[1024 + h * 64 + lane], b_ = p.gn_g[h * 64 + lane], c_ = p.gn_b[h * 64 + lane];
            asm volatile("s_waitcnt lgkmcnt(0)" ::: "memory"); pw[lane] = a_; pw[64 + lane] = b_; pw[128 + lane] = c_; asm volatile("s_waitcnt lgkmcnt(0)" ::: "memory"); }
        const int wofs = 16 * (g & 1) + 8 * (g >> 1);
        const int mode = t > 0 ? 0 : (prm ? (c > 0 ? 0 : 1) : 2);
        uint2 ylw[4], cvw[4], grw[4], pvw[4];
        { const u16* pr_ = proj + (size_t)row * NC + h * 64 + wofs; const u16* pp_ = proj + (size_t)(mode == 0 ? row - 1 : row) * NC + C_RV + h * 64 + wofs;
#pragma unroll
            for (int mp = 0; mp < 2; ++mp) {
                unwiden16(*(const uint4*)(z + 32 * mp + wofs), ylw[2 * mp], ylw[2 * mp + 1]);
                unwiden16(*(const uint4*)(pr_ + C_RV + 32 * mp), cvw[2 * mp], cvw[2 * mp + 1]);
                unwiden16(*(const uint4*)(pr_ + C_GR + 32 * mp), grw[2 * mp], grw[2 * mp + 1]);
                unwiden16(*(const uint4*)(pp_ + 32 * mp), pvw[2 * mp], pvw[2 * mp + 1]); } }
        f32x4 y[4];
#pragma unroll
        for (int mt = 0; mt < 4; ++mt) {
            const uint2 yl = ylw[mt]; f32x4 a = {bflo(yl.x), bfhi(yl.x), bflo(yl.y), bfhi(yl.y)};
            const u16* sp = SST + (size_t)u * 4096 + (16 * mt + i16) * 64 + 8 * g;
            a = __builtin_amdgcn_mfma_f32_16x16x32_bf16(*(const bf16x8*)sp, bq0, a, 0, 0, 0); a = __builtin_amdgcn_mfma_f32_16x16x32_bf16(*(const bf16x8*)(sp + 32), bq1, a, 0, 0, 0);
            y[mt] = a;
        }
        float s1 = 0.f;
#pragma unroll
        for (int mt = 0; mt < 4; ++mt) s1 += (y[mt][0] + y[mt][1]) + (y[mt][2] + y[mt][3]);
        s1 = xadd16(s1); s1 = xadd32(s1);
        const float mu = s1 * (1.f / 64.f); float s2 = 0.f;
#pragma unroll
        for (int mt = 0; mt < 4; ++mt)
#pragma unroll
            for (int e = 0; e < 4; ++e) { const float d = y[mt][e] - mu; s2 += d * d; }
        s2 = xadd16(s2); s2 = xadd32(s2);
        const float rs = __builtin_amdgcn_rsqf(s2 * (1.f / 64.f) + 64e-5f);
        const float bon = bonus[(size_t)u * 64 + t];
        uint2 wz[4];
#pragma unroll
        for (int mt = 0; mt < 4; ++mt) {
            const int i0 = 16 * mt + 4 * g; const int hj = h * 64 + i0;
            const uint2 cvp = cvw[mt]; const float cv[4] = {bflo(cvp.x), bfhi(cvp.x), bflo(cvp.y), bfhi(cvp.y)};
            float pv[4];
            if (mode == 0) { const uint2 w = pvw[mt]; pv[0] = bflo(w.x); pv[1] = bfhi(w.x); pv[2] = bflo(w.y); pv[3] = bfhi(w.y); }
            else if (mode == 1) { pv[0] = pv[1] = pv[2] = pv[3] = 0.f; }
            else { const float4 w = *(const float4*)(p.st_shift + (size_t)b * 1664 + 1024 + hj); pv[0] = w.x; pv[1] = w.y; pv[2] = w.z; pv[3] = w.w; }
            const float4 mv = *(const float4*)(pw + i0), gg = *(const float4*)(pw + 64 + i0), gb = *(const float4*)(pw + 128 + i0);
            const float mvv[4] = {mv.x, mv.y, mv.z, mv.w}, ggv[4] = {gg.x, gg.y, gg.z, gg.w}, gbv[4] = {gb.x, gb.y, gb.z, gb.w};
            const uint2 grp = grw[mt]; const float gr[4] = {bflo(grp.x), bfhi(grp.x), bflo(grp.y), bfhi(grp.y)};
            float ov[4];
#pragma unroll
            for (int e = 0; e < 4; ++e) { const float xv = cv[e] + (pv[e] - cv[e]) * mvv[e]; const float yn = (y[mt][e] - mu) * rs * ggv[e] + gbv[e] + bon * xv; ov[e] = yn * silu(gr[e]); }
            wz[mt].x = pack2(ov[0], ov[1]); wz[mt].y = pack2(ov[2], ov[3]);
        }
#pragma unroll
        for (int mt = 0; mt < 4; mt += 2) *(uint4*)(z + 16 * (mt + (g & 1)) + 8 * (g >> 1)) = widen16(wz[mt], wz[mt + 1]);
    }
}


#define XB_TMO      128
#define XB_XCNT(j)  (256  + 64 * (j))
#define XB_XSUB(j)  (1280 + 64 * (j))
#define XB_XGEN(j)  (2304 + 64 * (j))
#define XB_TOP      3328
#define XB_TOPGEN   3392
#define XCD_BAR_WORDS 3456
#define XB_SPIN_CAP (1u << 18)
DI unsigned xb_ld(unsigned* p) { return __hip_atomic_load(p, __ATOMIC_RELAXED, __HIP_MEMORY_SCOPE_AGENT); }
DI unsigned xb_add(unsigned* p, unsigned v) { return __hip_atomic_fetch_add(p, v, __ATOMIC_RELAXED, __HIP_MEMORY_SCOPE_AGENT); }
DI unsigned xb_xcc_id() { return (unsigned)__builtin_amdgcn_s_getreg((3 << 11) | 20) & 0xFu; }
#define XB_SPIN(cond, bar) do { unsigned _sp = 0; while (cond) { __builtin_amdgcn_s_sleep(2); \
    if ((++_sp & 255u) == 0u) { if (xb_ld(&(bar)[XB_TMO])) break; if (_sp > XB_SPIN_CAP) { atomicAdd(&(bar)[XB_TMO], 1u); break; } } } } while (0)
struct XcdBarrier { unsigned* bar; unsigned x; volatile LAS unsigned* st; };
DI XcdBarrier xcd_barrier_post(unsigned* bar, volatile LAS unsigned* st) {
    XcdBarrier b; b.bar = bar; b.x = xb_xcc_id(); b.st = st;
    if (threadIdx.x == 0) (void)xb_add(&bar[XB_XCNT(b.x)], 1u);
    return b;
}
DI void xcd_barrier_complete(unsigned* bar, unsigned x, unsigned& nloc, unsigned& nx) {
    const unsigned G = gridDim.x * gridDim.y * gridDim.z;
    unsigned sum, cnt, mine, sp = 0u;
    for (;;) {
        sum = 0u; cnt = 0u; mine = 0u;
#pragma unroll
        for (unsigned j = 0; j < 16; ++j) { const unsigned c = xb_ld(&bar[XB_XCNT(j)]); sum += c; cnt += (c > 0u) ? 1u : 0u; mine = (j == x) ? c : mine; }
        if (sum == G) break;
        __builtin_amdgcn_s_sleep(1);
        if ((++sp & 255u) == 0u) { if (xb_ld(&bar[XB_TMO])) break; if (sp > XB_SPIN_CAP) { atomicAdd(&bar[XB_TMO], 1u); break; } }
    }
    nloc = mine > 0u ? mine : 1u; nx = cnt > 0u ? cnt : 1u;
}
DI void xcd_barrier(const XcdBarrier& b) {
    asm volatile("s_waitcnt vmcnt(0)" ::: "memory");
    __syncthreads();
    if (threadIdx.x == 0) {
        unsigned* bar = b.bar;
        __builtin_amdgcn_s_waitcnt(0);
        unsigned nloc = b.st[0], nx = b.st[1];
        if (nloc == 0u) { xcd_barrier_complete(bar, b.x, nloc, nx); b.st[0] = nloc; b.st[1] = nx; }
        const unsigned old = xb_add(&bar[XB_XSUB(b.x)], 1u);
        const unsigned gen = old / nloc;
        if (old + 1u == (gen + 1u) * nloc) {
            __builtin_amdgcn_fence(__ATOMIC_RELEASE, "agent");
            asm volatile("s_waitcnt vmcnt(0)" ::: "memory");
            const unsigned og = xb_add(&bar[XB_TOP], 1u);
            const unsigned tg = og / nx;
            if (og + 1u == (tg + 1u) * nx) xb_add(&bar[XB_TOPGEN], 1u);
            else XB_SPIN(xb_ld(&bar[XB_TOPGEN]) == tg, bar);
            __builtin_amdgcn_fence(__ATOMIC_ACQUIRE, "agent");
            xb_add(&bar[XB_XGEN(b.x)], 1u);
            asm volatile("s_waitcnt vmcnt(0)" ::: "memory");
        } else {
            XB_SPIN(xb_ld(&bar[XB_XGEN(b.x)]) == gen, bar);
            __builtin_amdgcn_fence(__ATOMIC_ACQUIRE, "agent");
            asm volatile("s_waitcnt vmcnt(0)" ::: "memory");
        }
    }
    __syncthreads();
}

DI void run_phase(const Params& p, char* lds, int ph) {
    if (ph == 0) phase_prep(p, lds);
    else if (ph == 1) { Epi1 e{&p}; gemm_phase((const u16*)(p.ws + W_XB), (const u16*)(p.ws + W_WINT), 132, 33, lds, e); }
    else if (ph == 2) phase_rwkv_prep(p, lds);
    else if (ph == 3) phase_scan_attn(p, lds);
    else if (ph == 4) phase_rwkv_out(p, lds);
    else gemm_out(p, lds);
}

extern "C" __global__ void __launch_bounds__(256, 2) hymba_mega(Params p, int ph_lo, int ph_hi) {
    extern __shared__ __attribute__((aligned(16))) char lds[];
#if ONE_LAUNCH
    volatile LAS unsigned* st = (volatile LAS unsigned*)(lds + 75520);
    if (threadIdx.x == 0) { st[0] = 0u; st[1] = 0u; st[2] = 0u; st[3] = 0u; }
    __syncthreads();
    const XcdBarrier xb = xcd_barrier_post((unsigned*)(p.ws + W_BAR), st);
#ifndef PROBE_REP
#define PROBE_REP -1
#endif
#define RUNP(k) do { run_phase(p, lds, k); if (PROBE_REP == k) { xcd_barrier(xb); run_phase(p, lds, k); } } while (0)
    RUNP(0); xcd_barrier(xb);
    RUNP(1); xcd_barrier(xb);
    RUNP(2); xcd_barrier(xb);
    RUNP(3); xcd_barrier(xb);
    run_phase(p, lds, 4); xcd_barrier(xb);
    RUNP(5);
#else
    run_phase(p, lds, ph_lo);
#endif
}

extern "C" void kernel_launch(void* const* d_in, const int* in_sizes, int n_in, void* d_out, int out_size, void* d_ws, size_t ws_size, hipStream_t stream) {
    Params p{};
    const float** f = (const float**)&p;
    for (int i = 0; i < 22; ++i) f[i] = (const float*)d_in[i];
    p.out = (float*)d_out; p.ws = (char*)d_ws;
    static int grid_blocks = 0;
    if (!grid_blocks) {
        hipFuncSetAttribute((const void*)hymba_mega, hipFuncAttributeMaxDynamicSharedMemorySize, LDS_BYTES);
        int dev = 0, cus = 0, per_cu = 0;
        hipGetDevice(&dev);
        hipDeviceGetAttribute(&cus, hipDeviceAttributeMultiprocessorCount, dev);
        hipOccupancyMaxActiveBlocksPerMultiprocessor(&per_cu, hymba_mega, 256, LDS_BYTES);
        if (per_cu > 2) per_cu = 2;
        if (per_cu < 1) per_cu = 1;
        grid_blocks = cus * per_cu;
    }
#if ONE_LAUNCH
    int lo = 0, hi = 5;
    (void)hipMemsetAsync((char*)d_ws + W_BAR, 0, (XCD_BAR_WORDS + 128) * 4, stream);
    void* args[] = {&p, &lo, &hi};
    hipError_t e = hipLaunchCooperativeKernel((void*)hymba_mega, dim3(grid_blocks), dim3(256), args, LDS_BYTES, stream);
    if (e != hipSuccess) fprintf(stderr, "cooperative launch failed: %s (grid %d)\n", hipGetErrorString(e), grid_blocks);
#else
    for (int ph = 0; ph < 6; ++ph) hipLaunchKernelGGL(hymba_mega, dim3(grid_blocks), dim3(256), LDS_BYTES, stream, p, ph, ph);
#endif
}
```
